# Optimizing an MI355X kernel written in HIP

```python
import jax
import jax.numpy as jnp
from jax import lax
import numpy as np

D_MODEL = 1024
BATCH = 4
SEQ = 4096
DEPTH = 1
DEC_BATCH = 128
DEC_SEQ = 4
PAST_LEN = 2048
PAGE_SIZE = 128

H_M = 4
DK_M = 128
DV_M = 128
W_M = H_M * DV_M
H_F = 8
DH_F = 64
W_F = H_F * DH_F
D_FF = -(-8 * D_MODEL // (3 * 256)) * 256
PLE_DIM = 256
CHUNK = 128
Q_BLOCK = 128
EPS = 1e-6
F_SCALE = DH_F ** -0.5
K_SCALE_M = DK_M ** -0.5
SPLIT_SIZES = (W_M, W_M, W_M, W_M, H_M, H_M, W_F, W_F, W_F, H_F, D_MODEL, D_MODEL)
D_IN = sum(SPLIT_SIZES)

kernel_name = 'mlstm_fox_gated_hybrid_step'


def rmsnorm(x, g):
    xf = x.astype(jnp.float32)
    y = xf * lax.rsqrt(jnp.mean(xf * xf, axis=-1, keepdims=True) + EPS)
    return (y * g.astype(jnp.float32)).astype(x.dtype)


def project_in(x, g_mix, w_in, b_mi, b_mf, b_ff, g_qn, g_kn):
    bn, t = x.shape[:2]
    z = rmsnorm(x, g_mix) @ w_in
    parts = []
    off = 0
    for s in SPLIT_SIZES:
        parts.append(z[..., off:off + s])
        off += s
    mq, mk, mv, mo, mi, mf, fq, fk, fv, ff, ga, gb = parts
    mq = mq.reshape(bn, t, H_M, DK_M)
    mk = mk.reshape(bn, t, H_M, DK_M) * K_SCALE_M
    mv = mv.reshape(bn, t, H_M, DV_M)
    m_ig = (mi + b_mi).astype(jnp.float32)
    m_lf = jax.nn.log_sigmoid((mf + b_mf).astype(jnp.float32))
    fq = rmsnorm(fq.reshape(bn, t, H_F, DH_F), g_qn)
    fk = rmsnorm(fk.reshape(bn, t, H_F, DH_F), g_kn)
    fv = fv.reshape(bn, t, H_F, DH_F)
    f_lf = jax.nn.log_sigmoid((ff + b_ff).astype(jnp.float32))
    return (mq, mk, mv, mo, m_ig, m_lf), (fq, fk, fv, f_lf), (ga, gb)


def mlstm_chunk(carry, xs):
    c_st, n_st, m_st = carry
    q, k, v, ig, lf = xs
    q, k, v = (a.astype(jnp.float32).transpose(0, 2, 1, 3) for a in (q, k, v))
    ig = ig.transpose(0, 2, 1)
    lf = lf.transpose(0, 2, 1)
    length = q.shape[2]
    b = jnp.cumsum(lf, axis=-1)
    a = b + m_st[..., None]
    causal = jnp.tril(jnp.ones((length, length), dtype=bool))
    dlog = jnp.where(causal, b[..., :, None] - b[..., None, :] + ig[..., None, :], -jnp.inf)
    m_t = jnp.maximum(a, jnp.max(dlog, axis=-1))
    w_intra = jnp.exp(dlog - m_t[..., None])
    w_inter = jnp.exp(a - m_t)
    s = jnp.einsum('bhtd,bhsd->bhts', q, k) * w_intra
    num = w_inter[..., None] * jnp.einsum('bhtd,bhde->bhte', q, c_st) + jnp.einsum('bhts,bhse->bhte', s, v)
    den = w_inter * jnp.einsum('bhtd,bhd->bht', q, n_st) + jnp.sum(s, axis=-1)
    h = num / jnp.maximum(jnp.abs(den), jnp.exp(-m_t))[..., None]
    b_end = b[..., -1]
    a_end = b_end + m_st
    w_log = b_end[..., None] - b + ig
    m_new = jnp.maximum(a_end, jnp.max(w_log, axis=-1))
    w_s = jnp.exp(w_log - m_new[..., None])
    decay = jnp.exp(a_end - m_new)
    c_new = decay[..., None, None] * c_st + jnp.einsum('bhs,bhsd,bhse->bhde', w_s, k, v)
    n_new = decay[..., None] * n_st + jnp.einsum('bhs,bhsd->bhd', w_s, k)
    return (c_new, n_new, m_new), h.transpose(0, 2, 1, 3)


def mlstm_prompt(q, k, v, ig, lf):
    bn, s = q.shape[:2]
    nc = s // CHUNK

    def chunks(a):
        return a.reshape((bn, nc, CHUNK) + a.shape[2:]).swapaxes(0, 1)

    init = (jnp.zeros((bn, H_M, DK_M, DV_M), jnp.float32),
            jnp.zeros((bn, H_M, DK_M), jnp.float32),
            jnp.zeros((bn, H_M), jnp.float32))
    (c_f, n_f, m_f), h = lax.scan(mlstm_chunk, init, (chunks(q), chunks(k), chunks(v), chunks(ig), chunks(lf)))
    h = h.swapaxes(0, 1).reshape(bn, s, H_M, DV_M)
    return h, c_f, n_f, m_f


def fox_prompt(q, k, v, lf):
    bn, s = q.shape[:2]
    nb = s // Q_BLOCK
    f_cum = jnp.cumsum(lf, axis=1)
    f_keys = f_cum.transpose(0, 2, 1)
    kpos = jnp.arange(s)

    def block(args):
        qb, fb, start = args
        logits = jnp.einsum('bthd,bshd->bhts', qb, k).astype(jnp.float32) * F_SCALE
        logits = logits + fb.transpose(0, 2, 1)[..., None] - f_keys[:, :, None, :]
        qpos = start + jnp.arange(Q_BLOCK)
        logits = jnp.where(kpos[None, :] <= qpos[:, None], logits, -jnp.inf)
        p = jax.nn.softmax(logits, axis=-1)
        return jnp.einsum('bhts,bshd->bthd', p.astype(v.dtype), v)

    qs = q.reshape(bn, nb, Q_BLOCK, H_F, DH_F).swapaxes(0, 1)
    fs = f_cum.reshape(bn, nb, Q_BLOCK, H_F).swapaxes(0, 1)
    starts = jnp.arange(nb) * Q_BLOCK
    out = lax.map(block, (qs, fs, starts))
    return out.swapaxes(0, 1).reshape(bn, s, H_F, DH_F)


def fox_sample(q, k, v, lf, cache_k, cache_v, cache_lf, page_table):
    db, t = q.shape[:2]
    kp = cache_k[page_table].reshape(db, -1, H_F, DH_F)
    vp = cache_v[page_table].reshape(db, -1, H_F, DH_F)
    lfp = cache_lf[page_table].reshape(db, -1, H_F).astype(jnp.float32)
    n_past = kp.shape[1]
    past_cum = jnp.cumsum(lfp, axis=1)
    f_past = (past_cum - past_cum[:, -1:]).transpose(0, 2, 1)
    f_new = jnp.cumsum(lf, axis=1).transpose(0, 2, 1)
    lp = jnp.einsum('bthd,bshd->bhts', q, kp).astype(jnp.float32) * F_SCALE
    lp = lp + f_new[..., None] - f_past[:, :, None, :]
    ln = jnp.einsum('bthd,bshd->bhts', q, k).astype(jnp.float32) * F_SCALE
    ln = ln + f_new[..., None] - f_new[:, :, None, :]
    ln = jnp.where(jnp.tril(jnp.ones((t, t), dtype=bool)), ln, -jnp.inf)
    p = jax.nn.softmax(jnp.concatenate([lp, ln], axis=-1), axis=-1).astype(v.dtype)
    return (jnp.einsum('bhts,bshd->bthd', p[..., :n_past], vp)
            + jnp.einsum('bhts,bshd->bthd', p[..., n_past:], v))


def merge_out(x, y_m, m_o, g_mh, y_f, gates, w_pa, w_pb, w_out):
    bn, t = x.shape[:2]
    hm = rmsnorm(y_m.astype(x.dtype), g_mh) * jax.nn.sigmoid(m_o).reshape(bn, t, H_M, DV_M)
    a = hm.reshape(bn, t, W_M) @ w_pa
    b = y_f.reshape(bn, t, W_F) @ w_pb
    ga, gb = gates
    return x + (jax.nn.sigmoid(ga) * a + jax.nn.sigmoid(gb) * b) @ w_out


def ffn_and_ple(x, p, g_ffn, w_gu, w_down, g_ple, w_ple_gate, w_ple_proj):
    gu = rmsnorm(x, g_ffn) @ w_gu
    x = x + (jax.nn.silu(gu[..., :D_FF]) * gu[..., D_FF:]) @ w_down
    gate = jax.nn.sigmoid(rmsnorm(x, g_ple) @ w_ple_gate)
    return x + gate * (p.astype(x.dtype) @ w_ple_proj)


def setup_inputs(seed: int = 0) -> dict:
    key = jax.random.key(seed)
    ks = iter(jax.random.split(key, 48))
    f32 = jnp.float32

    def nrm(shape, scale):
        return jax.random.normal(next(ks), shape, f32) * scale

    n_pages = PAST_LEN // PAGE_SIZE
    n_used = DEC_BATCH * n_pages
    n_pool = n_used + n_used // 4
    page_table = jax.random.permutation(next(ks), n_pool)[:n_used].reshape(DEC_BATCH, n_pages).astype(jnp.int32)
    return {
        'x_prompt': nrm((BATCH, SEQ, D_MODEL), 1.0),
        'x_sample': nrm((DEC_BATCH, DEC_SEQ, D_MODEL), 1.0),
        'p_prompt': nrm((DEPTH, BATCH, SEQ, PLE_DIM), 1.0),
        'p_sample': nrm((DEPTH, DEC_BATCH, DEC_SEQ, PLE_DIM), 1.0),
        'cache_k': nrm((DEPTH, n_pool, PAGE_SIZE, H_F, DH_F), 1.0),
        'cache_v': nrm((DEPTH, n_pool, PAGE_SIZE, H_F, DH_F), 1.0),
        'cache_logf': jax.nn.log_sigmoid(2.5 + nrm((DEPTH, n_pool, PAGE_SIZE, H_F), 1.0)),
        'state_C': nrm((DEPTH, DEC_BATCH, H_M, DK_M, DV_M), 0.1),
        'state_n': nrm((DEPTH, DEC_BATCH, H_M, DK_M), 0.1),
        'state_m': nrm((DEPTH, DEC_BATCH, H_M), 1.0),
        'page_table': page_table,
        'g_mix': 1.0 + nrm((DEPTH, D_MODEL), 0.02),
        'w_in': nrm((DEPTH, D_MODEL, D_IN), D_MODEL ** -0.5),
        'b_mi': nrm((DEPTH, H_M), 0.1),
        'b_mf': jnp.linspace(3.0, 6.0, H_M, dtype=f32)[None, :] + nrm((DEPTH, H_M), 0.1),
        'b_ff': jnp.linspace(1.0, 4.0, H_F, dtype=f32)[None, :] + nrm((DEPTH, H_F), 0.1),
        'g_mh': 1.0 + nrm((DEPTH, H_M, DV_M), 0.02),
        'g_qn': 1.0 + nrm((DEPTH, DH_F), 0.02),
        'g_kn': 1.0 + nrm((DEPTH, DH_F), 0.02),
        'w_pa': nrm((DEPTH, W_M, D_MODEL), W_M ** -0.5),
        'w_pb': nrm((DEPTH, W_F, D_MODEL), W_F ** -0.5),
        'w_out': nrm((DEPTH, D_MODEL, D_MODEL), D_MODEL ** -0.5),
        'g_ffn': 1.0 + nrm((DEPTH, D_MODEL), 0.02),
        'w_gu': nrm((DEPTH, D_MODEL, 2 * D_FF), D_MODEL ** -0.5),
        'w_down': nrm((DEPTH, D_FF, D_MODEL), D_FF ** -0.5),
        'g_ple': 1.0 + nrm((DEPTH, D_MODEL), 0.02),
        'w_ple_gate': nrm((DEPTH, D_MODEL, D_MODEL), D_MODEL ** -0.5),
        'w_ple_proj': nrm((DEPTH, PLE_DIM, D_MODEL), PLE_DIM ** -0.5),
    }


def reference(x_prompt, x_sample, p_prompt, p_sample, cache_k, cache_v, cache_logf, state_C, state_n, state_m,
              page_table, g_mix, w_in, b_mi, b_mf, b_ff, g_mh, g_qn, g_kn, w_pa, w_pb, w_out, g_ffn, w_gu,
              w_down, g_ple, w_ple_gate, w_ple_proj):
    xp = x_prompt
    xs = x_sample
    kp_l, vp_l, lfp_l, cp_l, np_l, mp_l = [], [], [], [], [], []
    ks_l, vs_l, lfs_l, cs_l, ns_l, ms_l = [], [], [], [], [], []
    for l in range(DEPTH):
        mi, fi, gates = project_in(xp, g_mix[l], w_in[l], b_mi[l], b_mf[l], b_ff[l], g_qn[l], g_kn[l])
        mq, mk, mv, mo, mig, mlf = mi
        fq, fk, fv, flf = fi
        hm, c_f, n_f, m_f = mlstm_prompt(mq, mk, mv, mig, mlf)
        yf = fox_prompt(fq, fk, fv, flf)
        xp = merge_out(xp, hm, mo, g_mh[l], yf, gates, w_pa[l], w_pb[l], w_out[l])
        xp = ffn_and_ple(xp, p_prompt[l], g_ffn[l], w_gu[l], w_down[l], g_ple[l], w_ple_gate[l], w_ple_proj[l])
        kp_l.append(fk); vp_l.append(fv); lfp_l.append(flf)
        cp_l.append(c_f); np_l.append(n_f); mp_l.append(m_f)

        mi, fi, gates = project_in(xs, g_mix[l], w_in[l], b_mi[l], b_mf[l], b_ff[l], g_qn[l], g_kn[l])
        mq, mk, mv, mo, mig, mlf = mi
        fq, fk, fv, flf = fi
        carry = (state_C[l].astype(jnp.float32), state_n[l].astype(jnp.float32), state_m[l].astype(jnp.float32))
        (c_s, n_s, m_s), hm = mlstm_chunk(carry, (mq, mk, mv, mig, mlf))
        yf = fox_sample(fq, fk, fv, flf, cache_k[l], cache_v[l], cache_logf[l], page_table)
        xs = merge_out(xs, hm, mo, g_mh[l], yf, gates, w_pa[l], w_pb[l], w_out[l])
        xs = ffn_and_ple(xs, p_sample[l], g_ffn[l], w_gu[l], w_down[l], g_ple[l], w_ple_gate[l], w_ple_proj[l])
        ks_l.append(fk); vs_l.append(fv); lfs_l.append(flf)
        cs_l.append(c_s); ns_l.append(n_s); ms_l.append(m_s)

    return (xp, xs,
            jnp.stack(kp_l), jnp.stack(vp_l), jnp.stack(lfp_l),
            jnp.stack(cp_l), jnp.stack(np_l), jnp.stack(mp_l),
            jnp.stack(ks_l), jnp.stack(vs_l), jnp.stack(lfs_l),
            jnp.stack(cs_l), jnp.stack(ns_l), jnp.stack(ms_l))
```

```cpp
#include <hip/hip_runtime.h>
#include <hip/hip_bf16.h>
#include <cstdio>
#include <cstdint>
#include <cmath>
namespace pg8 {
#define PG8_LAS __attribute__((address_space(3)))
typedef unsigned short bf16_t;
typedef short bf16x8 __attribute__((ext_vector_type(8)));
typedef float f32x4 __attribute__((ext_vector_type(4)));
typedef unsigned u32x4 __attribute__((ext_vector_type(4)));
constexpr int BM = 256, BK = 64, HALF = 128, HTB = HALF * BK * 2  , STAGE_BYTES = 8 * HTB, NXCD = 8, WGM = 8;

__host__ __device__ __forceinline__ int lds_byte(int r, int c) { const int st = (r >> 4) * 2 + (c >> 5), rr = r & 15, cc = c & 31, ob = rr * 64 + cc * 2; return st * 1024 + (ob ^ (((ob >> 9) & 1) << 5)); }
__host__ __device__ __forceinline__ void stage_rc(int b, int& R, int& C) { const int st = b / 1024, sb = b % 1024, swz = sb ^ (((sb >> 9) & 1) << 5); R = (st >> 1) * 16 + swz / 64; C = (st & 1) * 32 + (swz % 64) / 2; }
__host__ __device__ __forceinline__ int perm32(int rho) { const int n = rho >> 4, i = rho & 15; return 8 * (i >> 2) + 4 * n + (i & 3); }

struct Unit { int pm, pn; };
struct Gemm { const bf16_t* A; const bf16_t* Bt; int M, N, K; };

struct StaticOrder {
    int nM, nN, nwg, G, c;
    __host__ __device__ void init(int M, int N, int G_, int c_) { nM = M / BM; nN = N / BM; nwg = nM * nN; G = G_; c = c_; }
    __host__ __device__ bool next(int i, Unit& u) const {
        const long L = (long)i * G + c; if (L >= nwg) return false;
        int wgid = (int)L; { const int q = nwg / NXCD, r = nwg % NXCD, xcd = wgid % NXCD, off = wgid / NXCD; wgid = (xcd < r ? xcd * (q + 1) : r * (q + 1) + (xcd - r) * q) + off; }
        const int nig = WGM * nN, gid = wgid / nig, fm = gid * WGM, gsz = (nM - fm) < WGM ? (nM - fm) : WGM;
        u.pm = fm + ((wgid % nig) % gsz); u.pn = (wgid % nig) / gsz; return true;
    }
    __device__ __forceinline__ void a_ready(const Unit&) const {}
    __device__ __forceinline__ void done(const Unit&) const {}
};

typedef float pg8_f32x2 __attribute__((ext_vector_type(2))); typedef __bf16 pg8_bf16x2 __attribute__((ext_vector_type(2)));
__device__ __forceinline__ unsigned cvt_pk_bf16(float lo, float hi) { const pg8_f32x2 v = {lo, hi}; const pg8_bf16x2 b = __builtin_convertvector(v, pg8_bf16x2); return __builtin_bit_cast(unsigned, b); }
typedef float f32x2 __attribute__((ext_vector_type(2)));
constexpr float EPSN = 1e-6f;
#define PG8_GAS __attribute__((address_space(1)))
__device__ __forceinline__ float sigm(float x) { return __builtin_amdgcn_rcpf(1.f + __builtin_amdgcn_exp2f(-1.4426950408889634f * x)); }
__device__ __forceinline__ f32x4 sigm4(f32x4 x) { f32x4 r; r[0] = sigm(x[0]); r[1] = sigm(x[1]); r[2] = sigm(x[2]); r[3] = sigm(x[3]); return r; }
__device__ __forceinline__ void st8bf(bf16_t* p, const f32x4 a, const f32x4 b) { u32x4 w; w.x = cvt_pk_bf16(a[0], a[1]); w.y = cvt_pk_bf16(a[2], a[3]); w.z = cvt_pk_bf16(b[0], b[1]); w.w = cvt_pk_bf16(b[2], b[3]); *(PG8_GAS u32x4*)p = w; }
__device__ __forceinline__ void ld8bf(const bf16_t* p, f32x4& a, f32x4& b) { const u32x4 w = *(const PG8_GAS u32x4*)p;
    a[0] = __uint_as_float(w.x << 16); a[1] = __uint_as_float(w.x & 0xffff0000u); a[2] = __uint_as_float(w.y << 16); a[3] = __uint_as_float(w.y & 0xffff0000u);
    b[0] = __uint_as_float(w.z << 16); b[1] = __uint_as_float(w.z & 0xffff0000u); b[2] = __uint_as_float(w.w << 16); b[3] = __uint_as_float(w.w & 0xffff0000u); }
__device__ __forceinline__ float dot4(f32x4 a) { return (a[0] * a[0] + a[1] * a[1]) + (a[2] * a[2] + a[3] * a[3]); }
constexpr int MP = 16384;

struct EpiIn {
    static constexpr bool PERM = true, AFTER_DRAIN = false;
    bf16_t *MQ, *MK, *MV, *MO, *FQ, *FK, *FV, *GA, *GB; float *kp, *ks, *vp, *vs; const float *g_qn, *g_kn; float c2;
    __device__ __forceinline__ void operator()(const f32x4 (&acc)[2][2][4][2], const Unit& u, int wr, int wc, int fr, int fq) const {
        asm volatile("" : "+v"(fr), "+v"(fq));
        const int pn = u.pn; const int row0 = u.pm * BM + wr * 64 + fr; const bool smp = u.pm >= MP / BM;
        if (pn >= 8 && pn < 12) {
            const bool isq = pn < 10; const float* g = isq ? g_qn : g_kn; const float post = isq ? c2 : 1.f;
            f32x4 gv[2][2];
#pragma unroll
            for (int bj = 0; bj < 2; ++bj)
#pragma unroll
                for (int n = 0; n < 2; ++n) gv[bj][n] = *(const PG8_GAS f32x4*)(g + 32 * bj + 8 * fq + 4 * n) * post;
            bf16_t* dst = isq ? FQ : FK; const int colb = (pn & 1) * 256 + 64 * wc + 8 * fq;
            float* ko = smp ? ks - (size_t)MP * 512 : kp;
#pragma unroll
            for (int ai = 0; ai < 2; ++ai)
#pragma unroll
                for (int m = 0; m < 4; ++m) { const size_t row = (size_t)(row0 + ai * HALF + m * 16);
                    float s = (dot4(acc[ai][0][m][0]) + dot4(acc[ai][0][m][1])) + (dot4(acc[ai][1][m][0]) + dot4(acc[ai][1][m][1]));
                    s += __shfl_xor(s, 16); s += __shfl_xor(s, 32);
                    const float r = rsqrtf(s * (1.0f / 64.0f) + EPSN);
#pragma unroll
                    for (int bj = 0; bj < 2; ++bj) { const f32x4 a = acc[ai][bj][m][0] * r * gv[bj][0], b = acc[ai][bj][m][1] * r * gv[bj][1];
                        st8bf(dst + row * 512 + colb + 32 * bj, a, b);
                        if (!isq) { float* o = ko + row * 512 + colb + 32 * bj; *(f32x4*)o = a; *(PG8_GAS f32x4*)(o + 4) = b; } } }
        } else if (pn < 14) {
            const int seg = pn >> 1;
            bf16_t* dst = seg == 0 ? MQ : seg == 1 ? MK : seg == 2 ? MV : seg == 3 ? MO : FV;
            const float sc = seg == 1 ? 0.08838834764831845f : 1.f; const int colb = (pn & 1) * 256 + 32 * wc + 8 * fq;
            float* vo = smp ? vs - (size_t)MP * 512 : vp;
#pragma unroll
            for (int ai = 0; ai < 2; ++ai)
#pragma unroll
                for (int m = 0; m < 4; ++m) { const size_t row = (size_t)(row0 + ai * HALF + m * 16);
#pragma unroll
                    for (int bj = 0; bj < 2; ++bj) { f32x4 a = acc[ai][bj][m][0] * sc, b = acc[ai][bj][m][1] * sc;
                        if (seg == 3) { a = sigm4(a); b = sigm4(b); }
                        st8bf(dst + row * 512 + colb + 128 * bj, a, b);
                        if (seg == 6) { float* o = vo + row * 512 + colb + 128 * bj; *(f32x4*)o = a; *(PG8_GAS f32x4*)(o + 4) = b; } } }
        } else {
            const int q = pn - 14; bf16_t* dst = q < 4 ? GA : GB; const int colb = (q & 3) * 256 + 32 * wc + 8 * fq;
#pragma unroll
            for (int ai = 0; ai < 2; ++ai)
#pragma unroll
                for (int m = 0; m < 4; ++m) { const size_t row = (size_t)(row0 + ai * HALF + m * 16);
#pragma unroll
                    for (int bj = 0; bj < 2; ++bj) st8bf(dst + row * 1024 + colb + 128 * bj, sigm4(acc[ai][bj][m][0]), sigm4(acc[ai][bj][m][1])); }
        }
    }
};
template <int FIRST> struct EpiMerge {
    static constexpr bool PERM = true, AFTER_DRAIN = false;
    const bf16_t* G; bf16_t* U;
    __device__ __forceinline__ void operator()(const f32x4 (&acc)[2][2][4][2], const Unit& u, int wr, int wc, int fr, int fq) const {
        asm volatile("" : "+v"(fr), "+v"(fq));
        const int row0 = u.pm * BM + wr * 64 + fr, colb = u.pn * BM + 32 * wc + 8 * fq;
#pragma unroll
        for (int ai = 0; ai < 2; ++ai)
#pragma unroll
            for (int m = 0; m < 4; ++m)
#pragma unroll
                for (int bj = 0; bj < 2; ++bj) { const size_t idx = (size_t)(row0 + ai * HALF + m * 16) * 1024 + colb + 128 * bj;
                    f32x4 ga, gb; ld8bf(G + idx, ga, gb); f32x4 a = acc[ai][bj][m][0] * ga, b = acc[ai][bj][m][1] * gb;
                    if (!FIRST) { f32x4 ua, ub; ld8bf(U + idx, ua, ub); a += ua; b += ub; }
                    st8bf(U + idx, a, b); }
    }
};
struct EpiRes {
    static constexpr bool PERM = true, AFTER_DRAIN = false;
    const float *basep, *bases; float* out; bf16_t* An; float* ssq; const float* g;
    __device__ __forceinline__ void operator()(const f32x4 (&acc)[2][2][4][2], const Unit& u, int wr, int wc, int fr, int fq) const {
        asm volatile("" : "+v"(fr), "+v"(fq));
        const int row0 = u.pm * BM + wr * 64 + fr, colb = u.pn * BM + 32 * wc + 8 * fq; const float* base = u.pm >= MP / BM ? bases : basep;
        f32x4 gv[2][2];
#pragma unroll
        for (int bj = 0; bj < 2; ++bj)
#pragma unroll
            for (int n = 0; n < 2; ++n) gv[bj][n] = *(const PG8_GAS f32x4*)(g + colb + 128 * bj + 4 * n);
#pragma unroll
        for (int ai = 0; ai < 2; ++ai)
#pragma unroll
            for (int m = 0; m < 4; ++m) { const int row = row0 + ai * HALF + m * 16; float s = 0.f;
#pragma unroll
                for (int bj = 0; bj < 2; ++bj) { const size_t idx = (size_t)row * 1024 + colb + 128 * bj;
                    const f32x4 a = *(const PG8_GAS f32x4*)(base + idx) + acc[ai][bj][m][0], b = *(const PG8_GAS f32x4*)(base + idx + 4) + acc[ai][bj][m][1];
                    *(PG8_GAS f32x4*)(out + idx) = a; *(PG8_GAS f32x4*)(out + idx + 4) = b; s += dot4(a) + dot4(b);
                    st8bf(An + idx, a * gv[bj][0], b * gv[bj][1]); }
                s += __shfl_xor(s, 16); s += __shfl_xor(s, 32);
                if (fq == 0) *(PG8_GAS float*)(ssq + (size_t)row * 16 + u.pn * 4 + wc) = s; }
    }
};
__device__ __forceinline__ float row_rstd(const float* ssq, int row) { const PG8_GAS f32x4* sp = (const PG8_GAS f32x4*)(ssq + (size_t)row * 16); const f32x4 t = (sp[0] + sp[1]) + (sp[2] + sp[3]);
    return rsqrtf(((t[0] + t[1]) + (t[2] + t[3])) * (1.0f / 1024.0f) + EPSN); }
struct EpiGU {
    static constexpr bool PERM = true, AFTER_DRAIN = false;
    const float* ssq; bf16_t* HB;
    __device__ __forceinline__ void operator()(const f32x4 (&acc)[2][2][4][2], const Unit& u, int wr, int wc, int fr, int fq) const {
        asm volatile("" : "+v"(fr), "+v"(fq));
        const int row0 = u.pm * BM + wr * 64 + fr, colb = u.pn * 128 + 32 * wc + 8 * fq;
#pragma unroll
        for (int ai = 0; ai < 2; ++ai)
#pragma unroll
            for (int m = 0; m < 4; ++m) { const int row = row0 + ai * HALF + m * 16; const float rs = row_rstd(ssq, row);
                f32x4 h[2];
#pragma unroll
                for (int n = 0; n < 2; ++n) { const f32x4 gg = acc[ai][0][m][n] * rs, uu = acc[ai][1][m][n] * rs; h[n] = gg * sigm4(gg) * uu; }
                st8bf(HB + (size_t)row * 2816 + colb, h[0], h[1]); }
    }
};
struct EpiStore {
    static constexpr bool PERM = true, AFTER_DRAIN = false;
    bf16_t* O;
    __device__ __forceinline__ void operator()(const f32x4 (&acc)[2][2][4][2], const Unit& u, int wr, int wc, int fr, int fq) const {
        asm volatile("" : "+v"(fr), "+v"(fq));
        const int row0 = u.pm * BM + wr * 64 + fr, colb = u.pn * BM + 32 * wc + 8 * fq;
#pragma unroll
        for (int ai = 0; ai < 2; ++ai)
#pragma unroll
            for (int m = 0; m < 4; ++m)
#pragma unroll
                for (int bj = 0; bj < 2; ++bj) st8bf(O + (size_t)(row0 + ai * HALF + m * 16) * 1024 + colb + 128 * bj, acc[ai][bj][m][0], acc[ai][bj][m][1]);
    }
};
struct EpiPle {
    static constexpr bool PERM = true, AFTER_DRAIN = false;
    const float* ssq; const bf16_t* TP; float* Y;
    __device__ __forceinline__ void operator()(const f32x4 (&acc)[2][2][4][2], const Unit& u, int wr, int wc, int fr, int fq) const {
        asm volatile("" : "+v"(fr), "+v"(fq));
        const int row0 = u.pm * BM + wr * 64 + fr, colb = u.pn * BM + 32 * wc + 8 * fq;
#pragma unroll
        for (int ai = 0; ai < 2; ++ai)
#pragma unroll
            for (int m = 0; m < 4; ++m) { const int row = row0 + ai * HALF + m * 16; const float rs = row_rstd(ssq, row);
#pragma unroll
                for (int bj = 0; bj < 2; ++bj) { const size_t idx = (size_t)row * 1024 + colb + 128 * bj; f32x4 ta, tb; ld8bf(TP + idx, ta, tb);
                    const f32x4 a = *(const PG8_GAS f32x4*)(Y + idx) + sigm4(acc[ai][bj][m][0] * rs) * ta, b = *(const PG8_GAS f32x4*)(Y + idx + 4) + sigm4(acc[ai][bj][m][1] * rs) * tb;
                    *(PG8_GAS f32x4*)(Y + idx) = a; *(PG8_GAS f32x4*)(Y + idx + 4) = b; } }
    }
};
template <class Epi, class Sched, bool ALIGN_EPI = false, bool SP2 = false>
__device__ __forceinline__ void gemm_phase(PG8_LAS unsigned char* lds, const Gemm g, const Sched& S, const Epi& E) {
    int tid_ = threadIdx.x; asm volatile("" : "+v"(tid_));
    const int tid = tid_, wid = __builtin_amdgcn_readfirstlane(tid >> 6), lane = tid & 63, wr = wid >> 2, wc = wid & 3, fr = lane & 15, fq = lane >> 4;
    int K_ = g.K; asm volatile("" : "+s"(K_));
    const int K = K_, nt = K / BK;
    unsigned voffA[2], voffB[2];
#pragma unroll
    for (int i = 0; i < 2; ++i) { int R, C; stage_rc(tid * 16 + i * 8192, R, C); const int Rb = Epi::PERM ? ((R & ~31) + perm32(R & 31)) : R;
        voffA[i] = (unsigned)(R * K + C) * 2u; voffB[i] = (unsigned)(Rb * K + C) * 2u; }
    const size_t kstep = (size_t)(BK * 2);
    const size_t hstep = (size_t)HALF * K * 2;
    const size_t tstep = 2 * hstep;
    const unsigned ldsw = (unsigned)wid * 1024u;
    const int aoff = lds_byte(wr * 64 + fr, fq * 8), boff = lds_byte(wc * 32 + fr, fq * 8);
#define PG8_SA(b, h) (((b) * 2 + (h)) * HTB)
#define PG8_SB(b, h) ((4 + (b) * 2 + (h)) * HTB)
#define PG8_STAGE(bufoff, gbase, voff) do { _Pragma("unroll") for (int _i = 0; _i < 2; ++_i) \
        __builtin_amdgcn_global_load_lds((const unsigned*)((const char*)(gbase) + (voff)[_i]), (PG8_LAS unsigned*)(lds + (bufoff) + ldsw + _i * 8192), 16, 0, 0); } while (0)
#define PG8_LDA(dst, b, h) do { _Pragma("unroll") for (int m = 0; m < 4; ++m) _Pragma("unroll") for (int k = 0; k < 2; ++k) dst[m][k] = *(const PG8_LAS bf16x8*)(lds + PG8_SA(b, h) + aoff + m * 2048 + k * 1024); } while (0)
#define PG8_LDB(dst, b, h) do { _Pragma("unroll") for (int n = 0; n < 2; ++n) _Pragma("unroll") for (int k = 0; k < 2; ++k) dst[n][k] = *(const PG8_LAS bf16x8*)(lds + PG8_SB(b, h) + boff + n * 2048 + k * 1024); } while (0)
#define PG8_MMA(ai, bj, At, Bt) do { __builtin_amdgcn_s_setprio(1); _Pragma("unroll") for (int m = 0; m < 4; ++m) _Pragma("unroll") for (int n = 0; n < 2; ++n) _Pragma("unroll") for (int k = 0; k < 2; ++k) \
        acc[ai][bj][m][n] = __builtin_amdgcn_mfma_f32_16x16x32_bf16(Bt[n][k], At[m][k], acc[ai][bj][m][n], 0, 0, 0); __builtin_amdgcn_s_setprio(0); } while (0)
#define PG8_WAIT_V(n) asm volatile("s_waitcnt vmcnt(" #n ")" ::: "memory")
#define PG8_WAIT_L(n) asm volatile("s_waitcnt lgkmcnt(" #n ")" ::: "memory")
#define PG8_BAR __builtin_amdgcn_s_barrier()
#define PG8_SCHED __builtin_amdgcn_sched_barrier(0)
    Unit cur, nxt; int ui = 0;
    if (!S.next(0, cur)) return;
    f32x4 acc[2][2][4][2];
#pragma unroll
    for (int a = 0; a < 2; ++a)
#pragma unroll
        for (int b = 0; b < 2; ++b)
#pragma unroll
            for (int m = 0; m < 4; ++m)
#pragma unroll
                for (int n = 0; n < 2; ++n) acc[a][b][m][n] = (f32x4){0.f, 0.f, 0.f, 0.f};
    bf16x8 At[4][2], B0[2][2], B1[2][2];
    const char* cA = (const char*)g.A + (size_t)cur.pm * tstep; const char* cB = (const char*)g.Bt + (size_t)cur.pn * tstep;
    S.a_ready(cur);
    if constexpr (SP2) {
        PG8_STAGE(PG8_SB(0, 0), cB, voffB); PG8_STAGE(PG8_SB(0, 1), cB + hstep, voffB); PG8_STAGE(PG8_SA(0, 0), cA, voffA); PG8_STAGE(PG8_SA(0, 1), cA + hstep, voffA);
        if (wr == 1) PG8_BAR;
        PG8_WAIT_V(2); PG8_BAR;
        PG8_STAGE(PG8_SB(1, 0), cB + kstep, voffB); PG8_STAGE(PG8_SA(1, 0), cA + kstep, voffA); PG8_STAGE(PG8_SB(1, 1), cB + hstep + kstep, voffB);
        PG8_WAIT_V(6); PG8_BAR;
    } else {
        PG8_STAGE(PG8_SB(0, 0), cB, voffB); PG8_STAGE(PG8_SA(0, 0), cA, voffA); PG8_STAGE(PG8_SB(0, 1), cB + hstep, voffB); PG8_STAGE(PG8_SA(0, 1), cA + hstep, voffA);
        if (wr == 1) PG8_BAR;
        PG8_WAIT_V(4); PG8_BAR;
        PG8_STAGE(PG8_SB(1, 0), cB + kstep, voffB); PG8_STAGE(PG8_SA(1, 0), cA + kstep, voffA); PG8_STAGE(PG8_SB(1, 1), cB + hstep + kstep, voffB);
        PG8_WAIT_V(6); PG8_BAR;
    }
    for (;;) {
        const bool has_next = S.next(ui + 1, nxt);
        const char* nA = has_next ? (const char*)g.A + (size_t)nxt.pm * tstep : cA; const char* nB = has_next ? (const char*)g.Bt + (size_t)nxt.pn * tstep : cB;
        for (int t = 0; t < nt; t += 2) {
            const bool last = (t == nt - 2);
            const char* a1 = cA + (size_t)(t + 1) * kstep;
            const char* a2 = last ? nA : cA + (size_t)(t + 2) * kstep; const char* b2 = last ? nB : cB + (size_t)(t + 2) * kstep;
            const char* a3 = a2 + kstep; const char* b3 = b2 + kstep;
            if (last && has_next) S.a_ready(nxt);
            if constexpr (SP2) {
            PG8_LDB(B0, 0, 0); PG8_LDB(B1, 0, 1); PG8_SCHED; PG8_LDA(At, 0, 0); PG8_STAGE(PG8_SA(1, 1), a1 + hstep, voffA);
            PG8_WAIT_V(8); PG8_WAIT_L(0); PG8_BAR; PG8_MMA(0, 0, At, B0); PG8_MMA(0, 1, At, B1); PG8_BAR; PG8_SCHED;
            PG8_LDA(At, 0, 1); PG8_STAGE(PG8_SB(0, 0), b2, voffB); PG8_STAGE(PG8_SB(0, 1), b2 + hstep, voffB); PG8_STAGE(PG8_SA(0, 0), a2, voffA);
            PG8_WAIT_V(8); PG8_WAIT_L(0); PG8_BAR; PG8_MMA(1, 0, At, B0); PG8_MMA(1, 1, At, B1); PG8_BAR; PG8_SCHED;
            PG8_LDB(B0, 1, 0); PG8_LDB(B1, 1, 1); PG8_SCHED; PG8_LDA(At, 1, 0); PG8_STAGE(PG8_SA(0, 1), a2 + hstep, voffA);
            PG8_WAIT_V(8); PG8_WAIT_L(0); PG8_BAR; PG8_MMA(0, 0, At, B0); PG8_MMA(0, 1, At, B1); PG8_BAR; PG8_SCHED;
            PG8_LDA(At, 1, 1); PG8_STAGE(PG8_SB(1, 0), b3, voffB); PG8_STAGE(PG8_SB(1, 1), b3 + hstep, voffB); PG8_STAGE(PG8_SA(1, 0), a3, voffA);
            PG8_WAIT_V(8); PG8_WAIT_L(0); PG8_BAR; PG8_MMA(1, 0, At, B0); PG8_MMA(1, 1, At, B1); PG8_BAR; PG8_SCHED;
            } else {
            PG8_LDB(B0, 0, 0); PG8_SCHED; PG8_LDA(At, 0, 0); PG8_STAGE(PG8_SA(1, 1), a1 + hstep, voffA);
            PG8_WAIT_L(8); PG8_BAR; PG8_WAIT_L(0); PG8_MMA(0, 0, At, B0); PG8_BAR; PG8_SCHED;
            PG8_LDB(B1, 0, 1); PG8_STAGE(PG8_SB(0, 0), b2, voffB);
            PG8_BAR; PG8_WAIT_L(0); PG8_MMA(0, 1, At, B1); PG8_BAR;
            PG8_LDA(At, 0, 1); PG8_STAGE(PG8_SA(0, 0), a2, voffA);
            PG8_BAR; PG8_WAIT_L(0); PG8_MMA(1, 0, At, B0); PG8_BAR; PG8_SCHED;
            PG8_STAGE(PG8_SB(0, 1), b2 + hstep, voffB);
            PG8_WAIT_V(6); PG8_BAR; PG8_MMA(1, 1, At, B1); PG8_BAR;
            PG8_LDB(B0, 1, 0); PG8_SCHED; PG8_LDA(At, 1, 0); PG8_STAGE(PG8_SA(0, 1), a2 + hstep, voffA);
            PG8_WAIT_L(8); PG8_BAR; PG8_WAIT_L(0); PG8_MMA(0, 0, At, B0); PG8_BAR; PG8_SCHED;
            PG8_LDB(B1, 1, 1); PG8_STAGE(PG8_SB(1, 0), b3, voffB);
            PG8_BAR; PG8_WAIT_L(0); PG8_MMA(0, 1, At, B1); PG8_BAR;
            PG8_LDA(At, 1, 1); PG8_STAGE(PG8_SA(1, 0), a3, voffA);
            PG8_BAR; PG8_WAIT_L(0); PG8_MMA(1, 0, At, B0); PG8_BAR; PG8_SCHED;
            PG8_STAGE(PG8_SB(1, 1), b3 + hstep, voffB);
            PG8_WAIT_V(6); PG8_BAR; PG8_MMA(1, 1, At, B1); PG8_BAR;
            }
        }
        if constexpr (ALIGN_EPI) { if (wr == 0) PG8_BAR; }
        if constexpr (!Epi::AFTER_DRAIN) { E(acc, cur, wr, wc, fr, fq); S.done(cur); }
        if (!has_next) break;
#pragma unroll
        for (int a = 0; a < 2; ++a)
#pragma unroll
            for (int b = 0; b < 2; ++b)
#pragma unroll
                for (int m = 0; m < 4; ++m)
#pragma unroll
                    for (int n = 0; n < 2; ++n) acc[a][b][m][n] = (f32x4){0.f, 0.f, 0.f, 0.f};
        cur = nxt; cA = nA; cB = nB; ++ui;
        if constexpr (ALIGN_EPI) { if (wr == 1) PG8_BAR; }
    }
    PG8_WAIT_V(0);
    if constexpr (!ALIGN_EPI) { if (wr == 0) PG8_BAR; }
    PG8_BAR;
    if constexpr (Epi::AFTER_DRAIN) { E.fused(acc, cur, wr, wc, fr, fq, lds, wid, lane); S.done(cur); }
#undef PG8_SA
#undef PG8_SB
#undef PG8_STAGE
#undef PG8_LDA
#undef PG8_LDB
#undef PG8_MMA
#undef PG8_WAIT_V
#undef PG8_WAIT_L
#undef PG8_BAR
#undef PG8_SCHED
}
}
namespace attn_body {
using bf16=__hip_bfloat16;
using bf16x8=__attribute__((ext_vector_type(8)))short;
using s16x4=__attribute__((ext_vector_type(4)))short;
using f32x16=__attribute__((ext_vector_type(16)))float;
using u32x4=__attribute__((ext_vector_type(4)))unsigned;
constexpr int BATCH=4,NHEAD=8,SEQ=4096,D=64,DM=NHEAD*D;
constexpr int NW=8,QBLK=32,QB=QBLK*NW,KVBLK=64,NQB=SEQ/QB;
constexpr int ATTN_PITCH=DM, ATTN_UNIT_ROWS=QB;
__device__ __forceinline__ int crow(int r,int hi){return (r&3)+8*(r>>2)+4*hi;}
#define SBAR() __builtin_amdgcn_sched_barrier(0)
__device__ __forceinline__ void cmask(f32x16&p0,f32x16&p1,int jb,int qrel,int hi){
  const float NEG=-INFINITY; int kb=64*jb+4*hi;
  #pragma unroll
  for(int r=0;r<16;++r){int kv=kb+(r&3)+8*(r>>2); if(kv>qrel)p0[r]=NEG; if(kv+32>qrel)p1[r]=NEG;}
}

constexpr int NSLOT=3, SLOTB=8192;
constexpr int LDS_K=0, LDS_V=NSLOT*SLOTB, LDS_WS=2*NSLOT*SLOTB, LDS_OST=LDS_WS+NW*64*4, LDS_BYTES=LDS_OST+NW*4096;
constexpr int LDS_TB=86016, LDS_F2=102400, LDS_BYTES_X=118784;
constexpr float C2=0.125f*1.4426950408889634f;
__device__ __forceinline__ void glds16(const void*gsrc,unsigned lds_dst){unsigned keep;
  asm volatile("s_mov_b32 %0, m0\n\ts_mov_b32 m0, %2\n\ts_nop 0\n\tglobal_load_lds_dwordx4 %1, off\n\ts_mov_b32 m0, %0":"=&s"(keep):"v"(gsrc),"s"(lds_dst):"memory");}
__device__ __forceinline__ float max3f(float a,float b,float c){float r;asm("v_max3_f32 %0, %1, %2, %3":"=v"(r):"v"(a),"v"(b),"v"(c));return r;}
__device__ __forceinline__ float max2f(float a,float b){float r;asm("v_max_f32_e32 %0, %1, %2":"=v"(r):"v"(a),"v"(b));return r;}
__device__ __forceinline__ float fadd_s(float a,float b){float r;asm("v_add_f32_e32 %0, %1, %2":"=v"(r):"v"(a),"v"(b));return r;}
__device__ __forceinline__ float fsub_s(float a,float b){float r;asm("v_sub_f32_e32 %0, %1, %2":"=v"(r):"v"(a),"v"(b));return r;}
typedef float f32x4_t __attribute__((ext_vector_type(4))); typedef float f32x2_t __attribute__((ext_vector_type(2))); typedef __bf16 bf16x2_t __attribute__((ext_vector_type(2)));
__device__ __forceinline__ unsigned cvtpk_s(float lo,float hi){f32x2_t v={lo,hi};bf16x2_t b=__builtin_convertvector(v,bf16x2_t);return __builtin_bit_cast(unsigned,b);}
#define WAIT_BAR(N) asm volatile("s_waitcnt vmcnt(" #N ") lgkmcnt(0)\n\ts_barrier":::"memory")

__device__ __forceinline__ void qkt(f32x16&p0,f32x16&p1,const char*Kslot,const bf16x8*qr,const f32x16&negm,int r32,int hi){
  const char*kb=Kslot+hi*1024+r32*16;
  #pragma unroll
  for(int d0=0;d0<4;++d0){
    const bf16x8 b0=*reinterpret_cast<const bf16x8*>(kb+d0*2048);
    const bf16x8 b1=*reinterpret_cast<const bf16x8*>(kb+d0*2048+512);
    if(d0==0){p0=__builtin_amdgcn_mfma_f32_32x32x16_bf16(b0,qr[0],negm,0,0,0);p1=__builtin_amdgcn_mfma_f32_32x32x16_bf16(b1,qr[0],negm,0,0,0);}
    else{p0=__builtin_amdgcn_mfma_f32_32x32x16_bf16(b0,qr[d0],p0,0,0,0);p1=__builtin_amdgcn_mfma_f32_32x32x16_bf16(b1,qr[d0],p1,0,0,0);}}
}
typedef __attribute__((address_space(3))) const char* lds_cptr;
typedef short v4i16_t __attribute__((ext_vector_type(4)));
__device__ __forceinline__ void kload8(bf16x8*kf,lds_cptr kp){
  kf[0]=*(const __attribute__((address_space(3))) bf16x8*)(kp);      kf[1]=*(const __attribute__((address_space(3))) bf16x8*)(kp+512);
  kf[2]=*(const __attribute__((address_space(3))) bf16x8*)(kp+2048); kf[3]=*(const __attribute__((address_space(3))) bf16x8*)(kp+2560);
  kf[4]=*(const __attribute__((address_space(3))) bf16x8*)(kp+4096); kf[5]=*(const __attribute__((address_space(3))) bf16x8*)(kp+4608);
  kf[6]=*(const __attribute__((address_space(3))) bf16x8*)(kp+6144); kf[7]=*(const __attribute__((address_space(3))) bf16x8*)(kp+6656);
}
__device__ __forceinline__ void kload2(bf16x8*kf,lds_cptr kp,int j){ kf[2*j]=*(const __attribute__((address_space(3))) bf16x8*)(kp+j*2048); kf[2*j+1]=*(const __attribute__((address_space(3))) bf16x8*)(kp+j*2048+512); }
__device__ __forceinline__ s16x4 vtr(lds_cptr p){ return __builtin_bit_cast(s16x4,__builtin_amdgcn_ds_read_tr16_b64_v4i16((__attribute__((address_space(3))) v4i16_t*)p)); }
__device__ __forceinline__ float rowmax(const f32x16&p0,const f32x16&p1){
  float a=max3f(p0[0],p0[1],p1[0]),b=max3f(p0[2],p0[3],p1[1]);a=max3f(a,p1[2],p1[3]);
  #pragma unroll
  for(int r=4;r<16;r+=4){a=max3f(a,p0[r],p0[r+1]);b=max3f(b,p0[r+2],p0[r+3]);a=max3f(a,p1[r],p1[r+1]);b=max3f(b,p1[r+2],p1[r+3]);}
  const float m=max2f(a,b);
  auto rr=__builtin_amdgcn_permlane32_swap(__float_as_uint(m),__float_as_uint(m),false,false);
  return max2f(__uint_as_float(rr[0]),__uint_as_float(rr[1]));
}
__device__ __forceinline__ void pv(f32x16*o,int vb,bf16x8 pa0,bf16x8 pa1,bf16x8 pa2,bf16x8 pa3){
  #pragma unroll
  for(int d0=0;d0<2;++d0){s16x4 lo[4],hi[4];
    #pragma unroll
    for(int ks=0;ks<4;++ks){
      asm volatile("ds_read_b64_tr_b16 %0,%1 offset:%c2":"=&v"(lo[ks]):"v"(vb),"i"(d0*4096+ks*1024):"memory");
      asm volatile("ds_read_b64_tr_b16 %0,%1 offset:%c2":"=&v"(hi[ks]):"v"(vb),"i"(d0*4096+ks*1024+512):"memory");}
    asm volatile("s_waitcnt lgkmcnt(0)":::"memory");SBAR();
    #define PK(k) (bf16x8){lo[k][0],lo[k][1],lo[k][2],lo[k][3],hi[k][0],hi[k][1],hi[k][2],hi[k][3]}
    o[d0]=__builtin_amdgcn_mfma_f32_32x32x16_bf16(pa0,PK(0),o[d0],0,0,0);
    o[d0]=__builtin_amdgcn_mfma_f32_32x32x16_bf16(pa1,PK(1),o[d0],0,0,0);
    o[d0]=__builtin_amdgcn_mfma_f32_32x32x16_bf16(pa2,PK(2),o[d0],0,0,0);
    o[d0]=__builtin_amdgcn_mfma_f32_32x32x16_bf16(pa3,PK(3),o[d0],0,0,0);
    #undef PK
  }
}

#ifndef ATTN_STORE16
#define ATTN_STORE16(p,v) (*(u32x4*)(p)=(v))
#endif
template<int THRL> __device__ __forceinline__ void attn_unit(int b,int h,int qb,const bf16*Q,const bf16*__restrict__ K,const bf16*__restrict__ V,bf16*O,char*shm){
  int tid_=threadIdx.x; asm volatile("":"+v"(tid_)); const int tid=tid_,lane=tid&63,r32=lane&31,hi=lane>>5; const int wid=__builtin_amdgcn_readfirstlane(tid>>6);
  const long rowbase=(long)b*SEQ; const int q0=qb*QB;
  const bf16*Qw=Q+(rowbase+q0+wid*QBLK)*DM+h*D;
  const bf16*Kh=K+rowbase*DM+h*D,*Vh=V+rowbase*DM+h*D;
  const unsigned lds0=(unsigned)(uintptr_t)shm;
  float*wsf=(float*)(shm+LDS_WS)+wid*64;
  typedef __attribute__((address_space(3))) float lds_f32; typedef __attribute__((address_space(3))) const f32x4_t lds_cf4;
  const lds_f32*tbp=(const lds_f32*)(shm+LDS_F2)+4*hi;
  #define TBADD(C0,C1,t) do{ const lds_cf4*tq_=(const lds_cf4*)(tbp+64*(t)); \
    { const f32x4_t a0_=tq_[0],a1_=tq_[2],a2_=tq_[4],a3_=tq_[6]; _Pragma("unroll") for(int v_=0;v_<4;++v_){C0[v_]+=a0_[v_];C0[4+v_]+=a1_[v_];C0[8+v_]+=a2_[v_];C0[12+v_]+=a3_[v_];} } \
    { const f32x4_t a0_=tq_[8],a1_=tq_[10],a2_=tq_[12],a3_=tq_[14]; _Pragma("unroll") for(int v_=0;v_<4;++v_){C1[v_]+=a0_[v_];C1[4+v_]+=a1_[v_];C1[8+v_]+=a2_[v_];C1[12+v_]+=a3_[v_];} } }while(0)
  const bf16*ksrc=Kh+(long)lane*DM+wid*8;
  const bf16*vsrc=Vh+(long)(16*(wid&3)+(lane>>2))*DM+(wid>>2)*32+(lane&3)*8;
  const unsigned kdst=lds0+LDS_K+wid*1024, vdst=lds0+LDS_V+wid*1024;
  #define DMA_K(t,slot) glds16(ksrc+(long)(t)*KVBLK*DM,(unsigned)__builtin_amdgcn_readfirstlane(kdst+(slot)))
  #define DMA_V(t,slot) glds16(vsrc+(long)(t)*KVBLK*DM,(unsigned)__builtin_amdgcn_readfirstlane(vdst+(slot)))
  const int vb0=(int)(lds0+LDS_V)+((lane>>4)&1)*32+(lane&3)*8+(4*hi+((lane&15)>>2))*64;
  const char*Kbase=shm+LDS_K; bf16x8 kf[8];
  const lds_cptr shm3=(lds_cptr)shm; const lds_cptr kp0=shm3+LDS_K+hi*1024+r32*16; const lds_cptr vp0=shm3+LDS_V+((lane>>4)&1)*32+(lane&3)*8+(4*hi+((lane&15)>>2))*64;
  const int NT=(q0+QB)/KVBLK;
  DMA_K(0,0);DMA_V(0,0);DMA_K(1,SLOTB);
  bf16x8 qr[4];
  #pragma unroll
  for(int d0=0;d0<4;++d0)qr[d0]=*reinterpret_cast<const bf16x8*>(&Qw[(long)r32*DM+d0*16+hi*8]);
  float zero_;asm volatile("v_mov_b32 %0, 0":"=v"(zero_));
  float mhat=zero_,l_reg=zero_;f32x16 o[2],negm;
  _Pragma("unroll") for(int r=0;r<16;++r){o[0][r]=zero_;o[1][r]=zero_;negm[r]=zero_;} asm volatile("":"+v"(negm));
  const int qrel=wid*QBLK+r32;
  #define CMASK(P0,P1,t) do{int jb_=(t)-(NT-4); if(jb_>=0)cmask(P0,P1,jb_,qrel,hi);}while(0)
  bool resc=false;
  #define START(P0,P1) do{ const float rm=rowmax(P0,P1); resc=false; \
    { const float dl=rm; mhat=fadd_s(mhat,dl); \
      _Pragma("unroll") for(int r=0;r<16;++r){P0[r]=fsub_s(P0[r],dl);P1[r]=fsub_s(P1[r],dl);} \
      _Pragma("unroll") for(int r=0;r<16;++r)negm[r]=-mhat; asm volatile("":"+v"(negm)); } \
    _Pragma("unroll") for(int r=0;r<16;++r)P0[r]=__builtin_amdgcn_exp2f(P0[r]); }while(0)
  #define RESC() do{ if(resc){ asm volatile("s_waitcnt lgkmcnt(0)":::"memory"); \
      _Pragma("unroll") for(int d_=0;d_<2;++d_) _Pragma("unroll") for(int r=0;r<16;++r)o[d_][r]*=wsf[crow(r,hi)]; } }while(0)
  f32x16 pA0,pA1,pB0,pB1;
  int sl_prev=0,sl_cur=0,sl_next=SLOTB;
  #define ROT() do{sl_prev=sl_cur;sl_cur=sl_next;sl_next=(sl_next==(NSLOT-1)*SLOTB)?0:sl_next+SLOTB;}while(0)
  DMA_K(2,2*SLOTB);
  WAIT_BAR(3);
  qkt(pA0,pA1,Kbase,qr,negm,r32,hi);asm volatile("s_nop 15\n\ts_nop 7":"+v"(pA0),"+v"(pA1));TBADD(pA0,pA1,0);CMASK(pA0,pA1,0);
  START(pA0,pA1);
  _Pragma("unroll") for(int r=0;r<16;++r)pA1[r]=__builtin_amdgcn_exp2f(pA1[r]);
  WAIT_BAR(0);
  DMA_K(3,0);DMA_V(1,SLOTB);
  ROT();
  kload8(kf,kp0+sl_cur);
  WAIT_BAR(2);
  s16x4 vlo[8],vhi[8]; u32x4 pw0,pw1,pw2,pw3;
  #define PKW(P,B) cvtpk_s(P[B],P[B+1])
  #define PAF(k) __builtin_bit_cast(bf16x8,pw##k)
  #define VFR(i) (bf16x8){vlo[i][0],vlo[i][1],vlo[i][2],vlo[i][3],vhi[i][0],vhi[i][1],vhi[i][2],vhi[i][3]}
  #define PIN(x) asm volatile("":"+v"(x))
  #define MX3(a,b,c) __builtin_fmaxf(__builtin_fmaxf((a),(b)),(c))
  #define GAPA(MF,A0,A1,A2,A3,W0,W1,PW) do{ MF; sacc+=A0; sacc+=A1; sacc+=A2; sacc+=A3; PIN(sacc); W0; W1; PIN(PW); SBAR(); }while(0)
  #define EX(v) __builtin_amdgcn_exp2f(v)
  #define GAPB(MF,X,B) do{ MF; X[B]=EX(X[B]); X[B+1]=EX(X[B+1]); X[B+2]=EX(X[B+2]); X[B+3]=EX(X[B+3]); PIN(X); SBAR(); }while(0)
  #define VRD(i) do{ vlo[i]=vtr(vp_+(((i)>>2)*4096+((i)&3)*1024)); vhi[i]=vtr(vp_+(((i)>>2)*4096+((i)&3)*1024+512)); }while(0)
  #define KRD(G,j) do{ if(G){ kload2(kf,kp0+sl_next,j); SBAR(); } }while(0)
  #define STEP(C0,C1,P0,P1,t,GK,GV,GL) do{ SBAR(); \
    const lds_cptr vp_=vp0+sl_prev; \
    VRD(0); SBAR(); float sacc=(P0[0]+P0[1]); \
    GAPA(C0=__builtin_amdgcn_mfma_f32_32x32x16_bf16(kf[0],qr[0],negm,0,0,0), P0[2],P0[3],P0[4],P0[5],     pw0[0]=PKW(P0,0), pw0[1]=PKW(P0,2), pw0); \
    VRD(4); SBAR(); GAPA(C1=__builtin_amdgcn_mfma_f32_32x32x16_bf16(kf[1],qr[0],negm,0,0,0), P0[6],P0[7],P0[8],P0[9],     pw0[2]=PKW(P0,4), pw0[3]=PKW(P0,6), pw0); \
    VRD(1); SBAR(); GAPA(C0=__builtin_amdgcn_mfma_f32_32x32x16_bf16(kf[2],qr[1],C0,0,0,0),   P0[10],P0[11],P0[12],P0[13], pw1[0]=PKW(P0,8), pw1[1]=PKW(P0,10), pw1); \
    VRD(5); SBAR(); GAPA(C1=__builtin_amdgcn_mfma_f32_32x32x16_bf16(kf[3],qr[1],C1,0,0,0),   P0[14],P0[15],P1[0],P1[1],   pw1[2]=PKW(P0,12),pw1[3]=PKW(P0,14), pw1); \
    VRD(2); SBAR(); GAPA(C0=__builtin_amdgcn_mfma_f32_32x32x16_bf16(kf[4],qr[2],C0,0,0,0),   P1[2],P1[3],P1[4],P1[5],     pw2[0]=PKW(P1,0), pw2[1]=PKW(P1,2), pw2); \
    VRD(6); SBAR(); GAPA(C1=__builtin_amdgcn_mfma_f32_32x32x16_bf16(kf[5],qr[2],C1,0,0,0),   P1[6],P1[7],P1[8],P1[9],     pw2[2]=PKW(P1,4), pw2[3]=PKW(P1,6), pw2); \
    VRD(3); SBAR(); GAPA(C0=__builtin_amdgcn_mfma_f32_32x32x16_bf16(kf[6],qr[3],C0,0,0,0),   P1[10],P1[11],P1[12],P1[13], pw3[0]=PKW(P1,8), pw3[1]=PKW(P1,10), pw3); \
    VRD(7); SBAR(); GAPA(C1=__builtin_amdgcn_mfma_f32_32x32x16_bf16(kf[7],qr[3],C1,0,0,0),   P1[14],P1[15],0.f,0.f,       pw3[2]=PKW(P1,12),pw3[3]=PKW(P1,14), pw3); \
    l_reg+=sacc; \
    if(GK){DMA_K((t)+3,sl_cur);} if(GV){DMA_V((t)+1,sl_next);} \
    TBADD(C0,C1,t); CMASK(C0,C1,t); \
    { float a=MX3(C0[0],C0[1],C1[0]),b=MX3(C0[2],C0[3],C1[1]); a=MX3(a,C1[2],C1[3]); \
      _Pragma("unroll") for(int r=4;r<16;r+=4){a=MX3(a,C0[r],C0[r+1]);b=MX3(b,C0[r+2],C0[r+3]);a=MX3(a,C1[r],C1[r+1]);b=MX3(b,C1[r+2],C1[r+3]);} \
      float rm=__builtin_fmaxf(a,b); { auto rr=__builtin_amdgcn_permlane32_swap(__float_as_uint(rm),__float_as_uint(rm),false,false); rm=__builtin_fmaxf(__uint_as_float(rr[0]),__uint_as_float(rr[1])); } \
      resc=false; \
      if(__builtin_expect(__any(rm>(float)THRL),0)){ const float dl=__builtin_fmaxf(rm,0.f); mhat+=dl; \
        _Pragma("unroll") for(int r=0;r<16;++r){C0[r]-=dl;C1[r]-=dl;} \
        _Pragma("unroll") for(int r=0;r<16;++r)negm[r]=-mhat; asm volatile("":"+v"(negm)); \
        const float f=__builtin_amdgcn_exp2f(-dl); l_reg*=f; if(hi==0)wsf[r32]=f; resc=true; } } \
    SBAR(); \
    GAPB(o[0]=__builtin_amdgcn_mfma_f32_32x32x16_bf16(PAF(0),VFR(0),o[0],0,0,0), C0,0); \
    GAPB(o[1]=__builtin_amdgcn_mfma_f32_32x32x16_bf16(PAF(0),VFR(4),o[1],0,0,0), C0,4); \
    KRD(GL,0); GAPB(o[0]=__builtin_amdgcn_mfma_f32_32x32x16_bf16(PAF(1),VFR(1),o[0],0,0,0), C0,8); \
    KRD(GL,1); GAPB(o[1]=__builtin_amdgcn_mfma_f32_32x32x16_bf16(PAF(1),VFR(5),o[1],0,0,0), C0,12); \
    KRD(GL,2); GAPB(o[0]=__builtin_amdgcn_mfma_f32_32x32x16_bf16(PAF(2),VFR(2),o[0],0,0,0), C1,0); \
    KRD(GL,3); GAPB(o[1]=__builtin_amdgcn_mfma_f32_32x32x16_bf16(PAF(2),VFR(6),o[1],0,0,0), C1,4); \
    GAPB(o[0]=__builtin_amdgcn_mfma_f32_32x32x16_bf16(PAF(3),VFR(3),o[0],0,0,0), C1,8); \
    GAPB(o[1]=__builtin_amdgcn_mfma_f32_32x32x16_bf16(PAF(3),VFR(7),o[1],0,0,0), C1,12); \
    }while(0)
  int t=1;
  #undef CMASK
  #define CMASK(P0,P1,t) do{}while(0)
  for(;t+5<NT;t+=2){
    STEP(pB0,pB1,pA0,pA1,t,true,true,true);     WAIT_BAR(2); RESC(); ROT();
    STEP(pA0,pA1,pB0,pB1,t+1,true,true,true);   WAIT_BAR(2); RESC(); ROT();
  }
  #undef CMASK
  #define CMASK(P0,P1,t) do{int jb_=(t)-(NT-4); if(jb_>=0)cmask(P0,P1,jb_,qrel,hi);}while(0)
  #define ENDW(tt) do{ if((tt)+3<NT){WAIT_BAR(2);} else if((tt)+2<NT){WAIT_BAR(1);} else {WAIT_BAR(0);} }while(0)
  for(;t+1<NT;t+=2){
    STEP(pB0,pB1,pA0,pA1,t,(t+3<NT),(t+1<NT),(t+1<NT));       ENDW(t);   RESC(); ROT();
    STEP(pA0,pA1,pB0,pB1,t+1,(t+4<NT),(t+2<NT),(t+2<NT));     ENDW(t+1); RESC(); ROT();
  }
  STEP(pB0,pB1,pA0,pA1,NT-1,false,false,false); RESC();
  { float sacc=pB0[0]+pB0[1]; _Pragma("unroll") for(int r=2;r<16;++r)sacc+=pB0[r]; _Pragma("unroll") for(int r=0;r<16;++r)sacc+=pB1[r]; l_reg+=sacc;
    pw0=(u32x4){PKW(pB0,0),PKW(pB0,2),PKW(pB0,4),PKW(pB0,6)};pw1=(u32x4){PKW(pB0,8),PKW(pB0,10),PKW(pB0,12),PKW(pB0,14)};pw2=(u32x4){PKW(pB1,0),PKW(pB1,2),PKW(pB1,4),PKW(pB1,6)};pw3=(u32x4){PKW(pB1,8),PKW(pB1,10),PKW(pB1,12),PKW(pB1,14)};
    SBAR(); pv(o,vb0+sl_cur,PAF(0),PAF(1),PAF(2),PAF(3)); }
  #undef PKW
  #undef PAF
  #undef VFR
  #undef PIN
  #undef MX3
  #undef GAPA
  #undef GAPB
  #undef EX
  #undef VRD
  #undef KRD
  #undef STEP
  #undef ENDW
  {auto rr=__builtin_amdgcn_permlane32_swap(__float_as_uint(l_reg),__float_as_uint(l_reg),false,false);l_reg=__uint_as_float(rr[0])+__uint_as_float(rr[1]);}
  if(hi==0)wsf[32+r32]=l_reg;asm volatile("s_waitcnt lgkmcnt(0)":::"memory");
  float rli[16];
  #pragma unroll
  for(int r=0;r<16;++r)rli[r]=__builtin_amdgcn_rcpf(wsf[32+crow(r,hi)]);
  bf16*Ow=O+(rowbase+q0+wid*QBLK)*DM+h*D;
  { bf16*stg=(bf16*)(shm+LDS_OST)+wid*2048;
    #pragma unroll
    for(int r=0;r<16;++r){const int orow=crow(r,hi);
      #pragma unroll
      for(int d0=0;d0<2;++d0)stg[orow*64+d0*32+r32]=__float2bfloat16(o[d0][r]*rli[r]);}
    asm volatile("s_waitcnt lgkmcnt(0)":::"memory");
    #pragma unroll
    for(int i=0;i<4;++i){const int row=i*8+(lane>>3),ch=lane&7; const u32x4 v=*(const u32x4*)(stg+row*64+ch*8); ATTN_STORE16(Ow+(long)row*DM+ch*8,v);} }
  asm volatile("s_waitcnt lgkmcnt(0)\n\ts_barrier":::"memory");
  #undef TBADD
  #undef DMA_K
  #undef DMA_V
  #undef CMASK
  #undef START
  #undef RESC
  #undef ROT
}
constexpr int ATTN_LDS_BYTES=LDS_BYTES;
struct AttnTensors { const bf16* Q; const bf16* K; const bf16* V; bf16* O; };
struct AttnUnit { int bh; int qb; };
#undef SBAR
#undef WAIT_BAR
}
constexpr int NWAVES = 8;
constexpr int DM = 1024, MP = 16384, MS = 512, MT = MP + MS;
constexpr int SEQ = 4096, NB = 4, DB = 128, DT = 4;
constexpr int DIN = 5648, NIN = 5632, DFF = 2816, NGU = 5632, PLE = 256;
constexpr int HM_ = 4, DKM = 128, HF = 8, DHF = 64, WM = 512, WF = 512;
constexpr int PAST = 2048, PAGE = 128, NPAGES = 16;
constexpr float EPS = 1e-6f;
constexpr float LOG2E = 1.4426950408889634f;
constexpr float C2Q = 0.125f * LOG2E;
constexpr size_t O_YP = 0, O_YS = (size_t)MP * DM, O_KP = O_YS + (size_t)MS * DM, O_VP = O_KP + (size_t)MP * 512, O_LFP = O_VP + (size_t)MP * 512,
    O_CP = O_LFP + (size_t)MP * 8, O_NP = O_CP + (size_t)NB * HM_ * 128 * 128, O_MPR = O_NP + (size_t)NB * HM_ * 128, O_KS = O_MPR + NB * HM_,
    O_VS = O_KS + (size_t)MS * 512, O_LFS = O_VS + (size_t)MS * 512, O_CS = O_LFS + (size_t)MS * 8, O_NS = O_CS + (size_t)DB * HM_ * 128 * 128,
    O_MS = O_NS + (size_t)DB * HM_ * 128, O_END = O_MS + (size_t)DB * HM_;
static_assert(O_END == 43457040, "d_out size");
constexpr size_t MiB = 1u << 20;
constexpr size_t WS_CTL = 0, CTL_ZERO_BYTES = 1 * MiB;
constexpr size_t WS_WIN = 2 * MiB, WS_WGU = 13 * MiB, WS_WDN = 24 * MiB, WS_WOUT = 30 * MiB, WS_WPG = 32 * MiB, WS_WPA = 34 * MiB, WS_WPB = 35 * MiB, WS_WPP = 36 * MiB;
constexpr size_t WS_GATES = 38 * MiB, WS_SSQ2 = 40 * MiB, WS_SSQ3 = 42 * MiB, WS_MISC = 44 * MiB;
constexpr size_t WS_XN = 64 * MiB, WS_PB = 98 * MiB, WS_MQ = 108 * MiB, WS_MK = 125 * MiB, WS_MV = 142 * MiB, WS_MO = 159 * MiB, WS_FQ = 176 * MiB, WS_FK = 193 * MiB, WS_FV = 210 * MiB,
    WS_HM = 227 * MiB, WS_YF = 244 * MiB, WS_GA = 262 * MiB, WS_GB = 296 * MiB, WS_U = 330 * MiB, WS_X1 = 364 * MiB, WS_A2 = 431 * MiB, WS_HB = 465 * MiB, WS_A3 = 557 * MiB, WS_TP = 591 * MiB,
    WS_LT = 625 * MiB, WS_CT = 658 * MiB, WS_END = 680 * MiB;
constexpr size_t MI_CHS = 0;
constexpr size_t MI_MC = 8192;
constexpr size_t MI_NL = 16384;
constexpr size_t MI_NC = MI_NL + 512 * 128 * 4;
constexpr size_t MI_DEC = 1 * MiB;
constexpr int CW_TMO = 0, CW_CODE = 1, CW_BAR = 4096;

constexpr int RING_OFF = 0, RING_BYTES = 131072;
constexpr int LDSCTL_OFF = RING_BYTES, MISC_OFF = LDSCTL_OFF + 320;
constexpr int LDS_BYTES = 147456;
#define GAS __attribute__((address_space(1)))
#define LAS __attribute__((address_space(3)))
typedef unsigned short bf16;
typedef unsigned v4u __attribute__((ext_vector_type(4)));
typedef float f32x4 __attribute__((ext_vector_type(4)));
typedef short bf16x8 __attribute__((ext_vector_type(8)));
typedef GAS unsigned gu32;
typedef GAS unsigned long long gu64;
#define RLX_AGENT __ATOMIC_RELAXED, __HIP_MEMORY_SCOPE_AGENT
#define LDS_WAIT() asm volatile("s_waitcnt lgkmcnt(0)" ::: "memory")
#define VM_WAIT() asm volatile("s_waitcnt vmcnt(0)" ::: "memory")
__device__ __forceinline__ unsigned long long rt() { return __builtin_amdgcn_s_memrealtime(); }
__device__ __forceinline__ unsigned f2bf(float f) { unsigned u = __builtin_bit_cast(unsigned, f); return (u + 0x7fffu + ((u >> 16) & 1u)) >> 16; }
__device__ __forceinline__ unsigned pk2(float lo, float hi) { return f2bf(lo) | (f2bf(hi) << 16); }

#define XB_TMO      128
#define XB_XCNT(j)  (256  + 64 * (j))
#define XB_XSUB(j)  (1280 + 64 * (j))
#define XB_XGEN(j)  (2304 + 64 * (j))
#define XB_TOP      3328
#define XB_TOPGEN   3392
#define XCD_BAR_WORDS 3456
#define XB_SPIN_CAP (1u << 18)

__device__ __forceinline__ unsigned xb_ld(unsigned* p)              { return __hip_atomic_load(p, __ATOMIC_RELAXED, __HIP_MEMORY_SCOPE_AGENT); }
__device__ __forceinline__ unsigned xb_add(unsigned* p, unsigned v) { return __hip_atomic_fetch_add(p, v, __ATOMIC_RELAXED, __HIP_MEMORY_SCOPE_AGENT); }
__device__ __forceinline__ unsigned xb_xcc_id() { return (unsigned)__builtin_amdgcn_s_getreg((3 << 11) | 20) & 0xFu; }
#define XB_SPIN(cond, bar) do { unsigned _sp = 0; while (cond) { __builtin_amdgcn_s_sleep(1); \
    if ((++_sp & 255u) == 0u) { if (xb_ld(&(bar)[XB_TMO])) break; if (_sp > XB_SPIN_CAP) { atomicAdd(&(bar)[XB_TMO], 1u); break; } } } } while (0)

struct XcdBarrier {
    unsigned* bar; unsigned x;
    volatile LAS unsigned* st;
};

__device__ __forceinline__ XcdBarrier xcd_barrier_post(unsigned* bar, volatile LAS unsigned* st) {
    XcdBarrier b; b.bar = bar; b.x = xb_xcc_id(); b.st = st;
    if (threadIdx.x == 0) (void)xb_add(&bar[XB_XCNT(b.x)], 1u);
    return b;
}
__device__ __forceinline__ void xcd_barrier_complete(unsigned* bar, unsigned x, unsigned& nloc, unsigned& nx) {
    const unsigned G = gridDim.x * gridDim.y * gridDim.z;
    unsigned sum, cnt, mine, sp = 0u;
    for (;;) {
        sum = 0u; cnt = 0u; mine = 0u;
#pragma unroll
        for (unsigned j = 0; j < 16; ++j) { const unsigned c = xb_ld(&bar[XB_XCNT(j)]); sum += c; cnt += (c > 0u) ? 1u : 0u; mine = (j == x) ? c : mine; }
        if (sum == G) break;
        __builtin_amdgcn_s_sleep(1);
        if ((++sp & 255u) == 0u) { if (xb_ld(&bar[XB_TMO])) break; if (sp > XB_SPIN_CAP) { atomicAdd(&bar[XB_TMO], 1u); break; } }
    }
    nloc = mine > 0u ? mine : 1u; nx = cnt > 0u ? cnt : 1u;
}

__device__ __forceinline__ void xcd_barrier(const XcdBarrier& b) {
    asm volatile("s_waitcnt vmcnt(0)" ::: "memory");
    __syncthreads();
    if (threadIdx.x == 0) {
        unsigned* bar = b.bar;
        __builtin_amdgcn_s_waitcnt(0);
        unsigned nloc = b.st[0], nx = b.st[1];
        if (nloc == 0u) { xcd_barrier_complete(bar, b.x, nloc, nx); b.st[0] = nloc; b.st[1] = nx; }
        const unsigned old = xb_add(&bar[XB_XSUB(b.x)], 1u);
        const unsigned gen = old / nloc;
        if (old + 1u == (gen + 1u) * nloc) {
            __builtin_amdgcn_fence(__ATOMIC_RELEASE, "agent");
            asm volatile("s_waitcnt vmcnt(0)" ::: "memory");
            const unsigned og = xb_add(&bar[XB_TOP], 1u);
            const unsigned tg = og / nx;
            if (og + 1u == (tg + 1u) * nx) xb_add(&bar[XB_TOPGEN], 1u);
            else XB_SPIN(xb_ld(&bar[XB_TOPGEN]) == tg, bar);
            __builtin_amdgcn_fence(__ATOMIC_ACQUIRE, "agent");
            xb_add(&bar[XB_XGEN(b.x)], 1u);
            asm volatile("s_waitcnt vmcnt(0)" ::: "memory");
        } else {
            XB_SPIN(xb_ld(&bar[XB_XGEN(b.x)]) == gen, bar);
            __builtin_amdgcn_fence(__ATOMIC_ACQUIRE, "agent");
            asm volatile("s_waitcnt vmcnt(0)" ::: "memory");
        }
    }
    __syncthreads();
}
struct Frame {
    LAS unsigned char* lds;
    volatile LAS unsigned* MISC;
    gu32* ctl;
    int vcu, G;
    float* out; unsigned char* ws;
};
struct Args { const void* in[28]; float* out; unsigned char* ws; int ph_lo, ph_hi; };
#define IN_F(k) ((const float*)A.in[k])
#define I_XP IN_F(0)
#define I_XS IN_F(1)
#define I_PP IN_F(2)
#define I_PS IN_F(3)
#define I_CK IN_F(4)
#define I_CV IN_F(5)
#define I_CLF IN_F(6)
#define I_SC IN_F(7)
#define I_SN IN_F(8)
#define I_SM IN_F(9)
#define I_PT ((const int*)A.in[10])
#define I_GMIX IN_F(11)
#define I_WIN IN_F(12)
#define I_BMI IN_F(13)
#define I_BMF IN_F(14)
#define I_BFF IN_F(15)
#define I_GMH IN_F(16)
#define I_GQN IN_F(17)
#define I_GKN IN_F(18)
#define I_WPA IN_F(19)
#define I_WPB IN_F(20)
#define I_WOUT IN_F(21)
#define I_GFFN IN_F(22)
#define I_WGU IN_F(23)
#define I_WDN IN_F(24)
#define I_GPLE IN_F(25)
#define I_WPG IN_F(26)
#define I_WPP IN_F(27)
__device__ __forceinline__ float wave_sum(float v) {
#pragma unroll
    for (int o = 1; o < 64; o <<= 1) v += __shfl_xor(v, o);
    return v;
}
__device__ __forceinline__ float dot4f(f32x4 a) { return (a[0] * a[0] + a[1] * a[1]) + (a[2] * a[2] + a[3] * a[3]); }
__device__ __forceinline__ float logsig(float x) { return fminf(x, 0.f) - log1pf(expf(-fabsf(x))); }
__device__ __forceinline__ void p0_transpose_item(const float* W, int ldw, int K, bf16* WT, int src_col0, int dst_row0, int k0, LAS float* scr, int lane) {
#pragma unroll 8
    for (int i = 0; i < 32; ++i) { const int kk = 2 * i + (lane >> 5); scr[kk * 33 + (lane & 31)] = W[(size_t)(k0 + kk) * ldw + src_col0 + (lane & 31)]; }
    LDS_WAIT(); asm volatile("" ::: "memory");
    const int c = lane & 7;
#pragma unroll
    for (int j = 0; j < 4; ++j) { const int n = (lane >> 3) + 8 * j; const LAS float* s = scr + (8 * c) * 33 + n;
        v4u o; o.x = pk2(s[0 * 33], s[1 * 33]); o.y = pk2(s[2 * 33], s[3 * 33]); o.z = pk2(s[4 * 33], s[5 * 33]); o.w = pk2(s[6 * 33], s[7 * 33]);
        *(GAS v4u*)(WT + (size_t)(dst_row0 + n) * K + k0 + 8 * c) = o; }
    LDS_WAIT(); asm volatile("" ::: "memory");
}
__device__ __forceinline__ int hperm(int f) { return 256 * (f >> 8) + 128 * ((f & 63) >> 5) + 32 * ((f & 255) >> 6) + (f & 31); }
__device__ __forceinline__ const float* xrow_ptr(const Args& A, int r) { return r < MP ? I_XP + (size_t)r * DM : I_XS + (size_t)(r - MP) * DM; }

__device__ __forceinline__ void p0_prologue(Frame& F, const Args& A) {
    int tid_ = threadIdx.x; asm volatile("" : "+v"(tid_)); const int tid = tid_, lane = tid & 63, wave = __builtin_amdgcn_readfirstlane(tid >> 6);
    LAS float* scr = (LAS float*)(F.lds + RING_OFF + wave * 16384);
    const int gw = F.vcu * NWAVES + wave, NGW = F.G * NWAVES;
    bf16* WIN = (bf16*)(F.ws + WS_WIN); bf16* WGU = (bf16*)(F.ws + WS_WGU); bf16* WDN = (bf16*)(F.ws + WS_WDN); bf16* WOUT = (bf16*)(F.ws + WS_WOUT);
    bf16* WPG = (bf16*)(F.ws + WS_WPG); bf16* WPA = (bf16*)(F.ws + WS_WPA); bf16* WPB = (bf16*)(F.ws + WS_WPB); bf16* WPP = (bf16*)(F.ws + WS_WPP);
    constexpr int NI_IN = 176 * 16, NI_GU = 176 * 16, NI_DN = 32 * 44, NI_OUT = 32 * 16, NI_PG = 32 * 16, NI_PA = 32 * 8, NI_PB = 32 * 8, NI_PP = 32 * 4;
    constexpr int NITEMS = NI_IN + NI_GU + NI_DN + NI_OUT + NI_PG + NI_PA + NI_PB + NI_PP;
    for (int it = gw; it < NITEMS; it += NGW) {
        int r = it;
        if (r < NI_IN) { const int blk = r >> 4, kb = r & 15; int src, dst;
            if (blk < 64) { src = 32 * blk; dst = 32 * blk; }
            else if (blk < 80) { const int f = 32 * (blk - 64); src = 2056 + f; dst = 2048 + hperm(f); }
            else if (blk < 96) { const int f = 32 * (blk - 80); src = 2568 + f; dst = 2560 + hperm(f); }
            else if (blk < 112) { const int f = 32 * (blk - 96); src = 3080 + f; dst = 3072 + f; }
            else { const int f = 32 * (blk - 112); src = 3600 + f; dst = 3584 + f; }
            p0_transpose_item(I_WIN, DIN, DM, WIN, src, dst, 64 * kb, scr, lane); continue; } r -= NI_IN;
        if (r < NI_GU) { const int db = r >> 4, kb = r & 15; const int pn = db >> 3, q = db & 7, bj = q >> 2, wc = q & 3;
            p0_transpose_item(I_WGU, NGU, DM, WGU, bj * DFF + 128 * pn + 32 * wc, 32 * db, 64 * kb, scr, lane); continue; } r -= NI_GU;
        if (r < NI_DN) { const int blk = r / 44, kb = r % 44; p0_transpose_item(I_WDN, DM, DFF, WDN, 32 * blk, 32 * blk, 64 * kb, scr, lane); continue; } r -= NI_DN;
        if (r < NI_OUT) { p0_transpose_item(I_WOUT, DM, DM, WOUT, 32 * (r >> 4), 32 * (r >> 4), 64 * (r & 15), scr, lane); continue; } r -= NI_OUT;
        if (r < NI_PG) { p0_transpose_item(I_WPG, DM, DM, WPG, 32 * (r >> 4), 32 * (r >> 4), 64 * (r & 15), scr, lane); continue; } r -= NI_PG;
        if (r < NI_PA) { p0_transpose_item(I_WPA, DM, WM, WPA, 32 * (r >> 3), 32 * (r >> 3), 64 * (r & 7), scr, lane); continue; } r -= NI_PA;
        if (r < NI_PB) { p0_transpose_item(I_WPB, DM, WF, WPB, 32 * (r >> 3), 32 * (r >> 3), 64 * (r & 7), scr, lane); continue; } r -= NI_PB;
        p0_transpose_item(I_WPP, DM, PLE, WPP, 32 * (r >> 2), 32 * (r >> 2), 64 * (r & 3), scr, lane);
    }
    { bf16* PB = (bf16*)(F.ws + WS_PB); const int gt = F.vcu * (NWAVES * 64) + tid, NGT = F.G * NWAVES * 64;
      for (int i = gt; i < MT * PLE / 4; i += NGT) { const int e = i * 4; const float* src = e < MP * PLE ? I_PP + e : I_PS + (e - MP * PLE);
          const f32x4 v = *(const GAS f32x4*)src; *(GAS unsigned long long*)(PB + e) = (unsigned long long)pk2(v.x, v.y) | ((unsigned long long)pk2(v.z, v.w) << 32); } }
    __syncthreads();
    LAS float* wg = (LAS float*)(F.lds + RING_OFF);
    for (int i = tid; i < DM * 16; i += NWAVES * 64) { const int k = i >> 4, c = i & 15; const int src = c < 8 ? 2048 + c : 3592 + (c - 8);
        wg[16 * k + 4 * ((k >> 2) & 15) + 64 * (k >> 6) + c] = I_WIN[(size_t)k * DIN + src]; }
    __syncthreads();
    {
        bf16* XN = (bf16*)(F.ws + WS_XN); float* GT = (float*)(F.ws + WS_GATES);
        const LAS float* wl = wg + 64 * lane + 64 * (lane >> 4) + 4 * (lane & 15);
        for (int pr = gw; pr < MT / 2; pr += NGW) {
            const int r0 = 2 * pr; const GAS f32x4* xa = (const GAS f32x4*)xrow_ptr(A, r0) + lane; const GAS f32x4* xb = (const GAS f32x4*)xrow_ptr(A, r0 + 1) + lane;
            float sa = 0.f, sb = 0.f;
#pragma unroll
            for (int j = 0; j < 4; ++j) { const f32x4 ta = xa[64 * j], tb = xb[64 * j]; sa += dot4f(ta); sb += dot4f(tb); }
            const float ra = rsqrtf(wave_sum(sa) * (1.f / DM) + EPS), rb = rsqrtf(wave_sum(sb) * (1.f / DM) + EPS);
            GAS unsigned long long* oa = (GAS unsigned long long*)(XN + (size_t)r0 * DM) + lane; GAS unsigned long long* ob = (GAS unsigned long long*)(XN + (size_t)(r0 + 1) * DM) + lane;
            float v[32];
#pragma unroll
            for (int c = 0; c < 32; ++c) v[c] = 0.f;
#pragma unroll 1
            for (int j = 0; j < 4; ++j) { const f32x4 gmj = ((const GAS f32x4*)I_GMIX)[64 * j + lane];
                const f32x4 va = xa[64 * j] * ra * gmj, vb = xb[64 * j] * rb * gmj;
                oa[64 * j] = (unsigned long long)pk2(va.x, va.y) | ((unsigned long long)pk2(va.z, va.w) << 32);
                ob[64 * j] = (unsigned long long)pk2(vb.x, vb.y) | ((unsigned long long)pk2(vb.z, vb.w) << 32);
#pragma unroll
                for (int e = 0; e < 4; ++e) { const LAS f32x4* wp = (const LAS f32x4*)(wl + 4352 * j + 16 * e); const float a = va[e], b = vb[e];
#pragma unroll
                    for (int q = 0; q < 4; ++q) { const f32x4 w = wp[q];
#pragma unroll
                        for (int t = 0; t < 4; ++t) { v[4 * q + t] += a * w[t]; v[16 + 4 * q + t] += b * w[t]; } } } }
#pragma unroll
            for (int i = 0; i < 16; ++i) { const bool up = (lane & 32) != 0; const float keep = up ? v[16 + i] : v[i], send = up ? v[i] : v[16 + i]; v[i] = keep + __shfl_xor(send, 32); }
#pragma unroll
            for (int i = 0; i < 8; ++i) { const bool up = (lane & 16) != 0; const float keep = up ? v[8 + i] : v[i], send = up ? v[i] : v[8 + i]; v[i] = keep + __shfl_xor(send, 16); }
#pragma unroll
            for (int i = 0; i < 4; ++i) { const bool up = (lane & 8) != 0; const float keep = up ? v[4 + i] : v[i], send = up ? v[i] : v[4 + i]; v[i] = keep + __shfl_xor(send, 8); }
#pragma unroll
            for (int i = 0; i < 2; ++i) { const bool up = (lane & 4) != 0; const float keep = up ? v[2 + i] : v[i], send = up ? v[i] : v[2 + i]; v[i] = keep + __shfl_xor(send, 4); }
            { const bool up = (lane & 2) != 0; const float keep = up ? v[1] : v[0], send = up ? v[0] : v[1]; v[0] = keep + __shfl_xor(send, 2); }
            v[0] += __shfl_xor(v[0], 1);
            if ((lane & 1) == 0) { const int row = r0 + (lane >> 5), c = (lane >> 1) & 15; float z = v[0], val;
                if (c < 4) val = z + I_BMI[c]; else if (c < 8) val = logsig(z + I_BMF[c - 4]); else { val = logsig(z + I_BFF[c - 8]);
                    if (row < MP) F.out[O_LFP + (size_t)row * 8 + (c - 8)] = val; else F.out[O_LFS + (size_t)(row - MP) * 8 + (c - 8)] = val; }
                GT[(size_t)row * 16 + c] = val; }
        }
    }
}
typedef short s16x4v __attribute__((ext_vector_type(4)));
typedef short v4i16_t __attribute__((ext_vector_type(4)));
__device__ __forceinline__ s16x4v tr4(const LAS unsigned char* p) { return __builtin_bit_cast(s16x4v, __builtin_amdgcn_ds_read_tr16_b64_v4i16((LAS v4i16_t*)p)); }
__device__ __forceinline__ bf16x8 join8(s16x4v lo, s16x4v hi) { return (bf16x8){lo[0], lo[1], lo[2], lo[3], hi[0], hi[1], hi[2], hi[3]}; }
#define MFMA16(X, Y, C) __builtin_amdgcn_mfma_f32_16x16x32_bf16(X, Y, C, 0, 0, 0)
__device__ __forceinline__ float bflo(unsigned u) { return __uint_as_float(u << 16); }
__device__ __forceinline__ float bfhi(unsigned u) { return __uint_as_float(u & 0xffff0000u); }
__device__ __forceinline__ float bf2f(bf16 v) { return __uint_as_float(((unsigned)v) << 16); }
constexpr int TP_ = 272;

__device__ __forceinline__ void chunk_scan(const float* GT  , int h, int tid, int lane, int wave, LAS float* sc, float& bj, float& gj, float& gpre, float& G, float& bend) {
    float lf = 0.f, ig = 0.f;
    if (tid < 128) { lf = GT[(size_t)tid * 16 + 4 + h]; ig = GT[(size_t)tid * 16 + h]; }
    float s = lf;
#pragma unroll
    for (int o = 1; o < 64; o <<= 1) { const float t = __shfl_up(s, o); if (lane >= o) s += t; }
    if (tid < 128 && lane == 63) sc[wave] = s;
    __syncthreads();
    if (wave == 1) s += sc[0];
    bj = s; gj = ig - bj;
    float pm = gj;
#pragma unroll
    for (int o = 1; o < 64; o <<= 1) { const float t = __shfl_up(pm, o); if (lane >= o) pm = fmaxf(pm, t); }
    if (tid < 128 && lane == 63) sc[2 + wave] = pm;
    if (tid == 127) sc[4] = s;
    __syncthreads();
    if (wave == 1) pm = fmaxf(pm, sc[2]);
    gpre = pm; G = fmaxf(sc[2], sc[3]); bend = sc[4];
}
__device__ __forceinline__ void stage_kv(const bf16* MKp, const bf16* MVp, LAS unsigned char* KT, LAS unsigned char* VT, const LAS float* wkl, int tid) {
#pragma unroll
    for (int i = 0; i < 4; ++i) { const int s = (tid >> 4) + 32 * i, c16 = tid & 15;
        const v4u kv = *(const GAS v4u*)(MKp + (size_t)s * 512 + 8 * c16); const v4u vv = *(const GAS v4u*)(MVp + (size_t)s * 512 + 8 * c16); const float w = wkl[s];
        v4u o; o.x = pk2(bflo(kv.x) * w, bfhi(kv.x) * w); o.y = pk2(bflo(kv.y) * w, bfhi(kv.y) * w); o.z = pk2(bflo(kv.z) * w, bfhi(kv.z) * w); o.w = pk2(bflo(kv.w) * w, bfhi(kv.w) * w);
        *(LAS v4u*)(KT + s * TP_ + c16 * 16) = o; *(LAS v4u*)(VT + s * TP_ + c16 * 16) = vv; }
}
__device__ __forceinline__ void mlstm_a_unit(unsigned char* ws, LAS unsigned char* lds, int u, int tid, int lane, int wave) {
    const int bh = u >> 5, c = u & 31, b = bh >> 2, h = bh & 3; const int r0 = b * SEQ + c * 128;
    LAS unsigned char* KT = lds; LAS unsigned char* VT = lds + 128 * TP_; LAS float* wkl = (LAS float*)(lds + 2 * 128 * TP_); LAS float* sc = wkl + 128;
    float bj, gj, gpre, G, bend; chunk_scan((const float*)(ws + WS_GATES) + (size_t)r0 * 16, h, tid, lane, wave, sc, bj, gj, gpre, G, bend);
    if (tid < 128) wkl[tid] = expf(gj - G);
    if (tid == 0) { float* chs = (float*)(ws + WS_MISC + MI_CHS) + u * 2; chs[0] = G; chs[1] = bend; }
    __syncthreads();
    stage_kv((const bf16*)(ws + WS_MK) + (size_t)r0 * 512 + h * 128, (const bf16*)(ws + WS_MV) + (size_t)r0 * 512 + h * 128, KT, VT, wkl, tid);
    __syncthreads();
    const int fr = lane & 15, fq = lane >> 4, q4 = (lane & 15) >> 2, p4 = lane & 3;
    f32x4 acc[8], accn = (f32x4){0.f, 0.f, 0.f, 0.f};
#pragma unroll
    for (int i = 0; i < 8; ++i) acc[i] = (f32x4){0.f, 0.f, 0.f, 0.f};
    const short one = fr == 0 ? (short)0x3F80 : (short)0; const bf16x8 ones = (bf16x8){one, one, one, one, one, one, one, one};
#pragma unroll
    for (int ks = 0; ks < 4; ++ks) { const int row = 32 * ks + 8 * fq + q4;
        const bf16x8 Y = join8(tr4(VT + row * TP_ + (16 * wave + 4 * p4) * 2), tr4(VT + (row + 4) * TP_ + (16 * wave + 4 * p4) * 2));
#pragma unroll
        for (int di = 0; di < 8; ++di) { const bf16x8 X = join8(tr4(KT + row * TP_ + (16 * di + 4 * p4) * 2), tr4(KT + (row + 4) * TP_ + (16 * di + 4 * p4) * 2));
            acc[di] = MFMA16(X, Y, acc[di]); if (di == wave) accn = MFMA16(X, ones, accn); } }
    float* LT = (float*)(ws + WS_LT) + (size_t)u * 16384;
#pragma unroll
    for (int di = 0; di < 8; ++di) *(GAS f32x4*)(LT + (16 * wave + fr) * 128 + 16 * di + 4 * fq) = acc[di];
    if (fr == 0) *(GAS f32x4*)((float*)(ws + WS_MISC + MI_NL) + (size_t)u * 128 + 16 * wave + 4 * fq) = accn;
    __syncthreads();
}
__device__ __forceinline__ void mlstm_b(unsigned char* ws, float* out, LAS unsigned char* lds, int vcu, int Gn, int tid) {
    const float* LTb = (const float*)(ws + WS_LT); bf16* CTb = (bf16*)(ws + WS_CT); const float* NL = (const float*)(ws + WS_MISC + MI_NL); float* NC = (float*)(ws + WS_MISC + MI_NC);
    for (int it = vcu; it < 256; it += Gn) { const int bh = it >> 4, part = it & 15;
        LAS float* decl = (LAS float*)lds; LAS float* fl = decl + 32;
        if (tid == 0) { float m = 0.f; const float* chs = (const float*)(ws + WS_MISC + MI_CHS) + (size_t)bh * 64; float* mc = (float*)(ws + WS_MISC + MI_MC) + bh * 33;
            for (int c = 0; c < 32; ++c) { const float Gc = chs[2 * c], be = chs[2 * c + 1], Mx = fmaxf(m, Gc); decl[c] = expf(m - Mx); fl[c] = expf(Gc - Mx); if (part == 0) mc[c] = m; m = be + Mx; }
            if (part == 0) { mc[32] = m; out[O_MPR + bh] = m; } }
        __syncthreads();
#pragma unroll 1
        for (int e2 = 0; e2 < 2; ++e2) { const int idx = part * 1024 + e2 * 512 + tid; float Cs = 0.f; const float* lt = LTb + (size_t)bh * 32 * 16384 + idx; bf16* ct = CTb + (size_t)bh * 32 * 16384 + idx;
#pragma unroll 8
            for (int c = 0; c < 32; ++c) { ct[(size_t)c * 16384] = (bf16)f2bf(Cs); Cs = decl[c] * Cs + fl[c] * lt[(size_t)c * 16384]; }
            const int e = idx >> 7, d = idx & 127; out[O_CP + (size_t)bh * 16384 + d * 128 + e] = Cs; }
        if (part == 0 && tid < 128) { float ns = 0.f;
            for (int c = 0; c < 32; ++c) { NC[(size_t)(bh * 32 + c) * 128 + tid] = ns; ns = decl[c] * ns + fl[c] * NL[(size_t)(bh * 32 + c) * 128 + tid]; }
            out[O_NP + bh * 128 + tid] = ns; }
        __syncthreads();
    }
}
__device__ __forceinline__ void mlstm_c_unit(const Args& A, unsigned char* ws, LAS unsigned char* lds, int u, int tid, int lane, int wave) {
    const int bh = u >> 5, c = u & 31, b = bh >> 2, h = bh & 3; const int r0 = b * SEQ + c * 128;
    LAS unsigned char* KT = lds; LAS unsigned char* VT = lds + 128 * TP_; LAS unsigned char* CTt = lds + 2 * 128 * TP_;
    LAS float* wkl = (LAS float*)(lds + (2 * 128 + 144) * TP_); LAS float* rjl = wkl + 128; LAS float* wil = rjl + 128; LAS float* eml = wil + 128; LAS float* sc = eml + 128;
    float bj, gj, gpre, G, bend; chunk_scan((const float*)(ws + WS_GATES) + (size_t)r0 * 16, h, tid, lane, wave, sc, bj, gj, gpre, G, bend);
    const float mc = ((const float*)(ws + WS_MISC + MI_MC))[bh * 33 + c];
    if (tid < 128) { const float Mj = fmaxf(mc, gpre); wkl[tid] = expf(gj - G); rjl[tid] = expf(G - Mj); wil[tid] = expf(mc - Mj); eml[tid] = expf(-(bj + Mj)); }
    __syncthreads();
    stage_kv((const bf16*)(ws + WS_MK) + (size_t)r0 * 512 + h * 128, (const bf16*)(ws + WS_MV) + (size_t)r0 * 512 + h * 128, KT, VT, wkl, tid);
    { const bf16* CTg = (const bf16*)(ws + WS_CT) + (size_t)u * 16384;
#pragma unroll
      for (int i = 0; i < 4; ++i) { const int e = (tid >> 4) + 32 * i, c16 = tid & 15; *(LAS v4u*)(CTt + e * TP_ + c16 * 16) = *(const GAS v4u*)(CTg + (size_t)e * 128 + 8 * c16); }
      const float* NCg = (const float*)(ws + WS_MISC + MI_NC) + (size_t)u * 128;
      if (tid < 256) { const int rr = tid >> 4, c16 = tid & 15; v4u o = (v4u){0u, 0u, 0u, 0u};
          if (rr == 0) { const f32x4 a = *(const GAS f32x4*)(NCg + 8 * c16), bq = *(const GAS f32x4*)(NCg + 8 * c16 + 4); o.x = pk2(a.x, a.y); o.y = pk2(a.z, a.w); o.z = pk2(bq.x, bq.y); o.w = pk2(bq.z, bq.w); }
          *(LAS v4u*)(CTt + (128 + rr) * TP_ + c16 * 16) = o; } }
    const int fr = lane & 15, fq = lane >> 4, q4 = (lane & 15) >> 2, p4 = lane & 3; const int j = 16 * wave + fr;
    bf16x8 qf[4];
    { const bf16* Qg = (const bf16*)(ws + WS_MQ) + (size_t)(r0 + j) * 512 + h * 128 + 8 * fq;
#pragma unroll
      for (int kd = 0; kd < 4; ++kd) qf[kd] = *(const GAS bf16x8*)(Qg + 32 * kd); }
    __syncthreads();
    f32x4 O[9];
#pragma unroll
    for (int eb = 0; eb < 9; ++eb) { O[eb] = (f32x4){0.f, 0.f, 0.f, 0.f};
#pragma unroll
        for (int kd = 0; kd < 4; ++kd) { const bf16x8 X = *(const LAS bf16x8*)(CTt + (16 * eb + fr) * TP_ + (32 * kd + 8 * fq) * 2); O[eb] = MFMA16(X, qf[kd], O[eb]); } }
    { const float wi = wil[j];
#pragma unroll
      for (int eb = 0; eb < 9; ++eb) O[eb] *= wi; }
    f32x4 S[8]; const float rj = rjl[j];
#pragma unroll
    for (int sb = 0; sb < 8; ++sb) { S[sb] = (f32x4){0.f, 0.f, 0.f, 0.f};
        if (sb <= wave) {
#pragma unroll
            for (int kd = 0; kd < 4; ++kd) { const bf16x8 X = *(const LAS bf16x8*)(KT + (16 * sb + fr) * TP_ + (32 * kd + 8 * fq) * 2); S[sb] = MFMA16(X, qf[kd], S[sb]); }
#pragma unroll
            for (int v = 0; v < 4; ++v) S[sb][v] = (16 * sb + 4 * fq + v <= j) ? S[sb][v] * rj : 0.f; } }
    const short one = fr == 0 ? (short)0x3F80 : (short)0; const bf16x8 ones = (bf16x8){one, one, one, one, one, one, one, one};
#pragma unroll
    for (int kp = 0; kp < 4; ++kp) if (2 * kp <= wave) {
        v4u pw; pw.x = pk2(S[2 * kp][0], S[2 * kp][1]); pw.y = pk2(S[2 * kp][2], S[2 * kp][3]); pw.z = pk2(S[2 * kp + 1][0], S[2 * kp + 1][1]); pw.w = pk2(S[2 * kp + 1][2], S[2 * kp + 1][3]);
        const bf16x8 Y = __builtin_bit_cast(bf16x8, pw); const int row = 32 * kp + 4 * fq + q4;
#pragma unroll
        for (int eb = 0; eb < 8; ++eb) { const bf16x8 X = join8(tr4(VT + row * TP_ + (16 * eb + 4 * p4) * 2), tr4(VT + (row + 16) * TP_ + (16 * eb + 4 * p4) * 2)); O[eb] = MFMA16(X, Y, O[eb]); }
        O[8] = MFMA16(ones, Y, O[8]); }
    const float den = __shfl(O[8][0], fr); const float hd = 1.0f / fmaxf(fabsf(den), eml[j]);
    float ssq = 0.f;
#pragma unroll
    for (int eb = 0; eb < 8; ++eb) { O[eb] *= hd; ssq += dot4f(O[eb]); }
    ssq += __shfl_xor(ssq, 16); ssq += __shfl_xor(ssq, 32);
    const float rstd = rsqrtf(ssq * (1.0f / 128.0f) + EPS);
    const float* gmh = I_GMH + h * 128 + 4 * fq; const bf16* MOg = (const bf16*)(ws + WS_MO) + (size_t)(r0 + j) * 512 + h * 128 + 4 * fq; bf16* HMg = (bf16*)(ws + WS_HM) + (size_t)(r0 + j) * 512 + h * 128 + 4 * fq;
#pragma unroll
    for (int eb = 0; eb < 8; ++eb) { const f32x4 g = *(const GAS f32x4*)(gmh + 16 * eb); const unsigned long long mo = *(const GAS unsigned long long*)(MOg + 16 * eb); const unsigned m0 = (unsigned)mo, m1 = (unsigned)(mo >> 32);
        const f32x4 o = O[eb] * rstd * g; *(GAS unsigned long long*)(HMg + 16 * eb) = (unsigned long long)pk2(o.x * bflo(m0), o.y * bfhi(m0)) | ((unsigned long long)pk2(o.z * bflo(m1), o.w * bfhi(m1)) << 32); }
    __syncthreads();
}
__device__ __forceinline__ void mlstm_s_unit(const Args& A, unsigned char* ws, float* out, LAS unsigned char* lds, int u, int tid, int lane, int wave) {
    const int b = u >> 2, h = u & 3; const int row0 = MP + b * DT;
    LAS float* ql = (LAS float*)lds; LAS float* kl = ql + 512; LAS float* vl = kl + 512; LAS float* kwl = vl + 512; LAS float* nl = kwl + 512; LAS float* red = nl + 128;
    LAS float* Sl = red + 8192; LAS float* qnl = Sl + 16; LAS float* ws2 = qnl + 4;
    float lf[4], ig[4], bc[4], mj[4], wint[4], wl[4]; const float* GT = (const float*)(ws + WS_GATES) + (size_t)row0 * 16;
#pragma unroll
    for (int j = 0; j < 4; ++j) { ig[j] = GT[j * 16 + h]; lf[j] = GT[j * 16 + 4 + h]; }
    const float mst = I_SM[b * 4 + h];
    bc[0] = lf[0]; bc[1] = bc[0] + lf[1]; bc[2] = bc[1] + lf[2]; bc[3] = bc[2] + lf[3];
#pragma unroll
    for (int j = 0; j < 4; ++j) { float m = bc[j] + mst;
#pragma unroll
        for (int s = 0; s <= j; ++s) m = fmaxf(m, bc[j] - bc[s] + ig[s]);
        mj[j] = m; wint[j] = expf(bc[j] + mst - m); }
    const float aend = bc[3] + mst; float mnew = aend;
#pragma unroll
    for (int s = 0; s < 4; ++s) mnew = fmaxf(mnew, bc[3] - bc[s] + ig[s]);
#pragma unroll
    for (int s = 0; s < 4; ++s) wl[s] = expf(bc[3] - bc[s] + ig[s] - mnew);
    const float decay = expf(aend - mnew);
    for (int idx = tid; idx < 1536; idx += 512) { const int arr = idx >> 9, jj = (idx >> 7) & 3, d = idx & 127;
        const bf16* src = (const bf16*)(ws + (arr == 0 ? WS_MQ : arr == 1 ? WS_MK : WS_MV)); ql[idx] = bf2f(src[(size_t)(row0 + jj) * 512 + h * 128 + d]); }
    if (tid < 128) nl[tid] = I_SN[(size_t)(b * 4 + h) * 128 + tid];
    __syncthreads();
    { const int s = tid >> 7; const float w = s == 0 ? wl[0] : s == 1 ? wl[1] : s == 2 ? wl[2] : wl[3]; kwl[tid] = w * kl[tid]; }
    if (tid < 16) { const int jj = tid >> 2, s = tid & 3; float a = 0.f; for (int d = 0; d < 128; ++d) a += ql[jj * 128 + d] * kl[s * 128 + d]; Sl[tid] = a; }
    else if (tid < 20) { const int jj = tid - 16; float a = 0.f; for (int d = 0; d < 128; ++d) a += ql[jj * 128 + d] * nl[d]; qnl[jj] = a; }
    __syncthreads();
    { const int e4 = tid & 31, dg = tid >> 5; const float* Cg = I_SC + ((size_t)(b * 4 + h) * 128 + dg * 8) * 128 + 4 * e4; float* Co = out + O_CS + ((size_t)(b * 4 + h) * 128 + dg * 8) * 128 + 4 * e4;
      f32x4 part[4]; f32x4 vv[4];
#pragma unroll
      for (int s = 0; s < 4; ++s) { part[s] = (f32x4){0.f, 0.f, 0.f, 0.f}; vv[s] = *(const LAS f32x4*)(vl + s * 128 + 4 * e4); }
#pragma unroll
      for (int i = 0; i < 8; ++i) { const f32x4 cv = *(const GAS f32x4*)(Cg + (size_t)i * 128); const int d = dg * 8 + i;
          f32x4 cn = cv * decay;
#pragma unroll
          for (int s = 0; s < 4; ++s) { part[s] += cv * ql[s * 128 + d]; cn += vv[s] * kwl[s * 128 + d]; }
          *(GAS f32x4*)(Co + (size_t)i * 128) = cn; }
#pragma unroll
      for (int s = 0; s < 4; ++s) *(LAS f32x4*)(red + (dg * 4 + s) * 128 + 4 * e4) = part[s]; }
    __syncthreads();
    { const int jj = tid >> 7, e = tid & 127; float qc = 0.f;
#pragma unroll
      for (int dg = 0; dg < 16; ++dg) qc += red[(dg * 4 + jj) * 128 + e];
      const float bcj = jj == 0 ? bc[0] : jj == 1 ? bc[1] : jj == 2 ? bc[2] : bc[3], mjj = jj == 0 ? mj[0] : jj == 1 ? mj[1] : jj == 2 ? mj[2] : mj[3], wi = jj == 0 ? wint[0] : jj == 1 ? wint[1] : jj == 2 ? wint[2] : wint[3];
      float num = wi * qc, den = wi * qnl[jj];
#pragma unroll
      for (int s = 0; s < 4; ++s) if (s <= jj) { const float w = Sl[jj * 4 + s] * expf(bcj - bc[s] + ig[s] - mjj); num += w * vl[s * 128 + e]; den += w; }
      const float hv = num / fmaxf(fabsf(den), expf(-mjj));
      const float sq = wave_sum(hv * hv); if (lane == 0) ws2[wave] = sq;
      __syncthreads();
      const float rstd = rsqrtf((ws2[2 * jj] + ws2[2 * jj + 1]) * (1.0f / 128.0f) + EPS);
      const size_t oi = (size_t)(row0 + jj) * 512 + h * 128 + e;
      ((bf16*)(ws + WS_HM))[oi] = (bf16)f2bf(hv * rstd * I_GMH[h * 128 + e] * bf2f(((const bf16*)(ws + WS_MO))[oi])); }
    if (tid < 128) out[O_NS + (size_t)(b * 4 + h) * 128 + tid] = decay * nl[tid] + ((kwl[tid] + kwl[128 + tid]) + (kwl[256 + tid] + kwl[384 + tid]));
    if (tid == 0) out[O_MS + b * 4 + h] = mnew;
    __syncthreads();
}
__device__ __forceinline__ float dpp_sum16(float v) {
    v += __builtin_bit_cast(float, __builtin_amdgcn_update_dpp(0, __builtin_bit_cast(int, v), 0xB1, 0xF, 0xF, true));
    v += __builtin_bit_cast(float, __builtin_amdgcn_update_dpp(0, __builtin_bit_cast(int, v), 0x4E, 0xF, 0xF, true));
    v += __builtin_bit_cast(float, __builtin_amdgcn_update_dpp(0, __builtin_bit_cast(int, v), 0x124, 0xF, 0xF, true));
    v += __builtin_bit_cast(float, __builtin_amdgcn_update_dpp(0, __builtin_bit_cast(int, v), 0x128, 0xF, 0xF, true));
    return v;
}
constexpr int DEC_ST = 68;
__device__ __forceinline__ void fox_dec_unit(const Args& A, unsigned char* ws, float* out, LAS unsigned char* lds, int u, int tid, int lane, int wave) {
    const int b = u >> 1, half = u & 1; const int* pt = I_PT + b * NPAGES;
    LAS float* tbl = (LAS float*)lds;
    LAS float* csum = tbl + 8192; LAS float* osum = csum + 512;
    { const int hh = tid & 7, cc = tid >> 3; float lfv[16]; float s = 0.f, so = 0.f;
#pragma unroll
      for (int i = 0; i < 16; ++i) { const int tok = 16 * cc + i; const int pg = pt[half * 8 + (tok >> 7)]; lfv[i] = I_CLF[((size_t)pg * PAGE + (tok & 127)) * 8 + hh]; s += lfv[i];
          if (half == 0) { const int pg2 = pt[8 + (tok >> 7)]; so += I_CLF[((size_t)pg2 * PAGE + (tok & 127)) * 8 + hh]; } }
      csum[cc * 8 + hh] = s; osum[cc * 8 + hh] = so;
      __syncthreads();
      float off = 0.f;
      for (int c2 = cc + 1; c2 < 64; ++c2) off += csum[c2 * 8 + hh];
      if (half == 0) for (int c2 = 0; c2 < 64; ++c2) off += osum[c2 * 8 + hh];
#pragma unroll
      for (int i = 15; i >= 0; --i) { tbl[(16 * cc + i) * 8 + hh] = off * LOG2E; off += lfv[i]; } }
    __syncthreads();
    const int h = wave, slot = lane >> 4, dl = lane & 15;
    float q[4][4]; const int rowq = MP + b * DT;
#pragma unroll
    for (int t = 0; t < 4; ++t) { const unsigned long long w = *(const GAS unsigned long long*)((const bf16*)(ws + WS_FQ) + (size_t)(rowq + t) * 512 + h * 64 + 4 * dl);
        q[t][0] = bflo((unsigned)w); q[t][1] = bfhi((unsigned)w); q[t][2] = bflo((unsigned)(w >> 32)); q[t][3] = bfhi((unsigned)(w >> 32)); }
    float m[4], l[4]; f32x4 o[4];
#pragma unroll
    for (int t = 0; t < 4; ++t) { m[t] = -INFINITY; l[t] = 0.f; o[t] = (f32x4){0.f, 0.f, 0.f, 0.f}; }
#define DEC_STEP(kv_, vv_, bias_, tmax_) do { \
        _Pragma("unroll") for (int t = 0; t < 4; ++t) { float sc_ = (kv_.x * q[t][0] + kv_.y * q[t][1]) + (kv_.z * q[t][2] + kv_.w * q[t][3]); sc_ = dpp_sum16(sc_) + (bias_); if (t < (tmax_)) sc_ = -INFINITY; \
            const float mn_ = fmaxf(m[t], sc_); const float cr_ = __builtin_amdgcn_exp2f(m[t] - mn_), p_ = __builtin_amdgcn_exp2f(sc_ - mn_); \
            l[t] = l[t] * cr_ + p_; o[t] = o[t] * cr_ + vv_ * p_; m[t] = mn_; } } while (0)
#pragma unroll 1
    for (int pj = 0; pj < 8; ++pj) { const int pg = pt[half * 8 + pj];
        const float* Kp = I_CK + ((size_t)pg * PAGE * 8 + h) * 64 + 4 * dl; const float* Vp = I_CV + ((size_t)pg * PAGE * 8 + h) * 64 + 4 * dl;
#pragma unroll 1
        for (int g0 = 0; g0 < 32; g0 += 4) {
            f32x4 kk[4], vv[4];
#pragma unroll
            for (int gi = 0; gi < 4; ++gi) { const int tok = 4 * (g0 + gi) + slot; kk[gi] = __builtin_nontemporal_load((const GAS f32x4*)(Kp + (size_t)tok * 512)); vv[gi] = __builtin_nontemporal_load((const GAS f32x4*)(Vp + (size_t)tok * 512)); }
#pragma unroll
            for (int gi = 0; gi < 4; ++gi) { const int tok = 4 * (g0 + gi) + slot; const float bias = tbl[(pj * 128 + tok) * 8 + h]; DEC_STEP(kk[gi], vv[gi], bias, 0); }
        } }
    if (half == 1) {
        const float* GT = (const float*)(ws + WS_GATES) + (size_t)rowq * 16 + 8 + h; float fn = 0.f;
#pragma unroll
        for (int t2 = 0; t2 < 4; ++t2) { const float x = GT[t2 * 16]; if (t2 <= slot) fn += x; }
        const f32x4 kk = *(const GAS f32x4*)(out + O_KS + (size_t)(b * DT + slot) * 512 + h * 64 + 4 * dl), vv = *(const GAS f32x4*)(out + O_VS + (size_t)(b * DT + slot) * 512 + h * 64 + 4 * dl);
        const float bias = -fn * LOG2E;
#pragma unroll
        for (int t = 0; t < 4; ++t) { float sc_ = (kk.x * q[t][0] + kk.y * q[t][1]) + (kk.z * q[t][2] + kk.w * q[t][3]); sc_ = dpp_sum16(sc_) + bias; if (slot > t) sc_ = -INFINITY;
            const float mn_ = fmaxf(m[t], sc_); const float cr_ = __builtin_amdgcn_exp2f(m[t] - mn_), p_ = __builtin_amdgcn_exp2f(sc_ - mn_);
            l[t] = l[t] * cr_ + p_; o[t] = o[t] * cr_ + vv * p_; m[t] = mn_; }
    }
#undef DEC_STEP
#pragma unroll
    for (int t = 0; t < 4; ++t) {
#pragma unroll
        for (int sh = 16; sh <= 32; sh <<= 1) { const float m2 = __shfl_xor(m[t], sh), l2 = __shfl_xor(l[t], sh); f32x4 o2; o2.x = __shfl_xor(o[t].x, sh); o2.y = __shfl_xor(o[t].y, sh); o2.z = __shfl_xor(o[t].z, sh); o2.w = __shfl_xor(o[t].w, sh);
            const float mn = fmaxf(m[t], m2), c1 = __builtin_amdgcn_exp2f(m[t] - mn), c2 = __builtin_amdgcn_exp2f(m2 - mn); l[t] = l[t] * c1 + l2 * c2; o[t] = o[t] * c1 + o2 * c2; m[t] = mn; }
        float* rec = (float*)(ws + WS_MISC + MI_DEC) + ((size_t)((b * 2 + half) * 8 + h) * 4 + t) * DEC_ST;
        if (slot == 0) { *(GAS f32x4*)(rec + 4 * dl) = o[t]; if (dl == 0) { rec[64] = m[t]; rec[65] = l[t]; } } }
    __syncthreads();
}
__device__ __forceinline__ void fox_dec_combine(unsigned char* ws, int vcu, int Gn, int tid) {
    const float* P = (const float*)(ws + WS_MISC + MI_DEC); bf16* YF = (bf16*)(ws + WS_YF);
    for (int i = vcu * 512 + tid; i < MS * 128; i += Gn * 512) { const int row = i >> 7, c4 = i & 127, h = c4 >> 4, d = (c4 & 15) * 4, b = row >> 2, t = row & 3;
        const float* r0 = P + ((size_t)((b * 2 + 0) * 8 + h) * 4 + t) * DEC_ST; const float* r1 = P + ((size_t)((b * 2 + 1) * 8 + h) * 4 + t) * DEC_ST;
        const float m0 = r0[64], l0 = r0[65], m1 = r1[64], l1 = r1[65], mx = fmaxf(m0, m1), w0 = exp2f(m0 - mx), w1 = exp2f(m1 - mx), inv = 1.0f / (l0 * w0 + l1 * w1);
        const f32x4 a = *(const GAS f32x4*)(r0 + d), c = *(const GAS f32x4*)(r1 + d); const f32x4 o = (a * w0 + c * w1) * inv;
        *(GAS unsigned long long*)(YF + (size_t)(MP + row) * 512 + h * 64 + d) = (unsigned long long)pk2(o.x, o.y) | ((unsigned long long)pk2(o.z, o.w) << 32); }
}
__device__ __forceinline__ void fox_f2_to_lds(unsigned char* ws, LAS unsigned char* lds, int b, int h, int tid, int lane, int wave) {
    const float* GT = (const float*)(ws + WS_GATES) + ((size_t)b * SEQ) * 16 + 8 + h;
    LAS float* F2l = (LAS float*)(lds + attn_body::LDS_F2); LAS float* wsum = (LAS float*)(lds + attn_body::LDS_WS);
    float v[8]; const int base = tid * 8;
#pragma unroll
    for (int i = 0; i < 8; ++i) v[i] = GT[(size_t)(base + i) * 16];
#pragma unroll
    for (int i = 1; i < 8; ++i) v[i] += v[i - 1];
    float sc = v[7];
#pragma unroll
    for (int o = 1; o < 64; o <<= 1) { const float t = __shfl_up(sc, o); if (lane >= o) sc += t; }
    if (lane == 63) wsum[wave] = sc;
    __syncthreads();
    float off = sc - v[7];
    for (int w = 0; w < wave; ++w) off += wsum[w];
#pragma unroll
    for (int i = 0; i < 8; ++i) F2l[base + i] = -(v[i] + off) * LOG2E;
    __syncthreads();
}
#define PHASE_IDS int tid_ = threadIdx.x; asm volatile("" : "+v"(tid_)); const int tid = tid_, lane = tid & 63, wave = __builtin_amdgcn_readfirstlane(tid >> 6)
__device__ __forceinline__ void mix_phase_a(Frame& F, const Args& A) {
    PHASE_IDS; size_t wso_ = 0; asm volatile("" : "+s"(wso_)); unsigned char* ws = F.ws + wso_;
    for (int u = F.vcu; u < 512; u += F.G) mlstm_a_unit(ws, F.lds, u, tid, lane, wave);
    for (int u = F.vcu; u < 512; u += F.G) mlstm_s_unit(A, ws, F.out, F.lds, u, tid, lane, wave);
    for (int u = F.vcu; u < 256; u += F.G) fox_dec_unit(A, ws, F.out, F.lds, u, tid, lane, wave);
}
__device__ __forceinline__ void mix_phase_b(Frame& F, const Args& A) {
    PHASE_IDS; size_t wso_ = 0; asm volatile("" : "+s"(wso_)); unsigned char* ws = F.ws + wso_;
    mlstm_b(ws, F.out, F.lds, F.vcu, F.G, tid);
    fox_dec_combine(ws, F.vcu, F.G, tid);
}
__device__ __forceinline__ void mix_phase_c(Frame& F, const Args& A, unsigned char* lds) {
    { PHASE_IDS; size_t wso_ = 0; asm volatile("" : "+s"(wso_)); unsigned char* ws = F.ws + wso_;
      for (int u = F.vcu; u < 512; u += F.G) mlstm_c_unit(A, ws, F.lds, u, tid, lane, wave); }
    { PHASE_IDS; size_t wso_ = 0; asm volatile("" : "+s"(wso_)); unsigned char* ws = F.ws + wso_;
      const int pu = F.vcu; if (pu < NB * HF * 8) { const int bh = pu >> 3, s = pu & 7, b = bh / HF, h = bh % HF;
        fox_f2_to_lds(ws, F.lds, b, h, tid, lane, wave);
        for (int i = 0; i < 2; ++i)
            attn_body::attn_unit<8>(b, h, i ? 15 - s : s, (const attn_body::bf16*)(ws + WS_FQ), (const attn_body::bf16*)(ws + WS_FK), (const attn_body::bf16*)(ws + WS_FV), (attn_body::bf16*)(ws + WS_YF), (char*)lds + RING_OFF);
    } }
}
constexpr int N_PHASES = 10;
__global__ void __launch_bounds__(NWAVES * 64, 2) fwd_kernel(Args args) {
    extern __shared__ __attribute__((aligned(16))) unsigned char lds[];
    Frame F;
    F.lds = (LAS unsigned char*)lds;
    F.MISC = (volatile LAS unsigned*)(F.lds + MISC_OFF);
    F.G = gridDim.x; { const int bx = blockIdx.x; F.vcu = (F.G % 8 == 0) ? (bx % 8) * (F.G / 8) + bx / 8 : bx; }
    unsigned char* ws0 = args.ws; F.ws = ws0; F.out = args.out;
    F.ctl = (gu32*)(ws0 + WS_CTL);
    const Args& A = args;
    for (int u = threadIdx.x; u < (LDS_BYTES - LDSCTL_OFF) / 4; u += NWAVES * 64) ((LAS unsigned*)(F.lds + LDSCTL_OFF))[u] = 0u;
    __syncthreads();
    XcdBarrier bar = xcd_barrier_post((unsigned*)(F.ctl + CW_BAR), F.MISC + 8);
    const int lo = args.ph_lo, hi = args.ph_hi;
#define IN(k) (lo <= (k) && (k) < hi)
#define SEAM(k) do { if (IN(k) && IN((k) + 1)) xcd_barrier(bar); } while (0)
#define PHASE_WS size_t wso_ = 0; asm volatile("" : "+s"(wso_)); unsigned char* ws = ws0 + wso_

    if (IN(0)) { p0_prologue(F, A); }
    SEAM(0);
    if (IN(1)) { PHASE_WS;
        pg8::Gemm g{(const bf16*)(ws + WS_XN), (const bf16*)(ws + WS_WIN), MT, NIN, DM}; pg8::StaticOrder S; S.init(MT, NIN, F.G, (int)blockIdx.x);
        pg8::EpiIn E{(bf16*)(ws + WS_MQ), (bf16*)(ws + WS_MK), (bf16*)(ws + WS_MV), (bf16*)(ws + WS_MO), (bf16*)(ws + WS_FQ), (bf16*)(ws + WS_FK), (bf16*)(ws + WS_FV), (bf16*)(ws + WS_GA), (bf16*)(ws + WS_GB),
                     F.out + O_KP, F.out + O_KS, F.out + O_VP, F.out + O_VS, I_GQN, I_GKN, C2Q};
        pg8::gemm_phase<pg8::EpiIn, pg8::StaticOrder, true, true>(F.lds + RING_OFF, g, S, E);
    }
    SEAM(1);
    if (IN(2)) { mix_phase_a(F, A); }
    SEAM(2);
    if (IN(3)) { mix_phase_b(F, A); }
    SEAM(3);
    if (IN(4)) { mix_phase_c(F, A, lds); }
    SEAM(4);
    if (IN(5)) { PHASE_WS;
        { pg8::Gemm g{(const bf16*)(ws + WS_HM), (const bf16*)(ws + WS_WPA), MT, DM, WM}; pg8::StaticOrder S; S.init(MT, DM, F.G, (int)blockIdx.x);
          pg8::EpiMerge<1> E{(const bf16*)(ws + WS_GA), (bf16*)(ws + WS_U)};
          pg8::gemm_phase<pg8::EpiMerge<1>, pg8::StaticOrder, true, true>(F.lds + RING_OFF, g, S, E); }
        __syncthreads();
        { pg8::Gemm g{(const bf16*)(ws + WS_YF), (const bf16*)(ws + WS_WPB), MT, DM, WF}; pg8::StaticOrder S; S.init(MT, DM, F.G, (int)blockIdx.x);
          pg8::EpiMerge<0> E{(const bf16*)(ws + WS_GB), (bf16*)(ws + WS_U)};
          pg8::gemm_phase<pg8::EpiMerge<0>, pg8::StaticOrder, true, true>(F.lds + RING_OFF, g, S, E); }
    }
    SEAM(5);
    if (IN(6)) { PHASE_WS;
        pg8::Gemm g{(const bf16*)(ws + WS_U), (const bf16*)(ws + WS_WOUT), MT, DM, DM}; pg8::StaticOrder S; S.init(MT, DM, F.G, (int)blockIdx.x);
        pg8::EpiRes E{I_XP, I_XS - (size_t)MP * DM, (float*)(ws + WS_X1), (bf16*)(ws + WS_A2), (float*)(ws + WS_SSQ2), I_GFFN};
        pg8::gemm_phase<pg8::EpiRes, pg8::StaticOrder, true, true>(F.lds + RING_OFF, g, S, E);
    }
    SEAM(6);
    if (IN(7)) { PHASE_WS;
        pg8::Gemm g{(const bf16*)(ws + WS_A2), (const bf16*)(ws + WS_WGU), MT, NGU, DM}; pg8::StaticOrder S; S.init(MT, NGU, F.G, (int)blockIdx.x);
        pg8::EpiGU E{(const float*)(ws + WS_SSQ2), (bf16*)(ws + WS_HB)};
        pg8::gemm_phase<pg8::EpiGU, pg8::StaticOrder, true, true>(F.lds + RING_OFF, g, S, E);
    }
    SEAM(7);
    if (IN(8)) { PHASE_WS;
        { pg8::Gemm g{(const bf16*)(ws + WS_HB), (const bf16*)(ws + WS_WDN), MT, DM, DFF}; pg8::StaticOrder S; S.init(MT, DM, F.G, (int)blockIdx.x);
          pg8::EpiRes E{(const float*)(ws + WS_X1), (const float*)(ws + WS_X1), F.out + O_YP, (bf16*)(ws + WS_A3), (float*)(ws + WS_SSQ3), I_GPLE};
          pg8::gemm_phase<pg8::EpiRes, pg8::StaticOrder, true, true>(F.lds + RING_OFF, g, S, E); }
        __syncthreads();
        { pg8::Gemm g{(const bf16*)(ws + WS_PB), (const bf16*)(ws + WS_WPP), MT, DM, PLE}; pg8::StaticOrder S; S.init(MT, DM, F.G, (int)blockIdx.x);
          pg8::EpiStore E{(bf16*)(ws + WS_TP)};
          pg8::gemm_phase<pg8::EpiStore, pg8::StaticOrder, true, true>(F.lds + RING_OFF, g, S, E); }
    }
    SEAM(8);
    if (IN(9)) { PHASE_WS;
        pg8::Gemm g{(const bf16*)(ws + WS_A3), (const bf16*)(ws + WS_WPG), MT, DM, DM}; pg8::StaticOrder S; S.init(MT, DM, F.G, (int)blockIdx.x);
        pg8::EpiPle E{(const float*)(ws + WS_SSQ3), (const bf16*)(ws + WS_TP), F.out + O_YP};
        pg8::gemm_phase<pg8::EpiPle, pg8::StaticOrder, true, true>(F.lds + RING_OFF, g, S, E);
    }
#undef IN
#undef SEAM
}

extern "C" void kernel_launch(void* const* d_in, const int* in_sizes, int n_in, void* d_out, int out_size, void* d_ws, size_t ws_size, hipStream_t stream) {
    static int grid = 0;
    if (grid == 0) {
        if (n_in != 28 || out_size != (int)O_END || ws_size < WS_END) { fprintf(stderr, "kernel_launch: unexpected shapes: n_in %d out %d ws %zu\n", n_in, out_size, ws_size); grid = -1; return; }
        int dev = 0, cus = 0, per_cu = 0;
        if (hipGetDevice(&dev) != hipSuccess || hipDeviceGetAttribute(&cus, hipDeviceAttributeMultiprocessorCount, dev) != hipSuccess) { grid = -1; return; }
        if (hipFuncSetAttribute((const void*)fwd_kernel, hipFuncAttributeMaxDynamicSharedMemorySize, LDS_BYTES) != hipSuccess) { fprintf(stderr, "kernel_launch: hipFuncSetAttribute failed\n"); grid = -1; return; }
        if (hipOccupancyMaxActiveBlocksPerMultiprocessor(&per_cu, (const void*)fwd_kernel, NWAVES * 64, LDS_BYTES) != hipSuccess || per_cu < 1) { fprintf(stderr, "kernel_launch: occupancy query says %d\n", per_cu); }
        (void)hipGetLastError();
        grid = cus;
    }
    if (grid < 0) return;
    if (hipMemsetAsync((char*)d_ws + WS_CTL, 0, CTL_ZERO_BYTES, stream) != hipSuccess) return;
    Args a{};
    for (int i = 0; i < 28; ++i) a.in[i] = d_in[i];
    a.out = (float*)d_out; a.ws = (unsigned char*)d_ws;
#ifndef MK_SPLIT
    a.ph_lo = 0; a.ph_hi = N_PHASES;
    hipLaunchKernelGGL(fwd_kernel, dim3(grid), dim3(NWAVES * 64), LDS_BYTES, stream, a);
#else
    for (int p = 0; p < N_PHASES; ++p) { a.ph_lo = p; a.ph_hi = p + 1; hipLaunchKernelGGL(fwd_kernel, dim3(grid), dim3(NWAVES * 64), LDS_BYTES, stream, a); }
#endif
}
```

```cpp
#include <hip/hip_runtime.h>
#include <hip/hip_bf16.h>
#include <cstdio>
#include <cstdint>
#include <cmath>
namespace pg8 {
#define PG8_LAS __attribute__((address_space(3)))
typedef unsigned short bf16_t;
typedef short bf16x8 __attribute__((ext_vector_type(8)));
typedef float f32x4 __attribute__((ext_vector_type(4)));
typedef unsigned u32x4 __attribute__((ext_vector_type(4)));
constexpr int BM = 256, BK = 64, HALF = 128, HTB = HALF * BK * 2  , STAGE_BYTES = 8 * HTB, NXCD = 8, WGM = 8;

__host__ __device__ __forceinline__ int lds_byte(int r, int c) { const int st = (r >> 4) * 2 + (c >> 5), rr = r & 15, cc = c & 31, ob = rr * 64 + cc * 2; return st * 1024 + (ob ^ (((ob >> 9) & 1) << 5)); }
__host__ __device__ __forceinline__ void stage_rc(int b, int& R, int& C) { const int st = b / 1024, sb = b % 1024, swz = sb ^ (((sb >> 9) & 1) << 5); R = (st >> 1) * 16 + swz / 64; C = (st & 1) * 32 + (swz % 64) / 2; }
__host__ __device__ __forceinline__ int perm32(int rho) { const int n = rho >> 4, i = rho & 15; return 8 * (i >> 2) + 4 * n + (i & 3); }

struct Unit { int pm, pn; };
struct Gemm { const bf16_t* A; const bf16_t* Bt; int M, N, K; };

struct StaticOrder {
    int nM, nN, nwg, G, c;
    __host__ __device__ void init(int M, int N, int G_, int c_) { nM = M / BM; nN = N / BM; nwg = nM * nN; G = G_; c = c_; }
    __host__ __device__ bool next(int i, Unit& u) const {
        const long L = (long)i * G + c; if (L >= nwg) return false;
        int wgid = (int)L; { const int q = nwg / NXCD, r = nwg % NXCD, xcd = wgid % NXCD, off = wgid / NXCD; wgid = (xcd < r ? xcd * (q + 1) : r * (q + 1) + (xcd - r) * q) + off; }
        const int nig = WGM * nN, gid = wgid / nig, fm = gid * WGM, gsz = (nM - fm) < WGM ? (nM - fm) : WGM;
        u.pm = fm + ((wgid % nig) % gsz); u.pn = (wgid % nig) / gsz; return true;
    }
    __device__ __forceinline__ void a_ready(const Unit&) const {}
    __device__ __forceinline__ void done(const Unit&) const {}
};

typedef float pg8_f32x2 __attribute__((ext_vector_type(2))); typedef __bf16 pg8_bf16x2 __attribute__((ext_vector_type(2)));
__device__ __forceinline__ unsigned cvt_pk_bf16(float lo, float hi) { const pg8_f32x2 v = {lo, hi}; const pg8_bf16x2 b = __builtin_convertvector(v, pg8_bf16x2); return __builtin_bit_cast(unsigned, b); }
typedef float f32x2 __attribute__((ext_vector_type(2)));
constexpr float EPSN = 1e-6f;
#define PG8_GAS __attribute__((address_space(1)))
__device__ __forceinline__ void st16_wt(void* p, u32x4 v) { asm volatile("global_store_dwordx4 %0, %1, off sc1\n\ts_nop 1" :: "v"(p), "v"(v) : "memory"); }
__device__ __forceinline__ void st16_wt(void* p, f32x4 v) { st16_wt(p, __builtin_bit_cast(u32x4, v)); }
__device__ __forceinline__ float sigm(float x) { return __builtin_amdgcn_rcpf(1.f + __builtin_amdgcn_exp2f(-1.4426950408889634f * x)); }
__device__ __forceinline__ f32x4 sigm4(f32x4 x) { f32x4 r; r[0] = sigm(x[0]); r[1] = sigm(x[1]); r[2] = sigm(x[2]); r[3] = sigm(x[3]); return r; }
__device__ __forceinline__ void st8bf(bf16_t* p, const f32x4 a, const f32x4 b) { u32x4 w; w.x = cvt_pk_bf16(a[0], a[1]); w.y = cvt_pk_bf16(a[2], a[3]); w.z = cvt_pk_bf16(b[0], b[1]); w.w = cvt_pk_bf16(b[2], b[3]); *(PG8_GAS u32x4*)p = w; }
__device__ __forceinline__ void ld8bf(const bf16_t* p, f32x4& a, f32x4& b) { const u32x4 w = *(const PG8_GAS u32x4*)p;
    a[0] = __uint_as_float(w.x << 16); a[1] = __uint_as_float(w.x & 0xffff0000u); a[2] = __uint_as_float(w.y << 16); a[3] = __uint_as_float(w.y & 0xffff0000u);
    b[0] = __uint_as_float(w.z << 16); b[1] = __uint_as_float(w.z & 0xffff0000u); b[2] = __uint_as_float(w.w << 16); b[3] = __uint_as_float(w.w & 0xffff0000u); }
__device__ __forceinline__ float dot4(f32x4 a) { return (a[0] * a[0] + a[1] * a[1]) + (a[2] * a[2] + a[3] * a[3]); }
constexpr int MP = 16384;

struct EpiIn { static constexpr int ID = 1;
    static constexpr bool PERM = true, AFTER_DRAIN = false, MID = false;
    bf16_t *MQ, *MK, *MV, *MO, *FQ, *FK, *FV, *GA, *GB; float *kp, *ks, *vp, *vs; const float *g_qn, *g_kn; float c2;
    __device__ __forceinline__ void operator()(const f32x4 (&acc)[2][2][4][2], const Unit& u, int wr, int wc, int fr, int fq) const {
        asm volatile("" : "+v"(fr), "+v"(fq));
        const int pn = u.pn; const int row0 = u.pm * BM + wr * 64 + fr; const bool smp = u.pm >= MP / BM;
        if (pn >= 8 && pn < 12) {
            const bool isq = pn < 10; const float* g = isq ? g_qn : g_kn; const float post = isq ? c2 : 1.f;
            f32x4 gv[2][2];
#pragma unroll
            for (int bj = 0; bj < 2; ++bj)
#pragma unroll
                for (int n = 0; n < 2; ++n) gv[bj][n] = *(const PG8_GAS f32x4*)(g + 32 * bj + 8 * fq + 4 * n) * post;
            bf16_t* dst = isq ? FQ : FK; const int colb = (pn & 1) * 256 + 64 * wc + 8 * fq;
            float* ko = smp ? ks - (size_t)MP * 512 : kp;
#pragma unroll
            for (int ai = 0; ai < 2; ++ai)
#pragma unroll
                for (int m = 0; m < 4; ++m) { const size_t row = (size_t)(row0 + ai * HALF + m * 16);
                    float s = (dot4(acc[ai][0][m][0]) + dot4(acc[ai][0][m][1])) + (dot4(acc[ai][1][m][0]) + dot4(acc[ai][1][m][1]));
                    s += __shfl_xor(s, 16); s += __shfl_xor(s, 32);
                    const float r = rsqrtf(s * (1.0f / 64.0f) + EPSN);
#pragma unroll
                    for (int bj = 0; bj < 2; ++bj) { const f32x4 a = acc[ai][bj][m][0] * r * gv[bj][0], b = acc[ai][bj][m][1] * r * gv[bj][1];
                        st8bf(dst + row * 512 + colb + 32 * bj, a, b);
                        if (!isq) { float* o = ko + row * 512 + colb + 32 * bj; *(PG8_GAS f32x4*)o = a; *(PG8_GAS f32x4*)(o + 4) = b; } } }
        } else if (pn < 14) {
            const int seg = pn >> 1;
            bf16_t* dst = seg == 0 ? MQ : seg == 1 ? MK : seg == 2 ? MV : seg == 3 ? MO : FV;
            const float sc = seg == 1 ? 0.08838834764831845f : 1.f; const int colb = (pn & 1) * 256 + 32 * wc + 8 * fq;
            float* vo = smp ? vs - (size_t)MP * 512 : vp;
#pragma unroll
            for (int ai = 0; ai < 2; ++ai)
#pragma unroll
                for (int m = 0; m < 4; ++m) { const size_t row = (size_t)(row0 + ai * HALF + m * 16);
#pragma unroll
                    for (int bj = 0; bj < 2; ++bj) { f32x4 a = acc[ai][bj][m][0] * sc, b = acc[ai][bj][m][1] * sc;
                        if (seg == 3) { a = sigm4(a); b = sigm4(b); }
                        st8bf(dst + row * 512 + colb + 128 * bj, a, b);
                        if (seg == 6) { float* o = vo + row * 512 + colb + 128 * bj; *(PG8_GAS f32x4*)o = a; *(PG8_GAS f32x4*)(o + 4) = b; } } }
        } else {
            const int q = pn - 14; bf16_t* dst = q < 4 ? GA : GB; const int colb = (q & 3) * 256 + 32 * wc + 8 * fq;
#pragma unroll
            for (int ai = 0; ai < 2; ++ai)
#pragma unroll
                for (int m = 0; m < 4; ++m) { const size_t row = (size_t)(row0 + ai * HALF + m * 16);
#pragma unroll
                    for (int bj = 0; bj < 2; ++bj) st8bf(dst + row * 1024 + colb + 128 * bj, sigm4(acc[ai][bj][m][0]), sigm4(acc[ai][bj][m][1])); }
        }
    }
};
struct EpiMerge2 { static constexpr int ID = 2;
    static constexpr bool PERM = true, AFTER_DRAIN = false, MID = true;
    const bf16_t *GA, *GB; bf16_t* U;
    __device__ __forceinline__ void mid(f32x4 (&acc)[2][2][4][2], const Unit& u, int wr, int wc, int fr, int fq) const {
        asm volatile("" : "+v"(fr), "+v"(fq));
        const int row0 = u.pm * BM + wr * 64 + fr, colb = u.pn * BM + 32 * wc + 8 * fq;
#pragma unroll
        for (int ai = 0; ai < 2; ++ai)
#pragma unroll
            for (int m = 0; m < 4; ++m)
#pragma unroll
                for (int bj = 0; bj < 2; ++bj) { const size_t idx = (size_t)(row0 + ai * HALF + m * 16) * 1024 + colb + 128 * bj;
                    f32x4 ga0, ga1, gb0, gb1; ld8bf(GA + idx, ga0, ga1); ld8bf(GB + idx, gb0, gb1);
#pragma unroll
                    for (int v = 0; v < 4; ++v) { acc[ai][bj][m][0][v] *= ga0[v] * __builtin_amdgcn_rcpf(fmaxf(gb0[v], 1e-30f)); acc[ai][bj][m][1][v] *= ga1[v] * __builtin_amdgcn_rcpf(fmaxf(gb1[v], 1e-30f)); } }
    }
    __device__ __forceinline__ void operator()(const f32x4 (&acc)[2][2][4][2], const Unit& u, int wr, int wc, int fr, int fq) const {
        asm volatile("" : "+v"(fr), "+v"(fq));
        const int row0 = u.pm * BM + wr * 64 + fr, colb = u.pn * BM + 32 * wc + 8 * fq;
#pragma unroll
        for (int ai = 0; ai < 2; ++ai) { u32x4 gw[4][2];
#pragma unroll
            for (int m = 0; m < 4; ++m)
#pragma unroll
                for (int bj = 0; bj < 2; ++bj) gw[m][bj] = *(const PG8_GAS u32x4*)(GB + (size_t)(row0 + ai * HALF + m * 16) * 1024 + colb + 128 * bj);
#pragma unroll
            for (int m = 0; m < 4; ++m)
#pragma unroll
                for (int bj = 0; bj < 2; ++bj) { const size_t idx = (size_t)(row0 + ai * HALF + m * 16) * 1024 + colb + 128 * bj; const u32x4 w = gw[m][bj];
                    f32x4 gb0, gb1;
                    gb0[0] = __uint_as_float(w.x << 16); gb0[1] = __uint_as_float(w.x & 0xffff0000u); gb0[2] = __uint_as_float(w.y << 16); gb0[3] = __uint_as_float(w.y & 0xffff0000u);
                    gb1[0] = __uint_as_float(w.z << 16); gb1[1] = __uint_as_float(w.z & 0xffff0000u); gb1[2] = __uint_as_float(w.w << 16); gb1[3] = __uint_as_float(w.w & 0xffff0000u);
#pragma unroll
                    for (int v = 0; v < 4; ++v) { gb0[v] = fmaxf(gb0[v], 1e-30f); gb1[v] = fmaxf(gb1[v], 1e-30f); }
                    st8bf(U + idx, acc[ai][bj][m][0] * gb0, acc[ai][bj][m][1] * gb1); } }
    }
};
template <int BASE_BF16> struct EpiRes { static constexpr int ID = 3;
    static constexpr bool PERM = true, AFTER_DRAIN = false, MID = false;
    const void* base; bf16_t* An; float* ssq;
    __device__ __forceinline__ void operator()(const f32x4 (&acc)[2][2][4][2], const Unit& u, int wr, int wc, int fr, int fq) const {
        asm volatile("" : "+v"(fr), "+v"(fq));
        const int row0 = u.pm * BM + wr * 64 + fr, colb = u.pn * BM + 32 * wc + 8 * fq;
#pragma unroll
        for (int ai = 0; ai < 2; ++ai)
#pragma unroll
            for (int mh = 0; mh < 2; ++mh) { f32x4 ba[2][2], bb[2][2]; u32x4 bw[2][2];
#pragma unroll
                for (int mm = 0; mm < 2; ++mm)
#pragma unroll
                    for (int bj = 0; bj < 2; ++bj) { const size_t idx = (size_t)(row0 + ai * HALF + (2 * mh + mm) * 16) * 1024 + colb + 128 * bj;
                        if (BASE_BF16) bw[mm][bj] = *(const PG8_GAS u32x4*)((const bf16_t*)base + idx); else { ba[mm][bj] = __builtin_nontemporal_load((const PG8_GAS f32x4*)((const float*)base + idx)); bb[mm][bj] = __builtin_nontemporal_load((const PG8_GAS f32x4*)((const float*)base + idx + 4)); } }
#pragma unroll
                for (int mm = 0; mm < 2; ++mm) { const int m = 2 * mh + mm; const int row = row0 + ai * HALF + m * 16; float s = 0.f;
#pragma unroll
                    for (int bj = 0; bj < 2; ++bj) { const size_t idx = (size_t)row * 1024 + colb + 128 * bj; f32x4 a, b;
                        if (BASE_BF16) { const u32x4 w = bw[mm][bj];
                            a[0] = __uint_as_float(w.x << 16); a[1] = __uint_as_float(w.x & 0xffff0000u); a[2] = __uint_as_float(w.y << 16); a[3] = __uint_as_float(w.y & 0xffff0000u);
                            b[0] = __uint_as_float(w.z << 16); b[1] = __uint_as_float(w.z & 0xffff0000u); b[2] = __uint_as_float(w.w << 16); b[3] = __uint_as_float(w.w & 0xffff0000u); }
                        else { a = ba[mm][bj]; b = bb[mm][bj]; }
                        a += acc[ai][bj][m][0]; b += acc[ai][bj][m][1]; s += dot4(a) + dot4(b);
                        st8bf(An + idx, a, b); }
                    s += __shfl_xor(s, 16); s += __shfl_xor(s, 32);
                    if (fq == 0) *(PG8_GAS float*)(ssq + (size_t)row * 16 + u.pn * 4 + wc) = s; } }
    }
};
__device__ __forceinline__ float row_rstd(const float* ssq, int row) { const PG8_GAS f32x4* sp = (const PG8_GAS f32x4*)(ssq + (size_t)row * 16); const f32x4 t = (sp[0] + sp[1]) + (sp[2] + sp[3]);
    return rsqrtf(((t[0] + t[1]) + (t[2] + t[3])) * (1.0f / 1024.0f) + EPSN); }
__device__ __forceinline__ void row_rstd8(const float* ssq, int row0, int fq, float (&rs)[2][4]) {
    f32x4 t[2][4];
#pragma unroll
    for (int ai = 0; ai < 2; ++ai)
#pragma unroll
        for (int m = 0; m < 4; ++m) t[ai][m] = *(const PG8_GAS f32x4*)(ssq + (size_t)(row0 + ai * HALF + m * 16) * 16 + 4 * fq);
#pragma unroll
    for (int ai = 0; ai < 2; ++ai)
#pragma unroll
        for (int m = 0; m < 4; ++m) { float q = (t[ai][m][0] + t[ai][m][1]) + (t[ai][m][2] + t[ai][m][3]); q += __shfl_xor(q, 16); q += __shfl_xor(q, 32); rs[ai][m] = rsqrtf(q * (1.0f / 1024.0f) + EPSN); }
}
struct EpiGU { static constexpr int ID = 4;
    static constexpr bool PERM = true, AFTER_DRAIN = false, MID = false;
    const float* ssq; bf16_t* HB;
    __device__ __forceinline__ void operator()(const f32x4 (&acc)[2][2][4][2], const Unit& u, int wr, int wc, int fr, int fq) const {
        asm volatile("" : "+v"(fr), "+v"(fq));
        const int row0 = u.pm * BM + wr * 64 + fr, colb = u.pn * 128 + 32 * wc + 8 * fq;
        float rsv[2][4]; row_rstd8(ssq, row0, fq, rsv);
#pragma unroll
        for (int ai = 0; ai < 2; ++ai)
#pragma unroll
            for (int m = 0; m < 4; ++m) { const int row = row0 + ai * HALF + m * 16; const float rs = rsv[ai][m];
                f32x4 h[2];
#pragma unroll
                for (int n = 0; n < 2; ++n) { const f32x4 gg = acc[ai][0][m][n] * rs, uu = acc[ai][1][m][n] * rs; h[n] = gg * sigm4(gg) * uu; }
                st8bf(HB + (size_t)row * 2816 + colb, h[0], h[1]); }
    }
};
struct EpiStore { static constexpr int ID = 5;
    static constexpr bool PERM = true, AFTER_DRAIN = false, MID = false;
    bf16_t* O;
    __device__ __forceinline__ void operator()(const f32x4 (&acc)[2][2][4][2], const Unit& u, int wr, int wc, int fr, int fq) const {
        asm volatile("" : "+v"(fr), "+v"(fq));
        const int row0 = u.pm * BM + wr * 64 + fr, colb = u.pn * BM + 32 * wc + 8 * fq;
#pragma unroll
        for (int ai = 0; ai < 2; ++ai)
#pragma unroll
            for (int m = 0; m < 4; ++m)
#pragma unroll
                for (int bj = 0; bj < 2; ++bj) st8bf(O + (size_t)(row0 + ai * HALF + m * 16) * 1024 + colb + 128 * bj, acc[ai][bj][m][0], acc[ai][bj][m][1]);
    }
};
struct EpiPle { static constexpr int ID = 6;
    static constexpr bool PERM = true, AFTER_DRAIN = false, MID = false;
    const float* ssq; const bf16_t* TP; const bf16_t* X2; float* Y;
    __device__ __forceinline__ void operator()(const f32x4 (&acc)[2][2][4][2], const Unit& u, int wr, int wc, int fr, int fq) const {
        asm volatile("" : "+v"(fr), "+v"(fq));
        const int row0 = u.pm * BM + wr * 64 + fr, colb = u.pn * BM + 32 * wc + 8 * fq;
        float rsv[2][4]; row_rstd8(ssq, row0, fq, rsv);
#pragma unroll
        for (int ai = 0; ai < 2; ++ai)
#pragma unroll
            for (int mh = 0; mh < 2; ++mh) { u32x4 tw[2][2], xw[2][2];
#pragma unroll
                for (int mm = 0; mm < 2; ++mm)
#pragma unroll
                    for (int bj = 0; bj < 2; ++bj) { const size_t idx = (size_t)(row0 + ai * HALF + (2 * mh + mm) * 16) * 1024 + colb + 128 * bj;
                        tw[mm][bj] = *(const PG8_GAS u32x4*)(TP + idx); xw[mm][bj] = *(const PG8_GAS u32x4*)(X2 + idx); }
#pragma unroll
                for (int mm = 0; mm < 2; ++mm) { const int m = 2 * mh + mm; const int row = row0 + ai * HALF + m * 16; const float rs = rsv[ai][m];
#pragma unroll
                    for (int bj = 0; bj < 2; ++bj) { const size_t idx = (size_t)row * 1024 + colb + 128 * bj; f32x4 ta, tb, xa, xb; const u32x4 w = tw[mm][bj], x = xw[mm][bj];
                        ta[0] = __uint_as_float(w.x << 16); ta[1] = __uint_as_float(w.x & 0xffff0000u); ta[2] = __uint_as_float(w.y << 16); ta[3] = __uint_as_float(w.y & 0xffff0000u);
                        tb[0] = __uint_as_float(w.z << 16); tb[1] = __uint_as_float(w.z & 0xffff0000u); tb[2] = __uint_as_float(w.w << 16); tb[3] = __uint_as_float(w.w & 0xffff0000u);
                        xa[0] = __uint_as_float(x.x << 16); xa[1] = __uint_as_float(x.x & 0xffff0000u); xa[2] = __uint_as_float(x.y << 16); xa[3] = __uint_as_float(x.y & 0xffff0000u);
                        xb[0] = __uint_as_float(x.z << 16); xb[1] = __uint_as_float(x.z & 0xffff0000u); xb[2] = __uint_as_float(x.w << 16); xb[3] = __uint_as_float(x.w & 0xffff0000u);
                        __builtin_nontemporal_store(xa + sigm4(acc[ai][bj][m][0] * rs) * ta, (PG8_GAS f32x4*)(Y + idx)); __builtin_nontemporal_store(xb + sigm4(acc[ai][bj][m][1] * rs) * tb, (PG8_GAS f32x4*)(Y + idx + 4)); } } }
    }
};
template <class Epi, class Sched, bool ALIGN_EPI = false, bool SP2 = false>
__device__ __forceinline__ void gemm_phase(PG8_LAS unsigned char* lds, const Gemm g, const Sched& S, const Epi& E) {
    int tid_ = threadIdx.x; asm volatile("" : "+v"(tid_));
    const int tid = tid_, wid = __builtin_amdgcn_readfirstlane(tid >> 6), lane = tid & 63, wr = wid >> 2, wc = wid & 3, fr = lane & 15, fq = lane >> 4;
    int K_ = g.K; asm volatile("" : "+s"(K_));
    const int K = K_, nt = K / BK;
    unsigned voffA[2], voffB[2];
#pragma unroll
    for (int i = 0; i < 2; ++i) { int R, C; stage_rc(tid * 16 + i * 8192, R, C); const int Rb = Epi::PERM ? ((R & ~31) + perm32(R & 31)) : R;
        voffA[i] = (unsigned)(R * K + C) * 2u; voffB[i] = (unsigned)(Rb * K + C) * 2u; }
    const size_t kstep = (size_t)(BK * 2);
    const size_t hstep = (size_t)HALF * K * 2;
    const size_t tstep = 2 * hstep;
    const unsigned ldsw = (unsigned)wid * 1024u;
    const int aoff = lds_byte(wr * 64 + fr, fq * 8), boff = lds_byte(wc * 32 + fr, fq * 8);
#define PG8_SA(b, h) (((b) * 2 + (h)) * HTB)
#define PG8_SB(b, h) ((4 + (b) * 2 + (h)) * HTB)
#define PG8_STAGE(bufoff, gbase, voff) do { _Pragma("unroll") for (int _i = 0; _i < 2; ++_i) \
        __builtin_amdgcn_global_load_lds((const unsigned*)((const char*)(gbase) + (voff)[_i]), (PG8_LAS unsigned*)(lds + (bufoff) + ldsw + _i * 8192), 16, 0, 0); } while (0)
#define PG8_LDA(dst, b, h) do { _Pragma("unroll") for (int m = 0; m < 4; ++m) _Pragma("unroll") for (int k = 0; k < 2; ++k) dst[m][k] = *(const PG8_LAS bf16x8*)(lds + PG8_SA(b, h) + aoff + m * 2048 + k * 1024); } while (0)
#define PG8_LDB(dst, b, h) do { _Pragma("unroll") for (int n = 0; n < 2; ++n) _Pragma("unroll") for (int k = 0; k < 2; ++k) dst[n][k] = *(const PG8_LAS bf16x8*)(lds + PG8_SB(b, h) + boff + n * 2048 + k * 1024); } while (0)
#define PG8_MMA(ai, bj, At, Bt) do { __builtin_amdgcn_s_setprio(1); _Pragma("unroll") for (int m = 0; m < 4; ++m) _Pragma("unroll") for (int n = 0; n < 2; ++n) _Pragma("unroll") for (int k = 0; k < 2; ++k) \
        acc[ai][bj][m][n] = __builtin_amdgcn_mfma_f32_16x16x32_bf16(Bt[n][k], At[m][k], acc[ai][bj][m][n], 0, 0, 0); __builtin_amdgcn_s_setprio(0); } while (0)
#define PG8_WAIT_V(n) asm volatile("s_waitcnt vmcnt(" #n ")" ::: "memory")
#define PG8_WAIT_L(n) asm volatile("s_waitcnt lgkmcnt(" #n ")" ::: "memory")
#define PG8_BAR __builtin_amdgcn_s_barrier()
#define PG8_SCHED __builtin_amdgcn_sched_barrier(0)
    Unit cur, nxt; int ui = 0;
    if (!S.next(0, cur)) return;
    f32x4 acc[2][2][4][2];
#pragma unroll
    for (int a = 0; a < 2; ++a)
#pragma unroll
        for (int b = 0; b < 2; ++b)
#pragma unroll
            for (int m = 0; m < 4; ++m)
#pragma unroll
                for (int n = 0; n < 2; ++n) acc[a][b][m][n] = (f32x4){0.f, 0.f, 0.f, 0.f};
    bf16x8 At[4][2], B0[2][2], B1[2][2];
    const char* cA = (const char*)g.A + (size_t)cur.pm * tstep; const char* cB = (const char*)g.Bt + (size_t)cur.pn * tstep;
    S.a_ready(cur);
    if constexpr (SP2) {
        PG8_STAGE(PG8_SB(0, 0), cB, voffB); PG8_STAGE(PG8_SB(0, 1), cB + hstep, voffB); PG8_STAGE(PG8_SA(0, 0), cA, voffA); PG8_STAGE(PG8_SA(0, 1), cA + hstep, voffA);
        if (wr == 1) PG8_BAR;
        PG8_WAIT_V(2); PG8_BAR;
        PG8_STAGE(PG8_SB(1, 0), cB + kstep, voffB); PG8_STAGE(PG8_SA(1, 0), cA + kstep, voffA); PG8_STAGE(PG8_SB(1, 1), cB + hstep + kstep, voffB);
        PG8_WAIT_V(6); PG8_BAR;
    } else {
        PG8_STAGE(PG8_SB(0, 0), cB, voffB); PG8_STAGE(PG8_SA(0, 0), cA, voffA); PG8_STAGE(PG8_SB(0, 1), cB + hstep, voffB); PG8_STAGE(PG8_SA(0, 1), cA + hstep, voffA);
        if (wr == 1) PG8_BAR;
        PG8_WAIT_V(4); PG8_BAR;
        PG8_STAGE(PG8_SB(1, 0), cB + kstep, voffB); PG8_STAGE(PG8_SA(1, 0), cA + kstep, voffA); PG8_STAGE(PG8_SB(1, 1), cB + hstep + kstep, voffB);
        PG8_WAIT_V(6); PG8_BAR;
    }
    for (;;) {
        const bool has_next = S.next(ui + 1, nxt);
        const char* nA = has_next ? (const char*)g.A + (size_t)nxt.pm * tstep : cA; const char* nB = has_next ? (const char*)g.Bt + (size_t)nxt.pn * tstep : cB;
        for (int t = 0; t < nt; t += 2) {
            if constexpr (Epi::MID) { if (t == (nt >> 1)) E.mid(acc, cur, wr, wc, fr, fq); }
            const bool last = (t == nt - 2);
            const char* a1 = cA + (size_t)(t + 1) * kstep;
            const char* a2 = last ? nA : cA + (size_t)(t + 2) * kstep; const char* b2 = last ? nB : cB + (size_t)(t + 2) * kstep;
            const char* a3 = a2 + kstep; const char* b3 = b2 + kstep;
            if (last && has_next) S.a_ready(nxt);
            if constexpr (SP2) {
            PG8_LDB(B0, 0, 0); PG8_LDB(B1, 0, 1); PG8_SCHED; PG8_LDA(At, 0, 0); PG8_STAGE(PG8_SA(1, 1), a1 + hstep, voffA);
            PG8_WAIT_V(8); PG8_WAIT_L(0); PG8_BAR; PG8_MMA(0, 0, At, B0); PG8_MMA(0, 1, At, B1); PG8_BAR; PG8_SCHED;
            PG8_LDA(At, 0, 1); PG8_STAGE(PG8_SB(0, 0), b2, voffB); PG8_STAGE(PG8_SB(0, 1), b2 + hstep, voffB); PG8_STAGE(PG8_SA(0, 0), a2, voffA);
            PG8_WAIT_V(8); PG8_WAIT_L(0); PG8_BAR; PG8_MMA(1, 0, At, B0); PG8_MMA(1, 1, At, B1); PG8_BAR; PG8_SCHED;
            PG8_LDB(B0, 1, 0); PG8_LDB(B1, 1, 1); PG8_SCHED; PG8_LDA(At, 1, 0); PG8_STAGE(PG8_SA(0, 1), a2 + hstep, voffA);
            PG8_WAIT_V(8); PG8_WAIT_L(0); PG8_BAR; PG8_MMA(0, 0, At, B0); PG8_MMA(0, 1, At, B1); PG8_BAR; PG8_SCHED;
            PG8_LDA(At, 1, 1); PG8_STAGE(PG8_SB(1, 0), b3, voffB); PG8_STAGE(PG8_SB(1, 1), b3 + hstep, voffB); PG8_STAGE(PG8_SA(1, 0), a3, voffA);
            PG8_WAIT_V(8); PG8_WAIT_L(0); PG8_BAR; PG8_MMA(1, 0, At, B0); PG8_MMA(1, 1, At, B1); PG8_BAR; PG8_SCHED;
            } else {
            PG8_LDB(B0, 0, 0); PG8_SCHED; PG8_LDA(At, 0, 0); PG8_STAGE(PG8_SA(1, 1), a1 + hstep, voffA);
            PG8_WAIT_L(8); PG8_BAR; PG8_WAIT_L(0); PG8_MMA(0, 0, At, B0); PG8_BAR; PG8_SCHED;
            PG8_LDB(B1, 0, 1); PG8_STAGE(PG8_SB(0, 0), b2, voffB);
            PG8_BAR; PG8_WAIT_L(0); PG8_MMA(0, 1, At, B1); PG8_BAR;
            PG8_LDA(At, 0, 1); PG8_STAGE(PG8_SA(0, 0), a2, voffA);
            PG8_BAR; PG8_WAIT_L(0); PG8_MMA(1, 0, At, B0); PG8_BAR; PG8_SCHED;
            PG8_STAGE(PG8_SB(0, 1), b2 + hstep, voffB);
            PG8_WAIT_V(6); PG8_BAR; PG8_MMA(1, 1, At, B1); PG8_BAR;
            PG8_LDB(B0, 1, 0); PG8_SCHED; PG8_LDA(At, 1, 0); PG8_STAGE(PG8_SA(0, 1), a2 + hstep, voffA);
            PG8_WAIT_L(8); PG8_BAR; PG8_WAIT_L(0); PG8_MMA(0, 0, At, B0); PG8_BAR; PG8_SCHED;
            PG8_LDB(B1, 1, 1); PG8_STAGE(PG8_SB(1, 0), b3, voffB);
            PG8_BAR; PG8_WAIT_L(0); PG8_MMA(0, 1, At, B1); PG8_BAR;
            PG8_LDA(At, 1, 1); PG8_STAGE(PG8_SA(1, 0), a3, voffA);
            PG8_BAR; PG8_WAIT_L(0); PG8_MMA(1, 0, At, B0); PG8_BAR; PG8_SCHED;
            PG8_STAGE(PG8_SB(1, 1), b3 + hstep, voffB);
            PG8_WAIT_V(6); PG8_BAR; PG8_MMA(1, 1, At, B1); PG8_BAR;
            }
        }
        if constexpr (ALIGN_EPI) { if (wr == 0) PG8_BAR; }
#ifdef DUP_EPI
        if constexpr (Epi::ID == DUP_EPI) { E(acc, cur, wr, wc, fr, fq); asm volatile("" ::: "memory"); }
#endif
        if constexpr (!Epi::AFTER_DRAIN) { E(acc, cur, wr, wc, fr, fq); S.done(cur); }
        if (!has_next) break;
#pragma unroll
        for (int a = 0; a < 2; ++a)
#pragma unroll
            for (int b = 0; b < 2; ++b)
#pragma unroll
                for (int m = 0; m < 4; ++m)
#pragma unroll
                    for (int n = 0; n < 2; ++n) acc[a][b][m][n] = (f32x4){0.f, 0.f, 0.f, 0.f};
        cur = nxt; cA = nA; cB = nB; ++ui;
        if constexpr (ALIGN_EPI) { if (wr == 1) PG8_BAR; }
    }
    PG8_WAIT_V(0);
    if constexpr (!ALIGN_EPI) { if (wr == 0) PG8_BAR; }
    PG8_BAR;
    if constexpr (Epi::AFTER_DRAIN) { E.fused(acc, cur, wr, wc, fr, fq, lds, wid, lane); S.done(cur); }
#undef PG8_SA
#undef PG8_SB
#undef PG8_STAGE
#undef PG8_LDA
#undef PG8_LDB
#undef PG8_MMA
#undef PG8_WAIT_V
#undef PG8_WAIT_L
#undef PG8_BAR
#undef PG8_SCHED
}
}
namespace attn_body {
using bf16=__hip_bfloat16;
using bf16x8=__attribute__((ext_vector_type(8)))short;
using s16x4=__attribute__((ext_vector_type(4)))short;
using f32x16=__attribute__((ext_vector_type(16)))float;
using u32x4=__attribute__((ext_vector_type(4)))unsigned;
constexpr int BATCH=4,NHEAD=8,SEQ=4096,D=64,DM=NHEAD*D;
constexpr int NW=8,QBLK=32,QB=QBLK*NW,KVBLK=64,NQB=SEQ/QB;
constexpr int ATTN_PITCH=DM, ATTN_UNIT_ROWS=QB, OPITCH=1024;
__device__ __forceinline__ int crow(int r,int hi){return (r&3)+8*(r>>2)+4*hi;}
#define SBAR() __builtin_amdgcn_sched_barrier(0)
__device__ __forceinline__ void cmask(f32x16&p0,f32x16&p1,int jb,int qrel,int hi){
  const float NEG=-INFINITY; int kb=64*jb+4*hi;
  #pragma unroll
  for(int r=0;r<16;++r){int kv=kb+(r&3)+8*(r>>2); if(kv>qrel)p0[r]=NEG; if(kv+32>qrel)p1[r]=NEG;}
}

constexpr int NSLOT=3, SLOTB=8192;
constexpr int LDS_K=0, LDS_V=NSLOT*SLOTB, LDS_WS=2*NSLOT*SLOTB, LDS_OST=LDS_WS+NW*64*4, LDS_BYTES=LDS_OST+NW*4096;
constexpr int LDS_TB=86016, LDS_F2=102400, LDS_BYTES_X=118784;
constexpr float C2=0.125f*1.4426950408889634f;
__device__ __forceinline__ void glds16(const void*gsrc,unsigned lds_dst){unsigned keep;
  asm volatile("s_mov_b32 %0, m0\n\ts_mov_b32 m0, %2\n\ts_nop 0\n\tglobal_load_lds_dwordx4 %1, off\n\ts_mov_b32 m0, %0":"=&s"(keep):"v"(gsrc),"s"(lds_dst):"memory");}
__device__ __forceinline__ float max3f(float a,float b,float c){float r;asm("v_max3_f32 %0, %1, %2, %3":"=v"(r):"v"(a),"v"(b),"v"(c));return r;}
__device__ __forceinline__ float max2f(float a,float b){float r;asm("v_max_f32_e32 %0, %1, %2":"=v"(r):"v"(a),"v"(b));return r;}
__device__ __forceinline__ float fadd_s(float a,float b){float r;asm("v_add_f32_e32 %0, %1, %2":"=v"(r):"v"(a),"v"(b));return r;}
__device__ __forceinline__ float fsub_s(float a,float b){float r;asm("v_sub_f32_e32 %0, %1, %2":"=v"(r):"v"(a),"v"(b));return r;}
typedef float f32x4_t __attribute__((ext_vector_type(4))); typedef float f32x2_t __attribute__((ext_vector_type(2))); typedef __bf16 bf16x2_t __attribute__((ext_vector_type(2)));
__device__ __forceinline__ unsigned cvtpk_s(float lo,float hi){f32x2_t v={lo,hi};bf16x2_t b=__builtin_convertvector(v,bf16x2_t);return __builtin_bit_cast(unsigned,b);}
#define WAIT_BAR(N) asm volatile("s_waitcnt vmcnt(" #N ") lgkmcnt(0)\n\ts_barrier":::"memory")

__device__ __forceinline__ void qkt(f32x16&p0,f32x16&p1,const char*Kslot,const bf16x8*qr,const f32x16&negm,int r32,int hi){
  const char*kb=Kslot+hi*1024+r32*16;
  #pragma unroll
  for(int d0=0;d0<4;++d0){
    const bf16x8 b0=*reinterpret_cast<const bf16x8*>(kb+d0*2048);
    const bf16x8 b1=*reinterpret_cast<const bf16x8*>(kb+d0*2048+512);
    if(d0==0){p0=__builtin_amdgcn_mfma_f32_32x32x16_bf16(b0,qr[0],negm,0,0,0);p1=__builtin_amdgcn_mfma_f32_32x32x16_bf16(b1,qr[0],negm,0,0,0);}
    else{p0=__builtin_amdgcn_mfma_f32_32x32x16_bf16(b0,qr[d0],p0,0,0,0);p1=__builtin_amdgcn_mfma_f32_32x32x16_bf16(b1,qr[d0],p1,0,0,0);}}
}
typedef __attribute__((address_space(3))) const char* lds_cptr;
typedef short v4i16_t __attribute__((ext_vector_type(4)));
__device__ __forceinline__ void kload8(bf16x8*kf,lds_cptr kp){
  kf[0]=*(const __attribute__((address_space(3))) bf16x8*)(kp);      kf[1]=*(const __attribute__((address_space(3))) bf16x8*)(kp+512);
  kf[2]=*(const __attribute__((address_space(3))) bf16x8*)(kp+2048); kf[3]=*(const __attribute__((address_space(3))) bf16x8*)(kp+2560);
  kf[4]=*(const __attribute__((address_space(3))) bf16x8*)(kp+4096); kf[5]=*(const __attribute__((address_space(3))) bf16x8*)(kp+4608);
  kf[6]=*(const __attribute__((address_space(3))) bf16x8*)(kp+6144); kf[7]=*(const __attribute__((address_space(3))) bf16x8*)(kp+6656);
}
__device__ __forceinline__ void kload2(bf16x8*kf,lds_cptr kp,int j){ kf[2*j]=*(const __attribute__((address_space(3))) bf16x8*)(kp+j*2048); kf[2*j+1]=*(const __attribute__((address_space(3))) bf16x8*)(kp+j*2048+512); }
__device__ __forceinline__ s16x4 vtr(lds_cptr p){ return __builtin_bit_cast(s16x4,__builtin_amdgcn_ds_read_tr16_b64_v4i16((__attribute__((address_space(3))) v4i16_t*)p)); }
__device__ __forceinline__ float rowmax(const f32x16&p0,const f32x16&p1){
  float a=max3f(p0[0],p0[1],p1[0]),b=max3f(p0[2],p0[3],p1[1]);a=max3f(a,p1[2],p1[3]);
  #pragma unroll
  for(int r=4;r<16;r+=4){a=max3f(a,p0[r],p0[r+1]);b=max3f(b,p0[r+2],p0[r+3]);a=max3f(a,p1[r],p1[r+1]);b=max3f(b,p1[r+2],p1[r+3]);}
  const float m=max2f(a,b);
  auto rr=__builtin_amdgcn_permlane32_swap(__float_as_uint(m),__float_as_uint(m),false,false);
  return max2f(__uint_as_float(rr[0]),__uint_as_float(rr[1]));
}
__device__ __forceinline__ void pv(f32x16*o,int vb,bf16x8 pa0,bf16x8 pa1,bf16x8 pa2,bf16x8 pa3){
  #pragma unroll
  for(int d0=0;d0<2;++d0){s16x4 lo[4],hi[4];
    #pragma unroll
    for(int ks=0;ks<4;++ks){
      asm volatile("ds_read_b64_tr_b16 %0,%1 offset:%c2":"=&v"(lo[ks]):"v"(vb),"i"(d0*4096+ks*1024):"memory");
      asm volatile("ds_read_b64_tr_b16 %0,%1 offset:%c2":"=&v"(hi[ks]):"v"(vb),"i"(d0*4096+ks*1024+512):"memory");}
    asm volatile("s_waitcnt lgkmcnt(0)":::"memory");SBAR();
    #define PK(k) (bf16x8){lo[k][0],lo[k][1],lo[k][2],lo[k][3],hi[k][0],hi[k][1],hi[k][2],hi[k][3]}
    o[d0]=__builtin_amdgcn_mfma_f32_32x32x16_bf16(pa0,PK(0),o[d0],0,0,0);
    o[d0]=__builtin_amdgcn_mfma_f32_32x32x16_bf16(pa1,PK(1),o[d0],0,0,0);
    o[d0]=__builtin_amdgcn_mfma_f32_32x32x16_bf16(pa2,PK(2),o[d0],0,0,0);
    o[d0]=__builtin_amdgcn_mfma_f32_32x32x16_bf16(pa3,PK(3),o[d0],0,0,0);
    #undef PK
  }
}

#ifndef ATTN_STORE16
#define ATTN_STORE16(p,v) (*(u32x4*)(p)=(v))
#endif
template<int THRL> __device__ __forceinline__ void attn_unit(int b,int h,int qb,int t0,const bf16*Q,const bf16*__restrict__ K,const bf16*__restrict__ V,bf16*O,char*shm){
  int tid_=threadIdx.x; asm volatile("":"+v"(tid_)); const int tid=tid_,lane=tid&63,r32=lane&31,hi=lane>>5; const int wid=__builtin_amdgcn_readfirstlane(tid>>6);
  const long rowbase=(long)b*SEQ; const int q0=qb*QB;
  const bf16*Qw=Q+(rowbase+q0+wid*QBLK)*DM+h*D;
  const bf16*Kh=K+(rowbase+(long)t0*KVBLK)*DM+h*D,*Vh=V+(rowbase+(long)t0*KVBLK)*DM+h*D;
  const unsigned lds0=(unsigned)(uintptr_t)shm;
  float*wsf=(float*)(shm+LDS_WS)+wid*64;
  typedef __attribute__((address_space(3))) float lds_f32; typedef __attribute__((address_space(3))) const f32x4_t lds_cf4;
  const lds_f32*tbp=(const lds_f32*)(shm+LDS_F2)+4*hi+64*t0;
  #define TBADD(C0,C1,t) do{ const lds_cf4*tq_=(const lds_cf4*)(tbp+64*(t)); \
    { const f32x4_t a0_=tq_[0],a1_=tq_[2],a2_=tq_[4],a3_=tq_[6]; _Pragma("unroll") for(int v_=0;v_<4;++v_){C0[v_]+=a0_[v_];C0[4+v_]+=a1_[v_];C0[8+v_]+=a2_[v_];C0[12+v_]+=a3_[v_];} } \
    { const f32x4_t a0_=tq_[8],a1_=tq_[10],a2_=tq_[12],a3_=tq_[14]; _Pragma("unroll") for(int v_=0;v_<4;++v_){C1[v_]+=a0_[v_];C1[4+v_]+=a1_[v_];C1[8+v_]+=a2_[v_];C1[12+v_]+=a3_[v_];} } }while(0)
  const bf16*ksrc=Kh+(long)lane*DM+wid*8;
  const bf16*vsrc=Vh+(long)(16*(wid&3)+(lane>>2))*DM+(wid>>2)*32+(lane&3)*8;
  const unsigned kdst=lds0+LDS_K+wid*1024, vdst=lds0+LDS_V+wid*1024;
  #define DMA_K(t,slot) glds16(ksrc+(long)(t)*KVBLK*DM,(unsigned)__builtin_amdgcn_readfirstlane(kdst+(slot)))
  #define DMA_V(t,slot) glds16(vsrc+(long)(t)*KVBLK*DM,(unsigned)__builtin_amdgcn_readfirstlane(vdst+(slot)))
  const int vb0=(int)(lds0+LDS_V)+((lane>>4)&1)*32+(lane&3)*8+(4*hi+((lane&15)>>2))*64;
  const char*Kbase=shm+LDS_K; bf16x8 kf[8];
  const lds_cptr shm3=(lds_cptr)shm; const lds_cptr kp0=shm3+LDS_K+hi*1024+r32*16; const lds_cptr vp0=shm3+LDS_V+((lane>>4)&1)*32+(lane&3)*8+(4*hi+((lane&15)>>2))*64;
  const int NT=(q0+QB)/KVBLK-t0;
  DMA_K(0,0);DMA_V(0,0);DMA_K(1,SLOTB);
  bf16x8 qr[4];
  #pragma unroll
  for(int d0=0;d0<4;++d0)qr[d0]=*reinterpret_cast<const bf16x8*>(&Qw[(long)r32*DM+d0*16+hi*8]);
  float zero_;asm volatile("v_mov_b32 %0, 0":"=v"(zero_));
  float mhat=zero_,l_reg=zero_;f32x16 o[2],negm;
  _Pragma("unroll") for(int r=0;r<16;++r){o[0][r]=zero_;o[1][r]=zero_;negm[r]=zero_;} asm volatile("":"+v"(negm));
  const int qrel=wid*QBLK+r32;
  #define CMASK(P0,P1,t) do{int jb_=(t)-(NT-4); if(jb_>=0)cmask(P0,P1,jb_,qrel,hi);}while(0)
  bool resc=false;
  #define START(P0,P1) do{ const float rm=rowmax(P0,P1); resc=false; \
    { const float dl=rm; mhat=fadd_s(mhat,dl); \
      _Pragma("unroll") for(int r=0;r<16;++r){P0[r]=fsub_s(P0[r],dl);P1[r]=fsub_s(P1[r],dl);} \
      _Pragma("unroll") for(int r=0;r<16;++r)negm[r]=-mhat; asm volatile("":"+v"(negm)); } \
    _Pragma("unroll") for(int r=0;r<16;++r)P0[r]=__builtin_amdgcn_exp2f(P0[r]); }while(0)
  #define RESC() do{ if(resc){ asm volatile("s_waitcnt lgkmcnt(0)":::"memory"); \
      _Pragma("unroll") for(int d_=0;d_<2;++d_) _Pragma("unroll") for(int r=0;r<16;++r)o[d_][r]*=wsf[crow(r,hi)]; } }while(0)
  f32x16 pA0,pA1,pB0,pB1;
  int sl_prev=0,sl_cur=0,sl_next=SLOTB;
  #define ROT() do{sl_prev=sl_cur;sl_cur=sl_next;sl_next=(sl_next==(NSLOT-1)*SLOTB)?0:sl_next+SLOTB;}while(0)
  DMA_K(2,2*SLOTB);
  WAIT_BAR(3);
  qkt(pA0,pA1,Kbase,qr,negm,r32,hi);asm volatile("s_nop 15\n\ts_nop 7":"+v"(pA0),"+v"(pA1));TBADD(pA0,pA1,0);CMASK(pA0,pA1,0);
  START(pA0,pA1);
  _Pragma("unroll") for(int r=0;r<16;++r)pA1[r]=__builtin_amdgcn_exp2f(pA1[r]);
  WAIT_BAR(0);
  DMA_K(3,0);DMA_V(1,SLOTB);
  ROT();
  kload8(kf,kp0+sl_cur);
  WAIT_BAR(2);
  s16x4 vlo[8],vhi[8]; u32x4 pw0,pw1,pw2,pw3;
  #define PKW(P,B) cvtpk_s(P[B],P[B+1])
  #define PAF(k) __builtin_bit_cast(bf16x8,pw##k)
  #define VFR(i) (bf16x8){vlo[i][0],vlo[i][1],vlo[i][2],vlo[i][3],vhi[i][0],vhi[i][1],vhi[i][2],vhi[i][3]}
  #define PIN(x) asm volatile("":"+v"(x))
  #define MX3(a,b,c) __builtin_fmaxf(__builtin_fmaxf((a),(b)),(c))
  #define GAPA(MF,A0,A1,A2,A3,W0,W1,PW) do{ MF; sacc+=A0; sacc+=A1; sacc+=A2; sacc+=A3; PIN(sacc); W0; W1; PIN(PW); SBAR(); }while(0)
  #define EX(v) __builtin_amdgcn_exp2f(v)
  #define GAPB(MF,X,B) do{ MF; X[B]=EX(X[B]); X[B+1]=EX(X[B+1]); X[B+2]=EX(X[B+2]); X[B+3]=EX(X[B+3]); PIN(X); SBAR(); }while(0)
  #define VRD(i) do{ vlo[i]=vtr(vp_+(((i)>>2)*4096+((i)&3)*1024)); vhi[i]=vtr(vp_+(((i)>>2)*4096+((i)&3)*1024+512)); }while(0)
  #define KRD(G,j) do{ if(G){ kload2(kf,kp0+sl_next,j); SBAR(); } }while(0)
  #define STEP(C0,C1,P0,P1,t,GK,GV,GL) do{ SBAR(); \
    const lds_cptr vp_=vp0+sl_prev; \
    VRD(0); SBAR(); float sacc=(P0[0]+P0[1]); \
    GAPA(C0=__builtin_amdgcn_mfma_f32_32x32x16_bf16(kf[0],qr[0],negm,0,0,0), P0[2],P0[3],P0[4],P0[5],     pw0[0]=PKW(P0,0), pw0[1]=PKW(P0,2), pw0); \
    VRD(4); SBAR(); GAPA(C1=__builtin_amdgcn_mfma_f32_32x32x16_bf16(kf[1],qr[0],negm,0,0,0), P0[6],P0[7],P0[8],P0[9],     pw0[2]=PKW(P0,4), pw0[3]=PKW(P0,6), pw0); \
    VRD(1); SBAR(); GAPA(C0=__builtin_amdgcn_mfma_f32_32x32x16_bf16(kf[2],qr[1],C0,0,0,0),   P0[10],P0[11],P0[12],P0[13], pw1[0]=PKW(P0,8), pw1[1]=PKW(P0,10), pw1); \
    VRD(5); SBAR(); GAPA(C1=__builtin_amdgcn_mfma_f32_32x32x16_bf16(kf[3],qr[1],C1,0,0,0),   P0[14],P0[15],P1[0],P1[1],   pw1[2]=PKW(P0,12),pw1[3]=PKW(P0,14), pw1); \
    VRD(2); SBAR(); GAPA(C0=__builtin_amdgcn_mfma_f32_32x32x16_bf16(kf[4],qr[2],C0,0,0,0),   P1[2],P1[3],P1[4],P1[5],     pw2[0]=PKW(P1,0), pw2[1]=PKW(P1,2), pw2); \
    VRD(6); SBAR(); GAPA(C1=__builtin_amdgcn_mfma_f32_32x32x16_bf16(kf[5],qr[2],C1,0,0,0),   P1[6],P1[7],P1[8],P1[9],     pw2[2]=PKW(P1,4), pw2[3]=PKW(P1,6), pw2); \
    VRD(3); SBAR(); GAPA(C0=__builtin_amdgcn_mfma_f32_32x32x16_bf16(kf[6],qr[3],C0,0,0,0),   P1[10],P1[11],P1[12],P1[13], pw3[0]=PKW(P1,8), pw3[1]=PKW(P1,10), pw3); \
    VRD(7); SBAR(); GAPA(C1=__builtin_amdgcn_mfma_f32_32x32x16_bf16(kf[7],qr[3],C1,0,0,0),   P1[14],P1[15],0.f,0.f,       pw3[2]=PKW(P1,12),pw3[3]=PKW(P1,14), pw3); \
    l_reg+=sacc; \
    if(GK){DMA_K((t)+3,sl_cur);} if(GV){DMA_V((t)+1,sl_next);} \
    TBADD(C0,C1,t); CMASK(C0,C1,t); \
    { float a=MX3(C0[0],C0[1],C1[0]),b=MX3(C0[2],C0[3],C1[1]); a=MX3(a,C1[2],C1[3]); \
      _Pragma("unroll") for(int r=4;r<16;r+=4){a=MX3(a,C0[r],C0[r+1]);b=MX3(b,C0[r+2],C0[r+3]);a=MX3(a,C1[r],C1[r+1]);b=MX3(b,C1[r+2],C1[r+3]);} \
      float rm=__builtin_fmaxf(a,b); { auto rr=__builtin_amdgcn_permlane32_swap(__float_as_uint(rm),__float_as_uint(rm),false,false); rm=__builtin_fmaxf(__uint_as_float(rr[0]),__uint_as_float(rr[1])); } \
      resc=false; \
      if(__builtin_expect(__any(rm>(float)THRL),0)){ const float dl=__builtin_fmaxf(rm,0.f); mhat+=dl; \
        _Pragma("unroll") for(int r=0;r<16;++r){C0[r]-=dl;C1[r]-=dl;} \
        _Pragma("unroll") for(int r=0;r<16;++r)negm[r]=-mhat; asm volatile("":"+v"(negm)); \
        const float f=__builtin_amdgcn_exp2f(-dl); l_reg*=f; if(hi==0)wsf[r32]=f; resc=true; } } \
    SBAR(); \
    GAPB(o[0]=__builtin_amdgcn_mfma_f32_32x32x16_bf16(PAF(0),VFR(0),o[0],0,0,0), C0,0); \
    GAPB(o[1]=__builtin_amdgcn_mfma_f32_32x32x16_bf16(PAF(0),VFR(4),o[1],0,0,0), C0,4); \
    KRD(GL,0); GAPB(o[0]=__builtin_amdgcn_mfma_f32_32x32x16_bf16(PAF(1),VFR(1),o[0],0,0,0), C0,8); \
    KRD(GL,1); GAPB(o[1]=__builtin_amdgcn_mfma_f32_32x32x16_bf16(PAF(1),VFR(5),o[1],0,0,0), C0,12); \
    KRD(GL,2); GAPB(o[0]=__builtin_amdgcn_mfma_f32_32x32x16_bf16(PAF(2),VFR(2),o[0],0,0,0), C1,0); \
    KRD(GL,3); GAPB(o[1]=__builtin_amdgcn_mfma_f32_32x32x16_bf16(PAF(2),VFR(6),o[1],0,0,0), C1,4); \
    GAPB(o[0]=__builtin_amdgcn_mfma_f32_32x32x16_bf16(PAF(3),VFR(3),o[0],0,0,0), C1,8); \
    GAPB(o[1]=__builtin_amdgcn_mfma_f32_32x32x16_bf16(PAF(3),VFR(7),o[1],0,0,0), C1,12); \
    }while(0)
  int t=1;
  #undef CMASK
  #define CMASK(P0,P1,t) do{}while(0)
  for(;t+5<NT;t+=2){
    STEP(pB0,pB1,pA0,pA1,t,true,true,true);     WAIT_BAR(2); RESC(); ROT();
    STEP(pA0,pA1,pB0,pB1,t+1,true,true,true);   WAIT_BAR(2); RESC(); ROT();
  }
  #undef CMASK
  #define CMASK(P0,P1,t) do{int jb_=(t)-(NT-4); if(jb_>=0)cmask(P0,P1,jb_,qrel,hi);}while(0)
  #define ENDW(tt) do{ if((tt)+3<NT){WAIT_BAR(2);} else if((tt)+2<NT){WAIT_BAR(1);} else {WAIT_BAR(0);} }while(0)
  for(;t+1<NT;t+=2){
    STEP(pB0,pB1,pA0,pA1,t,(t+3<NT),(t+1<NT),(t+1<NT));       ENDW(t);   RESC(); ROT();
    STEP(pA0,pA1,pB0,pB1,t+1,(t+4<NT),(t+2<NT),(t+2<NT));     ENDW(t+1); RESC(); ROT();
  }
  STEP(pB0,pB1,pA0,pA1,NT-1,false,false,false); RESC();
  { float sacc=pB0[0]+pB0[1]; _Pragma("unroll") for(int r=2;r<16;++r)sacc+=pB0[r]; _Pragma("unroll") for(int r=0;r<16;++r)sacc+=pB1[r]; l_reg+=sacc;
    pw0=(u32x4){PKW(pB0,0),PKW(pB0,2),PKW(pB0,4),PKW(pB0,6)};pw1=(u32x4){PKW(pB0,8),PKW(pB0,10),PKW(pB0,12),PKW(pB0,14)};pw2=(u32x4){PKW(pB1,0),PKW(pB1,2),PKW(pB1,4),PKW(pB1,6)};pw3=(u32x4){PKW(pB1,8),PKW(pB1,10),PKW(pB1,12),PKW(pB1,14)};
    SBAR(); pv(o,vb0+sl_cur,PAF(0),PAF(1),PAF(2),PAF(3)); }
  #undef PKW
  #undef PAF
  #undef VFR
  #undef PIN
  #undef MX3
  #undef GAPA
  #undef GAPB
  #undef EX
  #undef VRD
  #undef KRD
  #undef STEP
  #undef ENDW
  {auto rr=__builtin_amdgcn_permlane32_swap(__float_as_uint(l_reg),__float_as_uint(l_reg),false,false);l_reg=__uint_as_float(rr[0])+__uint_as_float(rr[1]);}
  if(hi==0)wsf[32+r32]=l_reg;asm volatile("s_waitcnt lgkmcnt(0)":::"memory");
  float rli[16];
  #pragma unroll
  for(int r=0;r<16;++r)rli[r]=__builtin_amdgcn_rcpf(wsf[32+crow(r,hi)]);
  bf16*Ow=O+(rowbase+q0+wid*QBLK)*OPITCH+h*D;
  { bf16*stg=(bf16*)(shm+LDS_OST)+wid*2048;
    #pragma unroll
    for(int r=0;r<16;++r){const int orow=crow(r,hi);
      #pragma unroll
      for(int d0=0;d0<2;++d0)stg[orow*64+d0*32+r32]=__float2bfloat16(o[d0][r]*rli[r]);}
    asm volatile("s_waitcnt lgkmcnt(0)":::"memory");
    int ln2_; asm volatile("v_mbcnt_lo_u32_b32 %0, -1, 0\n\tv_mbcnt_hi_u32_b32 %0, -1, %0":"=v"(ln2_));
    #pragma unroll
    for(int i=0;i<4;++i){const int row=i*8+(ln2_>>3),ch=ln2_&7; const u32x4 v=*(const u32x4*)(stg+row*64+ch*8); ATTN_STORE16(Ow+(long)row*OPITCH+ch*8,v);} }
  asm volatile("s_waitcnt lgkmcnt(0)\n\ts_barrier":::"memory");
  #undef TBADD
  #undef DMA_K
  #undef DMA_V
  #undef CMASK
  #undef START
  #undef RESC
  #undef ROT
}
constexpr int ATTN_LDS_BYTES=LDS_BYTES;
struct AttnTensors { const bf16* Q; const bf16* K; const bf16* V; bf16* O; };
struct AttnUnit { int bh; int qb; };
#undef SBAR
#undef WAIT_BAR
}
constexpr int NWAVES = 8;
constexpr int DM = 1024, MP = 16384, MS = 512, MT = MP + MS;
constexpr int SEQ = 4096, NB = 4, DB = 128, DT = 4;
constexpr int DIN = 5648, NIN = 5632, DFF = 2816, NGU = 5632, PLE = 256;
constexpr int HM_ = 4, DKM = 128, HF = 8, DHF = 64, WM = 512, WF = 512;
constexpr int PAST = 2048, PAGE = 128, NPAGES = 16;
constexpr float EPS = 1e-6f;
constexpr float LOG2E = 1.4426950408889634f;
constexpr float C2Q = 0.125f * LOG2E;
constexpr size_t O_YP = 0, O_YS = (size_t)MP * DM, O_KP = O_YS + (size_t)MS * DM, O_VP = O_KP + (size_t)MP * 512, O_LFP = O_VP + (size_t)MP * 512,
    O_CP = O_LFP + (size_t)MP * 8, O_NP = O_CP + (size_t)NB * HM_ * 128 * 128, O_MPR = O_NP + (size_t)NB * HM_ * 128, O_KS = O_MPR + NB * HM_,
    O_VS = O_KS + (size_t)MS * 512, O_LFS = O_VS + (size_t)MS * 512, O_CS = O_LFS + (size_t)MS * 8, O_NS = O_CS + (size_t)DB * HM_ * 128 * 128,
    O_MS = O_NS + (size_t)DB * HM_ * 128, O_END = O_MS + (size_t)DB * HM_;
static_assert(O_END == 43457040, "d_out size");
constexpr size_t MiB = 1u << 20;
constexpr size_t WS_CTL = 0, CTL_ZERO_BYTES = 1 * MiB;
constexpr size_t WS_WIN = 2 * MiB, WS_WGU = 13 * MiB, WS_WDN = 24 * MiB, WS_WOUT = 30 * MiB, WS_WPG = 32 * MiB, WS_WPA = 34 * MiB, WS_WPB = 35 * MiB, WS_WPP = 36 * MiB;
constexpr size_t WS_GATES = 38 * MiB, WS_SSQ2 = 40 * MiB, WS_SSQ3 = 42 * MiB, WS_MISC = 44 * MiB;
constexpr size_t WS_XN = 64 * MiB, WS_PB = 98 * MiB, WS_MQ = 108 * MiB, WS_MK = 125 * MiB, WS_MV = 142 * MiB, WS_MO = 159 * MiB, WS_FQ = 176 * MiB, WS_FK = 193 * MiB, WS_FV = 210 * MiB,
    WS_HM = 227 * MiB, WS_YF = 244 * MiB, WS_GA = 262 * MiB, WS_GB = 296 * MiB, WS_U = 330 * MiB, WS_X1 = 364 * MiB, WS_A2 = 431 * MiB, WS_HB = 465 * MiB, WS_A3 = 557 * MiB, WS_TP = 591 * MiB,
    WS_LT = 625 * MiB, WS_CT = 658 * MiB, WS_HY = 680 * MiB, WS_END = 714 * MiB;
constexpr size_t MI_CHS = 0;
constexpr size_t MI_MC = 8192;
constexpr size_t MI_NL = 16384;
constexpr size_t MI_NC = MI_NL + 512 * 128 * 4;
constexpr size_t MI_F2 = 12 * MiB;
constexpr size_t MI_DEC = 1 * MiB;
constexpr int CW_TMO = 0, CW_CODE = 1, CW_BAR = 4096;

constexpr int RING_OFF = 0, RING_BYTES = 131072;
constexpr int LDSCTL_OFF = RING_BYTES, MISC_OFF = LDSCTL_OFF + 320;
constexpr int LDS_BYTES = 147456;
#define GAS __attribute__((address_space(1)))
#define LAS __attribute__((address_space(3)))
typedef unsigned short bf16;
typedef unsigned v4u __attribute__((ext_vector_type(4)));
typedef float f32x4 __attribute__((ext_vector_type(4)));
typedef short bf16x8 __attribute__((ext_vector_type(8)));
typedef GAS unsigned gu32;
typedef GAS unsigned long long gu64;
#define RLX_AGENT __ATOMIC_RELAXED, __HIP_MEMORY_SCOPE_AGENT
#define LDS_WAIT() asm volatile("s_waitcnt lgkmcnt(0)" ::: "memory")
#define VM_WAIT() asm volatile("s_waitcnt vmcnt(0)" ::: "memory")
__device__ __forceinline__ unsigned long long rt() { return __builtin_amdgcn_s_memrealtime(); }
__device__ __forceinline__ unsigned f2bf(float f) { unsigned u = __builtin_bit_cast(unsigned, f); return (u + 0x7fffu + ((u >> 16) & 1u)) >> 16; }
__device__ __forceinline__ unsigned pk2(float lo, float hi) { return f2bf(lo) | (f2bf(hi) << 16); }

#define XB_TMO      128
#define XB_XCNT(j)  (256  + 64 * (j))
#define XB_XSUB(j)  (1280 + 64 * (j))
#define XB_XGEN(j)  (2304 + 64 * (j))
#define XB_TOP      3328
#define XB_TOPGEN   3392
#define XCD_BAR_WORDS 3456
#define XB_SPIN_CAP (1u << 18)

__device__ __forceinline__ unsigned xb_ld(unsigned* p)              { return __hip_atomic_load(p, __ATOMIC_RELAXED, __HIP_MEMORY_SCOPE_AGENT); }
__device__ __forceinline__ unsigned xb_add(unsigned* p, unsigned v) { return __hip_atomic_fetch_add(p, v, __ATOMIC_RELAXED, __HIP_MEMORY_SCOPE_AGENT); }
__device__ __forceinline__ unsigned xb_xcc_id() { return (unsigned)__builtin_amdgcn_s_getreg((3 << 11) | 20) & 0xFu; }
#define XB_SPIN(cond, bar) do { unsigned _sp = 0; while (cond) { __builtin_amdgcn_s_sleep(1); \
    if ((++_sp & 255u) == 0u) { if (xb_ld(&(bar)[XB_TMO])) break; if (_sp > XB_SPIN_CAP) { atomicAdd(&(bar)[XB_TMO], 1u); break; } } } } while (0)

struct XcdBarrier {
    unsigned* bar; unsigned x;
    volatile LAS unsigned* st;
};

__device__ __forceinline__ XcdBarrier xcd_barrier_post(unsigned* bar, volatile LAS unsigned* st) {
    XcdBarrier b; b.bar = bar; b.x = xb_xcc_id(); b.st = st;
    if (threadIdx.x == 0) (void)xb_add(&bar[XB_XCNT(b.x)], 1u);
    return b;
}
__device__ __forceinline__ void xcd_barrier_complete(unsigned* bar, unsigned x, unsigned& nloc, unsigned& nx) {
    const unsigned G = gridDim.x * gridDim.y * gridDim.z;
    unsigned sum, cnt, mine, sp = 0u;
    for (;;) {
        sum = 0u; cnt = 0u; mine = 0u;
#pragma unroll
        for (unsigned j = 0; j < 16; ++j) { const unsigned c = xb_ld(&bar[XB_XCNT(j)]); sum += c; cnt += (c > 0u) ? 1u : 0u; mine = (j == x) ? c : mine; }
        if (sum == G) break;
        __builtin_amdgcn_s_sleep(1);
        if ((++sp & 255u) == 0u) { if (xb_ld(&bar[XB_TMO])) break; if (sp > XB_SPIN_CAP) { atomicAdd(&bar[XB_TMO], 1u); break; } }
    }
    nloc = mine > 0u ? mine : 1u; nx = cnt > 0u ? cnt : 1u;
}

__device__ __forceinline__ void xcd_barrier(const XcdBarrier& b) {
    asm volatile("s_waitcnt vmcnt(0)" ::: "memory");
    __syncthreads();
    if (threadIdx.x == 0) {
        unsigned* bar = b.bar;
        __builtin_amdgcn_s_waitcnt(0);
        unsigned nloc = b.st[0], nx = b.st[1];
        if (nloc == 0u) { xcd_barrier_complete(bar, b.x, nloc, nx); b.st[0] = nloc; b.st[1] = nx; }
        const unsigned old = xb_add(&bar[XB_XSUB(b.x)], 1u);
        const unsigned gen = old / nloc;
        if (old + 1u == (gen + 1u) * nloc) {
            __builtin_amdgcn_fence(__ATOMIC_RELEASE, "agent");
            asm volatile("s_waitcnt vmcnt(0)" ::: "memory");
            const unsigned og = xb_add(&bar[XB_TOP], 1u);
            const unsigned tg = og / nx;
            if (og + 1u == (tg + 1u) * nx) xb_add(&bar[XB_TOPGEN], 1u);
            else XB_SPIN(xb_ld(&bar[XB_TOPGEN]) == tg, bar);
            __builtin_amdgcn_fence(__ATOMIC_ACQUIRE, "agent");
            xb_add(&bar[XB_XGEN(b.x)], 1u);
            asm volatile("s_waitcnt vmcnt(0)" ::: "memory");
        } else {
            XB_SPIN(xb_ld(&bar[XB_XGEN(b.x)]) == gen, bar);
            __builtin_amdgcn_fence(__ATOMIC_ACQUIRE, "agent");
            asm volatile("s_waitcnt vmcnt(0)" ::: "memory");
        }
    }
    __syncthreads();
}
struct Frame {
    LAS unsigned char* lds;
    volatile LAS unsigned* MISC;
    gu32* ctl;
    int vcu, G;
    float* out; unsigned char* ws;
};
struct Args { const void* in[28]; float* out; unsigned char* ws; int ph_lo, ph_hi; };
#define IN_F(k) ((const float*)A.in[k])
#define I_XP IN_F(0)
#define I_XS IN_F(1)
#define I_PP IN_F(2)
#define I_PS IN_F(3)
#define I_CK IN_F(4)
#define I_CV IN_F(5)
#define I_CLF IN_F(6)
#define I_SC IN_F(7)
#define I_SN IN_F(8)
#define I_SM IN_F(9)
#define I_PT ((const int*)A.in[10])
#define I_GMIX IN_F(11)
#define I_WIN IN_F(12)
#define I_BMI IN_F(13)
#define I_BMF IN_F(14)
#define I_BFF IN_F(15)
#define I_GMH IN_F(16)
#define I_GQN IN_F(17)
#define I_GKN IN_F(18)
#define I_WPA IN_F(19)
#define I_WPB IN_F(20)
#define I_WOUT IN_F(21)
#define I_GFFN IN_F(22)
#define I_WGU IN_F(23)
#define I_WDN IN_F(24)
#define I_GPLE IN_F(25)
#define I_WPG IN_F(26)
#define I_WPP IN_F(27)
__device__ __forceinline__ float wave_sum(float v) {
#pragma unroll
    for (int o = 1; o < 64; o <<= 1) v += __shfl_xor(v, o);
    return v;
}
__device__ __forceinline__ float dot4f(f32x4 a) { return (a[0] * a[0] + a[1] * a[1]) + (a[2] * a[2] + a[3] * a[3]); }
__device__ __forceinline__ float logsig(float x) { return fminf(x, 0.f) - log1pf(expf(-fabsf(x))); }
__device__ __forceinline__ void p0_transpose_load(float (&wv_)[32], const float* W, int ldw, int src_col0, int k0, int lane) {
#pragma unroll
    for (int i = 0; i < 32; ++i) { const int kk = 2 * i + (lane >> 5); wv_[i] = W[(size_t)(k0 + kk) * ldw + src_col0 + (lane & 31)]; }
}
__device__ __forceinline__ void p0_transpose_finish(const float (&wv_)[32], int K, bf16* WT, int dst_row0, int k0, LAS float* scr, int lane, const float* kscale = nullptr, int dko = 0) {
#pragma unroll
    for (int i = 0; i < 32; ++i) { const int kk = 2 * i + (lane >> 5); float w = wv_[i]; if (kscale) w *= kscale[k0 + kk]; scr[kk * 33 + (lane & 31)] = w; }
    LDS_WAIT(); asm volatile("" ::: "memory");
    const int c = lane & 7;
#pragma unroll
    for (int j = 0; j < 4; ++j) { const int n = (lane >> 3) + 8 * j; const LAS float* s = scr + (8 * c) * 33 + n;
        v4u o; o.x = pk2(s[0 * 33], s[1 * 33]); o.y = pk2(s[2 * 33], s[3 * 33]); o.z = pk2(s[4 * 33], s[5 * 33]); o.w = pk2(s[6 * 33], s[7 * 33]);
        *(GAS v4u*)(WT + (size_t)(dst_row0 + n) * K + dko + k0 + 8 * c) = o; }
    LDS_WAIT(); asm volatile("" ::: "memory");
}
__device__ __forceinline__ void p0_transpose_item(const float* W, int ldw, int K, bf16* WT, int src_col0, int dst_row0, int k0, LAS float* scr, int lane, const float* kscale = nullptr, int dko = 0) {
    float wv_[32];
    p0_transpose_load(wv_, W, ldw, src_col0, k0, lane);
    p0_transpose_finish(wv_, K, WT, dst_row0, k0, scr, lane, kscale, dko);
}
__device__ __forceinline__ int hperm(int f) { return 256 * (f >> 8) + 128 * ((f & 63) >> 5) + 32 * ((f & 255) >> 6) + (f & 31); }
__device__ __forceinline__ void p0_win_item(int r, int& src, int& dst, int& k0) {
    const int blk = r >> 4, kb = r & 15; k0 = 64 * kb;
    if (blk < 64) { src = 32 * blk; dst = 32 * blk; }
    else if (blk < 80) { const int f = 32 * (blk - 64); src = 2056 + f; dst = 2048 + hperm(f); }
    else if (blk < 96) { const int f = 32 * (blk - 80); src = 2568 + f; dst = 2560 + hperm(f); }
    else if (blk < 112) { const int f = 32 * (blk - 96); src = 3080 + f; dst = 3072 + f; }
    else { const int f = 32 * (blk - 112); src = 3600 + f; dst = 3584 + f; }
}
__device__ __forceinline__ const float* xrow_ptr(const Args& A, int r) { return r < MP ? I_XP + (size_t)r * DM : I_XS + (size_t)(r - MP) * DM; }

constexpr int NI_IN = 176 * 16, NI_GU = 176 * 16, NI_DN = 32 * 44, NI_OUT = 32 * 16, NI_PG = 32 * 16, NI_PA = 32 * 8, NI_PB = 32 * 8, NI_PP = 32 * 4;
constexpr int NLATE = NI_GU + NI_DN + NI_OUT + NI_PG + NI_PA + NI_PB + NI_PP;
__device__ __forceinline__ void p0_late_item(const Args& A, unsigned char* ws, int r, LAS float* scr, int lane) {
    bf16* WGU = (bf16*)(ws + WS_WGU); bf16* WDN = (bf16*)(ws + WS_WDN); bf16* WOUT = (bf16*)(ws + WS_WOUT); bf16* WPG = (bf16*)(ws + WS_WPG); bf16* WPA = (bf16*)(ws + WS_WPA); bf16* WPB = (bf16*)(ws + WS_WPB); bf16* WPP = (bf16*)(ws + WS_WPP);
    do {
        if (r < NI_GU) { const int db = r >> 4, kb = r & 15; const int pn = db >> 3, q = db & 7, bj = q >> 2, wc = q & 3;
            p0_transpose_item(I_WGU, NGU, DM, WGU, bj * DFF + 128 * pn + 32 * wc, 32 * db, 64 * kb, scr, lane, I_GFFN); break; } r -= NI_GU;
        if (r < NI_DN) { const int blk = r / 44, kb = r % 44; p0_transpose_item(I_WDN, DM, DFF, WDN, 32 * blk, 32 * blk, 64 * kb, scr, lane); break; } r -= NI_DN;
        if (r < NI_OUT) { p0_transpose_item(I_WOUT, DM, DM, WOUT, 32 * (r >> 4), 32 * (r >> 4), 64 * (r & 15), scr, lane); break; } r -= NI_OUT;
        if (r < NI_PG) { p0_transpose_item(I_WPG, DM, DM, WPG, 32 * (r >> 4), 32 * (r >> 4), 64 * (r & 15), scr, lane, I_GPLE); break; } r -= NI_PG;
        if (r < NI_PA) { p0_transpose_item(I_WPA, DM, DM, WPA, 32 * (r >> 3), 32 * (r >> 3), 64 * (r & 7), scr, lane, nullptr, 0); break; } r -= NI_PA;
        if (r < NI_PB) { p0_transpose_item(I_WPB, DM, DM, WPA, 32 * (r >> 3), 32 * (r >> 3), 64 * (r & 7), scr, lane, nullptr, 512); break; } r -= NI_PB;
        p0_transpose_item(I_WPP, DM, PLE, WPP, 32 * (r >> 2), 32 * (r >> 2), 64 * (r & 3), scr, lane);
    } while (0);
}
template <int NR, bool PRE> __device__ __forceinline__ void p0_rows_trip(Frame& F, const Args& A, const int r0, const int lane, const LAS float* wl, bf16* XN, float* GT, const f32x4 (&xp)[4]) {
    const GAS f32x4* xr[NR];
#pragma unroll
    for (int q = 0; q < NR; ++q) xr[q] = (const GAS f32x4*)xrow_ptr(A, r0 + q) + lane;
    f32x4 xv[NR][4]; float ss[NR];
#pragma unroll
    for (int q = 0; q < NR; ++q) ss[q] = 0.f;
#pragma unroll
    for (int j = 0; j < 4; ++j)
#pragma unroll
        for (int q = 0; q < NR; ++q) { if constexpr (PRE) xv[q][j] = xp[j]; else xv[q][j] = xr[q][64 * j]; ss[q] += dot4f(xv[q][j]); }
    float rr[NR];
#pragma unroll
    for (int q = 0; q < NR; ++q) rr[q] = rsqrtf(wave_sum(ss[q]) * (1.f / DM) + EPS);
    float v[16 * NR];
#pragma unroll
    for (int c = 0; c < 16 * NR; ++c) v[c] = 0.f;
#pragma unroll
    for (int j = 0; j < 4; ++j) { const f32x4 gmj = ((const GAS f32x4*)I_GMIX)[64 * j + lane]; f32x4 vx[NR];
#pragma unroll
        for (int q = 0; q < NR; ++q) { vx[q] = xv[q][j] * rr[q] * gmj;
            ((GAS unsigned long long*)(XN + (size_t)(r0 + q) * DM) + lane)[64 * j] = (unsigned long long)pk2(vx[q].x, vx[q].y) | ((unsigned long long)pk2(vx[q].z, vx[q].w) << 32); }
#pragma unroll
        for (int e = 0; e < 4; ++e) { const LAS f32x4* wp = (const LAS f32x4*)(wl + 4352 * j + 16 * e);
#pragma unroll
            for (int qq = 0; qq < 4; ++qq) { const f32x4 w = wp[qq];
#pragma unroll
                for (int q = 0; q < NR; ++q) { const float xs = vx[q][e];
#pragma unroll
                    for (int t = 0; t < 4; ++t) v[16 * q + 4 * qq + t] += xs * w[t]; } }
            asm volatile("" ::: "memory"); } }
    if constexpr (NR == 4) {
#pragma unroll
        for (int i = 0; i < 32; ++i) { const bool up = (lane & 32) != 0; const float keep = up ? v[32 + i] : v[i], send = up ? v[i] : v[32 + i]; v[i] = keep + __shfl_xor(send, 32); }
#pragma unroll
        for (int i = 0; i < 16; ++i) { const bool up = (lane & 16) != 0; const float keep = up ? v[16 + i] : v[i], send = up ? v[i] : v[16 + i]; v[i] = keep + __shfl_xor(send, 16); }
    } else {
#pragma unroll
        for (int i = 0; i < 16; ++i) { v[i] += __shfl_xor(v[i], 32); v[i] += __shfl_xor(v[i], 16); }
    }
#pragma unroll
    for (int i = 0; i < 8; ++i) { const bool up = (lane & 8) != 0; const float keep = up ? v[8 + i] : v[i], send = up ? v[i] : v[8 + i]; v[i] = keep + __shfl_xor(send, 8); }
#pragma unroll
    for (int i = 0; i < 4; ++i) { const bool up = (lane & 4) != 0; const float keep = up ? v[4 + i] : v[i], send = up ? v[i] : v[4 + i]; v[i] = keep + __shfl_xor(send, 4); }
#pragma unroll
    for (int i = 0; i < 2; ++i) { const bool up = (lane & 2) != 0; const float keep = up ? v[2 + i] : v[i], send = up ? v[i] : v[2 + i]; v[i] = keep + __shfl_xor(send, 2); }
    { const bool up = (lane & 1) != 0; const float keep = up ? v[1] : v[0], send = up ? v[0] : v[1]; v[0] = keep + __shfl_xor(send, 1); }
    if (NR == 4 || lane < 16) { const int row = r0 + (NR == 4 ? (lane >> 4) : 0), c = lane & 15; float z = v[0], val;
        if (c < 4) val = z + I_BMI[c]; else if (c < 8) val = logsig(z + I_BMF[c - 4]); else { val = logsig(z + I_BFF[c - 8]);
            if (row < MP) F.out[O_LFP + (size_t)row * 8 + (c - 8)] = val; else F.out[O_LFS + (size_t)(row - MP) * 8 + (c - 8)] = val; }
        GT[(size_t)row * 16 + c] = val; }
}
__device__ __forceinline__ void p0_prologue(Frame& F, const Args& A, const int parts = 7) {
    int tid_ = threadIdx.x; asm volatile("" : "+v"(tid_)); const int tid = tid_, lane = tid & 63, wave = __builtin_amdgcn_readfirstlane(tid >> 6);
    LAS float* scr = (LAS float*)(F.lds + RING_OFF + wave * 16384);
    const int gw = F.vcu * NWAVES + wave, NGW = F.G * NWAVES;
    bf16* WIN = (bf16*)(F.ws + WS_WIN);
    if (parts & 1) {
        for (int it = gw; it < NI_IN; it += 2 * NGW) {
            const int it2 = it + NGW; const bool two = it2 < NI_IN; int s0, d0, k0, s1, d1, k1; p0_win_item(it, s0, d0, k0); p0_win_item(two ? it2 : it, s1, d1, k1);
            float wa[32], wb[32];
            p0_transpose_load(wa, I_WIN, DIN, s0, k0, lane); if (two) p0_transpose_load(wb, I_WIN, DIN, s1, k1, lane);
            p0_transpose_finish(wa, DM, WIN, d0, k0, scr, lane); if (two) p0_transpose_finish(wb, DM, WIN, d1, k1, scr, lane);
        }
    }
    f32x4 gw0[4], gw1[4];
    if (parts & 4) {
#pragma unroll
      for (int u = 0; u < 4; ++u) { const int i = tid + u * (NWAVES * 64), k = i >> 1, g = i & 1; const GAS f32x4* sp = (const GAS f32x4*)(I_WIN + (size_t)k * DIN + (g ? 3592 : 2048)); gw0[u] = sp[0]; gw1[u] = sp[1]; } }
    if (parts & 2) { bf16* PB = (bf16*)(F.ws + WS_PB); const int gt = F.vcu * (NWAVES * 64) + tid, NGT = F.G * NWAVES * 64;
      constexpr int NPB = MT * PLE / 4;
      for (int i0 = gt; i0 < NPB; i0 += 9 * NGT) { f32x4 v[9];
#pragma unroll
          for (int u = 0; u < 9; ++u) { const int i = i0 + u * NGT; const int e = (i < NPB ? i : gt) * 4; const float* src = e < MP * PLE ? I_PP + e : I_PS + (e - MP * PLE); v[u] = *(const GAS f32x4*)src; }
#pragma unroll
          for (int u = 0; u < 9; ++u) { const int i = i0 + u * NGT; if (i < NPB) *(GAS unsigned long long*)(PB + (size_t)i * 4) = (unsigned long long)pk2(v[u].x, v[u].y) | ((unsigned long long)pk2(v[u].z, v[u].w) << 32); } } }
    if (!(parts & 4)) return;
    __syncthreads();
    LAS float* wg = (LAS float*)(F.lds + RING_OFF);
    {
#pragma unroll
      for (int u = 0; u < 4; ++u) { const int i = tid + u * (NWAVES * 64), k = i >> 1, g = i & 1; LAS f32x4* dp = (LAS f32x4*)(wg + 16 * k + 4 * ((k >> 2) & 15) + 64 * (k >> 6) + 8 * g); dp[0] = gw0[u]; dp[1] = gw1[u]; } }
    __syncthreads();
    {
        bf16* XN = (bf16*)(F.ws + WS_XN); float* GT = (float*)(F.ws + WS_GATES);
        const LAS float* wl = wg + 64 * lane + 64 * (lane >> 4) + 4 * (lane & 15);
        const bool has1 = wave < 2 && 2 * F.vcu + wave < MS; const int r1 = MP + 2 * F.vcu + wave; f32x4 x1[4];
#pragma unroll
        for (int j = 0; j < 4; ++j) x1[j] = ((const GAS f32x4*)xrow_ptr(A, has1 ? r1 : MP) + lane)[64 * j];
        for (int pr = gw; pr < MP / 4; pr += NGW) p0_rows_trip<4, false>(F, A, 4 * pr, lane, wl, XN, GT, x1);
        if (has1) p0_rows_trip<1, true>(F, A, r1, lane, wl, XN, GT, x1);
        if (F.G * 2 < MS) for (int r = F.G * 2 + gw; r < MS; r += NGW) p0_rows_trip<1, false>(F, A, MP + r, lane, wl, XN, GT, x1);
    }
}
#define PHASE_IDS_ int tid_ = threadIdx.x; asm volatile("" : "+v"(tid_)); const int tid = tid_, lane = tid & 63, wave = __builtin_amdgcn_readfirstlane(tid >> 6)
#define OPAQUE_WS_ size_t wsoo_ = 0; asm volatile("" : "+s"(wsoo_)); unsigned char* ws = ws_ + wsoo_
typedef short s16x4v __attribute__((ext_vector_type(4)));
typedef short v4i16_t __attribute__((ext_vector_type(4)));
__device__ __forceinline__ s16x4v tr4(const LAS unsigned char* p) { return __builtin_bit_cast(s16x4v, __builtin_amdgcn_ds_read_tr16_b64_v4i16((LAS v4i16_t*)p)); }
__device__ __forceinline__ bf16x8 join8(s16x4v lo, s16x4v hi) { return (bf16x8){lo[0], lo[1], lo[2], lo[3], hi[0], hi[1], hi[2], hi[3]}; }
#define MFMA16(X, Y, C) __builtin_amdgcn_mfma_f32_16x16x32_bf16(X, Y, C, 0, 0, 0)
__device__ __forceinline__ float bflo(unsigned u) { return __uint_as_float(u << 16); }
__device__ __forceinline__ float bfhi(unsigned u) { return __uint_as_float(u & 0xffff0000u); }
__device__ __forceinline__ float bf2f(bf16 v) { return __uint_as_float(((unsigned)v) << 16); }
__device__ __forceinline__ void st4bf(bf16* p, f32x4 v) { *(GAS unsigned long long*)p = (unsigned long long)pk2(v.x, v.y) | ((unsigned long long)pk2(v.z, v.w) << 32); }
__device__ __forceinline__ f32x4 ld4bf(const bf16* p) { const unsigned long long w = *(const GAS unsigned long long*)p; return (f32x4){bflo((unsigned)w), bfhi((unsigned)w), bflo((unsigned)(w >> 32)), bfhi((unsigned)(w >> 32))}; }
constexpr int TP_ = 272;

__device__ __forceinline__ void chunk_scan(const float* GT  , int h, int tid, int lane, int wave, LAS float* sc, float& bj, float& gj, float& gpre, float& G, float& bend) {
    float lf = 0.f, ig = 0.f;
    if (tid < 128) { lf = GT[(size_t)tid * 16 + 4 + h]; ig = GT[(size_t)tid * 16 + h]; }
    float s = lf;
#pragma unroll
    for (int o = 1; o < 64; o <<= 1) { const float t = __shfl_up(s, o); if (lane >= o) s += t; }
    if (tid < 128 && lane == 63) sc[wave] = s;
    __syncthreads();
    if (wave == 1) s += sc[0];
    bj = s; gj = ig - bj;
    float pm = gj;
#pragma unroll
    for (int o = 1; o < 64; o <<= 1) { const float t = __shfl_up(pm, o); if (lane >= o) pm = fmaxf(pm, t); }
    if (tid < 128 && lane == 63) sc[2 + wave] = pm;
    if (tid == 127) sc[4] = s;
    __syncthreads();
    if (wave == 1) pm = fmaxf(pm, sc[2]);
    gpre = pm; G = fmaxf(sc[2], sc[3]); bend = sc[4];
}
struct KVRegs { v4u k[4], v[4]; };
__device__ __forceinline__ void load_kv(KVRegs& R, const bf16* MKp, const bf16* MVp, int tid) {
#pragma unroll
    for (int i = 0; i < 4; ++i) { const int s = (tid >> 4) + 32 * i, c16 = tid & 15; R.k[i] = *(const GAS v4u*)(MKp + (size_t)s * 512 + 8 * c16); R.v[i] = *(const GAS v4u*)(MVp + (size_t)s * 512 + 8 * c16); }
}
__device__ __forceinline__ void store_kv(const KVRegs& R, LAS unsigned char* KT, LAS unsigned char* VT, const LAS float* wkl, int tid) {
#pragma unroll
    for (int i = 0; i < 4; ++i) { const int s = (tid >> 4) + 32 * i, c16 = tid & 15; const v4u kv = R.k[i]; const float w = wkl[s];
        v4u o; o.x = pk2(bflo(kv.x) * w, bfhi(kv.x) * w); o.y = pk2(bflo(kv.y) * w, bfhi(kv.y) * w); o.z = pk2(bflo(kv.z) * w, bfhi(kv.z) * w); o.w = pk2(bflo(kv.w) * w, bfhi(kv.w) * w);
        *(LAS v4u*)(KT + s * TP_ + c16 * 16) = o; *(LAS v4u*)(VT + s * TP_ + c16 * 16) = R.v[i]; }
}
__device__ __forceinline__ void mlstm_a_unit(unsigned char* ws_, LAS unsigned char* lds, int u) {
    PHASE_IDS_; OPAQUE_WS_;
    const int bh = u >> 5, c = u & 31, b = bh >> 2, h = bh & 3; const int r0 = b * SEQ + c * 128;
    LAS unsigned char* KT = lds; LAS unsigned char* VT = lds + 128 * TP_; LAS float* wkl = (LAS float*)(lds + 2 * 128 * TP_); LAS float* sc = wkl + 128;
    KVRegs R; load_kv(R, (const bf16*)(ws + WS_MK) + (size_t)r0 * 512 + h * 128, (const bf16*)(ws + WS_MV) + (size_t)r0 * 512 + h * 128, tid);
    float bj, gj, gpre, G, bend; chunk_scan((const float*)(ws + WS_GATES) + (size_t)r0 * 16, h, tid, lane, wave, sc, bj, gj, gpre, G, bend);
    if (tid < 128) wkl[tid] = expf(gj - G);
    if (tid == 0) { float* chs = (float*)(ws + WS_MISC + MI_CHS) + u * 2; chs[0] = G; chs[1] = bend; }
    __syncthreads();
    store_kv(R, KT, VT, wkl, tid);
    __syncthreads();
    const int fr = lane & 15, fq = lane >> 4, q4 = (lane & 15) >> 2, p4 = lane & 3;
    f32x4 acc[8], accn = (f32x4){0.f, 0.f, 0.f, 0.f};
#pragma unroll
    for (int i = 0; i < 8; ++i) acc[i] = (f32x4){0.f, 0.f, 0.f, 0.f};
    const short one = fr == 0 ? (short)0x3F80 : (short)0; const bf16x8 ones = (bf16x8){one, one, one, one, one, one, one, one};
#pragma unroll
    for (int ks = 0; ks < 4; ++ks) { const int row = 32 * ks + 8 * fq + q4;
        const bf16x8 Y = join8(tr4(VT + row * TP_ + (16 * wave + 4 * p4) * 2), tr4(VT + (row + 4) * TP_ + (16 * wave + 4 * p4) * 2));
#pragma unroll
        for (int di = 0; di < 8; ++di) { const bf16x8 X = join8(tr4(KT + row * TP_ + (16 * di + 4 * p4) * 2), tr4(KT + (row + 4) * TP_ + (16 * di + 4 * p4) * 2));
            acc[di] = MFMA16(X, Y, acc[di]); if (di == wave) accn = MFMA16(X, ones, accn); } }
    float* LT = (float*)(ws + WS_LT) + (size_t)u * 16384;
#pragma unroll
    for (int di = 0; di < 8; ++di) *(GAS f32x4*)(LT + (16 * wave + fr) * 128 + 16 * di + 4 * fq) = acc[di];
    if (fr == 0) *(GAS f32x4*)((float*)(ws + WS_MISC + MI_NL) + (size_t)u * 128 + 16 * wave + 4 * fq) = accn;
    __syncthreads();
}
__device__ __forceinline__ void mlstm_b(unsigned char* ws, float* out, LAS unsigned char* lds, int vcu, int Gn, int tid) {
    const float* LTb = (const float*)(ws + WS_LT); bf16* CTb = (bf16*)(ws + WS_CT); const float* NL = (const float*)(ws + WS_MISC + MI_NL); float* NC = (float*)(ws + WS_MISC + MI_NC);
    for (int it = vcu; it < 256; it += Gn) { const int bh = it >> 4, part = it & 15;
        LAS float* decl = (LAS float*)lds; LAS float* fl = decl + 32; LAS float* chl = decl + 64; LAS float* mcl = decl + 128;
        if (tid < 64) chl[tid] = ((const float*)(ws + WS_MISC + MI_CHS) + (size_t)bh * 64)[tid];
        __syncthreads();
        if (tid == 0) { float m = 0.f;
            for (int c = 0; c < 32; ++c) { const float Gc = chl[2 * c], be = chl[2 * c + 1], Mx = fmaxf(m, Gc); decl[c] = expf(m - Mx); fl[c] = expf(Gc - Mx); mcl[c] = m; m = be + Mx; }
            mcl[32] = m; }
        __syncthreads();
        if (part == 0 && tid < 33) { ((float*)(ws + WS_MISC + MI_MC) + bh * 33)[tid] = mcl[tid]; if (tid == 32) out[O_MPR + bh] = mcl[32]; }
#pragma unroll
        for (int e2 = 0; e2 < 2; ++e2) { const int idx = part * 1024 + e2 * 512 + tid; float Cs = 0.f; const float* lt = LTb + (size_t)bh * 32 * 16384 + idx; bf16* ct = CTb + (size_t)bh * 32 * 16384 + idx;
            float ltv[32];
#pragma unroll
            for (int c = 0; c < 32; ++c) ltv[c] = lt[(size_t)c * 16384];
#pragma unroll
            for (int c = 0; c < 32; ++c) { ct[(size_t)c * 16384] = (bf16)f2bf(Cs); Cs = decl[c] * Cs + fl[c] * ltv[c]; }
            const int e = idx >> 7, d = idx & 127; out[O_CP + (size_t)bh * 16384 + d * 128 + e] = Cs; }
        if (part == 0 && tid < 128) { float ns = 0.f; float nlv[32];
#pragma unroll
            for (int c = 0; c < 32; ++c) nlv[c] = NL[(size_t)(bh * 32 + c) * 128 + tid];
#pragma unroll
            for (int c = 0; c < 32; ++c) { NC[(size_t)(bh * 32 + c) * 128 + tid] = ns; ns = decl[c] * ns + fl[c] * nlv[c]; }
            out[O_NP + bh * 128 + tid] = ns; }
        __syncthreads();
    }
}
__device__ __forceinline__ void mlstm_c_unit(const Args& A, unsigned char* ws, LAS unsigned char* lds, int u, int tid, int lane, int wave) {
    const int bh = u >> 5, c = u & 31, b = bh >> 2, h = bh & 3; const int r0 = b * SEQ + c * 128;
    LAS unsigned char* KT = lds; LAS unsigned char* VT = lds + 128 * TP_; LAS unsigned char* CTt = lds + 2 * 128 * TP_;
    LAS float* wkl = (LAS float*)(lds + (2 * 128 + 144) * TP_); LAS float* rjl = wkl + 128; LAS float* wil = rjl + 128; LAS float* eml = wil + 128; LAS float* sc = eml + 128;
    KVRegs R; load_kv(R, (const bf16*)(ws + WS_MK) + (size_t)r0 * 512 + h * 128, (const bf16*)(ws + WS_MV) + (size_t)r0 * 512 + h * 128, tid);
    v4u ctr[4]; { const bf16* CTg = (const bf16*)(ws + WS_CT) + (size_t)u * 16384;
#pragma unroll
      for (int i = 0; i < 4; ++i) ctr[i] = *(const GAS v4u*)(CTg + (size_t)((tid >> 4) + 32 * i) * 128 + 8 * (tid & 15)); }
    const float mc = ((const float*)(ws + WS_MISC + MI_MC))[bh * 33 + c];
    f32x4 nca = (f32x4){0.f, 0.f, 0.f, 0.f}, ncb = nca; { const float* NCg = (const float*)(ws + WS_MISC + MI_NC) + (size_t)u * 128; if (tid < 16) { nca = *(const GAS f32x4*)(NCg + 8 * tid); ncb = *(const GAS f32x4*)(NCg + 8 * tid + 4); } }
    float bj, gj, gpre, G, bend; chunk_scan((const float*)(ws + WS_GATES) + (size_t)r0 * 16, h, tid, lane, wave, sc, bj, gj, gpre, G, bend);
    if (tid < 128) { const float Mj = fmaxf(mc, gpre); wkl[tid] = expf(gj - G); rjl[tid] = expf(G - Mj); wil[tid] = expf(mc - Mj); eml[tid] = expf(-(bj + Mj)); }
    __syncthreads();
    store_kv(R, KT, VT, wkl, tid);
    {
#pragma unroll
      for (int i = 0; i < 4; ++i) { const int e = (tid >> 4) + 32 * i, c16 = tid & 15; *(LAS v4u*)(CTt + e * TP_ + c16 * 16) = ctr[i]; }
      if (tid < 256) { const int rr = tid >> 4, c16 = tid & 15; v4u o = (v4u){0u, 0u, 0u, 0u};
          if (rr == 0) { o.x = pk2(nca.x, nca.y); o.y = pk2(nca.z, nca.w); o.z = pk2(ncb.x, ncb.y); o.w = pk2(ncb.z, ncb.w); }
          *(LAS v4u*)(CTt + (128 + rr) * TP_ + c16 * 16) = o; } }
    const int fr = lane & 15, fq = lane >> 4, q4 = (lane & 15) >> 2, p4 = lane & 3; const int j = 16 * wave + fr;
    bf16x8 qf[4];
    { const bf16* Qg = (const bf16*)(ws + WS_MQ) + (size_t)(r0 + j) * 512 + h * 128 + 8 * fq;
#pragma unroll
      for (int kd = 0; kd < 4; ++kd) qf[kd] = *(const GAS bf16x8*)(Qg + 32 * kd); }
    const float* gmh = I_GMH + h * 128 + 4 * fq; const bf16* MOg = (const bf16*)(ws + WS_MO) + (size_t)(r0 + j) * 512 + h * 128 + 4 * fq;
    f32x4 gmv[8]; unsigned long long mov[8];
#pragma unroll
    for (int eb = 0; eb < 8; ++eb) { gmv[eb] = *(const GAS f32x4*)(gmh + 16 * eb); mov[eb] = *(const GAS unsigned long long*)(MOg + 16 * eb); }
    __syncthreads();
    f32x4 O[9];
#pragma unroll
    for (int eb = 0; eb < 9; ++eb) { O[eb] = (f32x4){0.f, 0.f, 0.f, 0.f};
#pragma unroll
        for (int kd = 0; kd < 4; ++kd) { const bf16x8 X = *(const LAS bf16x8*)(CTt + (16 * eb + fr) * TP_ + (32 * kd + 8 * fq) * 2); O[eb] = MFMA16(X, qf[kd], O[eb]); } }
    { const float wi = wil[j];
#pragma unroll
      for (int eb = 0; eb < 9; ++eb) O[eb] *= wi; }
    f32x4 S[8]; const float rj = rjl[j];
#pragma unroll
    for (int sb = 0; sb < 8; ++sb) { S[sb] = (f32x4){0.f, 0.f, 0.f, 0.f};
        if (sb <= wave) {
#pragma unroll
            for (int kd = 0; kd < 4; ++kd) { const bf16x8 X = *(const LAS bf16x8*)(KT + (16 * sb + fr) * TP_ + (32 * kd + 8 * fq) * 2); S[sb] = MFMA16(X, qf[kd], S[sb]); }
#pragma unroll
            for (int v = 0; v < 4; ++v) S[sb][v] = (16 * sb + 4 * fq + v <= j) ? S[sb][v] * rj : 0.f; } }
    const short one = fr == 0 ? (short)0x3F80 : (short)0; const bf16x8 ones = (bf16x8){one, one, one, one, one, one, one, one};
#pragma unroll
    for (int kp = 0; kp < 4; ++kp) if (2 * kp <= wave) {
        v4u pw; pw.x = pk2(S[2 * kp][0], S[2 * kp][1]); pw.y = pk2(S[2 * kp][2], S[2 * kp][3]); pw.z = pk2(S[2 * kp + 1][0], S[2 * kp + 1][1]); pw.w = pk2(S[2 * kp + 1][2], S[2 * kp + 1][3]);
        const bf16x8 Y = __builtin_bit_cast(bf16x8, pw); const int row = 32 * kp + 4 * fq + q4;
#pragma unroll
        for (int eb = 0; eb < 8; ++eb) { const bf16x8 X = join8(tr4(VT + row * TP_ + (16 * eb + 4 * p4) * 2), tr4(VT + (row + 16) * TP_ + (16 * eb + 4 * p4) * 2)); O[eb] = MFMA16(X, Y, O[eb]); }
        O[8] = MFMA16(ones, Y, O[8]); }
    const float den = __shfl(O[8][0], fr); const float hd = 1.0f / fmaxf(fabsf(den), eml[j]);
    float ssq = 0.f;
#pragma unroll
    for (int eb = 0; eb < 8; ++eb) { O[eb] *= hd; ssq += dot4f(O[eb]); }
    ssq += __shfl_xor(ssq, 16); ssq += __shfl_xor(ssq, 32);
    const float rstd = rsqrtf(ssq * (1.0f / 128.0f) + EPS);
    bf16* HMg = (bf16*)(ws + WS_HY) + (size_t)(r0 + j) * 1024 + h * 128 + 4 * fq;
#pragma unroll
    for (int eb = 0; eb < 8; ++eb) { const f32x4 g = gmv[eb]; const unsigned long long mo = mov[eb]; const unsigned m0 = (unsigned)mo, m1 = (unsigned)(mo >> 32);
        const f32x4 o = O[eb] * rstd * g; *(GAS unsigned long long*)(HMg + 16 * eb) = (unsigned long long)pk2(o.x * bflo(m0), o.y * bfhi(m0)) | ((unsigned long long)pk2(o.z * bflo(m1), o.w * bfhi(m1)) << 32); }
    __syncthreads();
}
__device__ __forceinline__ void mlstm_s_unit(const float* sm_, const float* sn_, const float* sc_, const float* gmh_, unsigned char* ws_, float* out, LAS unsigned char* lds, int u) {
    PHASE_IDS_; OPAQUE_WS_;
    const int b = u >> 2, h = u & 3; const int row0 = MP + b * DT;
    LAS float* ql = (LAS float*)lds; LAS float* kl = ql + 512; LAS float* vl = kl + 512; LAS float* kwl = vl + 512; LAS float* nl = kwl + 512; LAS float* red = nl + 128;
    LAS float* Sl = red + 8192; LAS float* qnl = Sl + 16; LAS float* ws2 = qnl + 4;
    const int e4 = tid & 31, dg = tid >> 5; const float* Cg = sc_ + ((size_t)(b * 4 + h) * 128 + dg * 8) * 128 + 4 * e4; f32x4 cvr[8];
#pragma unroll
    for (int i = 0; i < 8; ++i) cvr[i] = __builtin_nontemporal_load((const GAS f32x4*)(Cg + (size_t)i * 128));
    float lf[4], ig[4], bc[4], mj[4], wint[4], wl[4]; const float* GT = (const float*)(ws + WS_GATES) + (size_t)row0 * 16;
#pragma unroll
    for (int j = 0; j < 4; ++j) { ig[j] = GT[j * 16 + h]; lf[j] = GT[j * 16 + 4 + h]; }
    const float mst = sm_[b * 4 + h];
    bc[0] = lf[0]; bc[1] = bc[0] + lf[1]; bc[2] = bc[1] + lf[2]; bc[3] = bc[2] + lf[3];
#pragma unroll
    for (int j = 0; j < 4; ++j) { float m = bc[j] + mst;
#pragma unroll
        for (int s = 0; s <= j; ++s) m = fmaxf(m, bc[j] - bc[s] + ig[s]);
        mj[j] = m; wint[j] = expf(bc[j] + mst - m); }
    const float aend = bc[3] + mst; float mnew = aend;
#pragma unroll
    for (int s = 0; s < 4; ++s) mnew = fmaxf(mnew, bc[3] - bc[s] + ig[s]);
#pragma unroll
    for (int s = 0; s < 4; ++s) wl[s] = expf(bc[3] - bc[s] + ig[s] - mnew);
    const float decay = expf(aend - mnew);
    for (int idx = tid; idx < 1536; idx += 512) { const int arr = idx >> 9, jj = (idx >> 7) & 3, d = idx & 127;
        const bf16* src = (const bf16*)(ws + (arr == 0 ? WS_MQ : arr == 1 ? WS_MK : WS_MV)); ql[idx] = bf2f(src[(size_t)(row0 + jj) * 512 + h * 128 + d]); }
    if (tid < 128) nl[tid] = sn_[(size_t)(b * 4 + h) * 128 + tid];
    __syncthreads();
    { const int s = tid >> 7; const float w = s == 0 ? wl[0] : s == 1 ? wl[1] : s == 2 ? wl[2] : wl[3]; kwl[tid] = w * kl[tid]; }
    for (int p = wave; p < 20; p += 8) {
        const LAS float* a_ = ql + (p < 16 ? (p >> 2) : (p - 16)) * 128; const LAS float* b_ = p < 16 ? kl + (p & 3) * 128 : nl;
        const float a = wave_sum(a_[lane] * b_[lane] + a_[lane + 64] * b_[lane + 64]);
        if (lane == 0) { if (p < 16) Sl[p] = a; else qnl[p - 16] = a; } }
    __syncthreads();
    { float* Co = out + O_CS + ((size_t)(b * 4 + h) * 128 + dg * 8) * 128 + 4 * e4;
      f32x4 part[4]; f32x4 vv[4];
#pragma unroll
      for (int s = 0; s < 4; ++s) { part[s] = (f32x4){0.f, 0.f, 0.f, 0.f}; vv[s] = *(const LAS f32x4*)(vl + s * 128 + 4 * e4); }
#pragma unroll
      for (int i = 0; i < 8; ++i) { const f32x4 cv = cvr[i]; const int d = dg * 8 + i;
          f32x4 cn = cv * decay;
#pragma unroll
          for (int s = 0; s < 4; ++s) { part[s] += cv * ql[s * 128 + d]; cn += vv[s] * kwl[s * 128 + d]; }
          __builtin_nontemporal_store(cn, (GAS f32x4*)(Co + (size_t)i * 128)); }
#pragma unroll
      for (int s = 0; s < 4; ++s) *(LAS f32x4*)(red + (dg * 4 + s) * 128 + 4 * e4) = part[s]; }
    __syncthreads();
    { const int jj = tid >> 7, e = tid & 127; float qc = 0.f;
#pragma unroll
      for (int dg = 0; dg < 16; ++dg) qc += red[(dg * 4 + jj) * 128 + e];
      const float bcj = jj == 0 ? bc[0] : jj == 1 ? bc[1] : jj == 2 ? bc[2] : bc[3], mjj = jj == 0 ? mj[0] : jj == 1 ? mj[1] : jj == 2 ? mj[2] : mj[3], wi = jj == 0 ? wint[0] : jj == 1 ? wint[1] : jj == 2 ? wint[2] : wint[3];
      float num = wi * qc, den = wi * qnl[jj];
#pragma unroll
      for (int s = 0; s < 4; ++s) if (s <= jj) { const float w = Sl[jj * 4 + s] * expf(bcj - bc[s] + ig[s] - mjj); num += w * vl[s * 128 + e]; den += w; }
      const float hv = num / fmaxf(fabsf(den), expf(-mjj));
      const float sq = wave_sum(hv * hv); if (lane == 0) ws2[wave] = sq;
      __syncthreads();
      const float rstd = rsqrtf((ws2[2 * jj] + ws2[2 * jj + 1]) * (1.0f / 128.0f) + EPS);
      const size_t oi = (size_t)(row0 + jj) * 512 + h * 128 + e;
      ((bf16*)(ws + WS_HY))[(size_t)(row0 + jj) * 1024 + h * 128 + e] = (bf16)f2bf(hv * rstd * gmh_[h * 128 + e] * bf2f(((const bf16*)(ws + WS_MO))[oi])); }
    if (tid < 128) out[O_NS + (size_t)(b * 4 + h) * 128 + tid] = decay * nl[tid] + ((kwl[tid] + kwl[128 + tid]) + (kwl[256 + tid] + kwl[384 + tid]));
    if (tid == 0) out[O_MS + b * 4 + h] = mnew;
    __syncthreads();
}
__device__ __forceinline__ float dpp_sum16(float v) {
    v += __builtin_bit_cast(float, __builtin_amdgcn_update_dpp(0, __builtin_bit_cast(int, v), 0xB1, 0xF, 0xF, true));
    v += __builtin_bit_cast(float, __builtin_amdgcn_update_dpp(0, __builtin_bit_cast(int, v), 0x4E, 0xF, 0xF, true));
    v += __builtin_bit_cast(float, __builtin_amdgcn_update_dpp(0, __builtin_bit_cast(int, v), 0x124, 0xF, 0xF, true));
    v += __builtin_bit_cast(float, __builtin_amdgcn_update_dpp(0, __builtin_bit_cast(int, v), 0x128, 0xF, 0xF, true));
    return v;
}
#ifndef DEC_NPG
#define DEC_NPG 4
#endif
constexpr int DEC_NPG_ = DEC_NPG, DEC_NI = NPAGES / DEC_NPG_, DEC_TOK = PAGE * DEC_NPG_, DEC_TPT = DEC_TOK / 64;
constexpr int DEC_ST = 68;
__device__ __forceinline__ void fox_dec_unit(const int* pt_, const float* clf_, const float* ck_, const float* cv_, unsigned char* ws_, float* out, LAS unsigned char* lds, int u) {
    PHASE_IDS_; OPAQUE_WS_;
    const int b = u / DEC_NI, qtr = u % DEC_NI; const int* pt = pt_ + b * NPAGES;
    LAS float* tbl = (LAS float*)lds;
    LAS float* csum = tbl + DEC_TOK * 8; LAS float* osum = csum + 512;
    LAS int* pgl = (LAS int*)(osum + 512); if (tid < DEC_NPG_) pgl[tid] = pt[qtr * DEC_NPG_ + tid];
    { const int hh = tid & 7, cc = tid >> 3; float lfv[DEC_TPT]; float s = 0.f, so = 0.f;
#pragma unroll
      for (int i = 0; i < DEC_TPT; ++i) { const int tok = DEC_TPT * cc + i; const int pg = pt[qtr * DEC_NPG_ + (tok >> 7)]; lfv[i] = clf_[((size_t)pg * PAGE + (tok & 127)) * 8 + hh]; s += lfv[i]; }
      for (int t8 = DEC_TOK * (qtr + 1); t8 < PAST; t8 += 512) {
        float lv[8];
#pragma unroll
        for (int i = 0; i < 8; ++i) { const int pg2 = pt[(t8 >> 7) + (i >> 1)]; lv[i] = clf_[((size_t)pg2 * PAGE + ((cc + 64 * i) & 127)) * 8 + hh]; }
        so += ((lv[0] + lv[1]) + (lv[2] + lv[3])) + ((lv[4] + lv[5]) + (lv[6] + lv[7])); }
      float sc = s;
      { const float t_ = __shfl_down(sc, 8);  if (lane < 56) sc += t_; }
      { const float t_ = __shfl_down(sc, 16); if (lane < 48) sc += t_; }
      { const float t_ = __shfl_down(sc, 32); if (lane < 32) sc += t_; }
      float off = __shfl_down(sc, 8); if (lane >= 56) off = 0.f;
      so += __shfl_xor(so, 8); so += __shfl_xor(so, 16); so += __shfl_xor(so, 32);
      if (lane < 8) { csum[wave * 8 + hh] = sc; osum[wave * 8 + hh] = so; }
      __syncthreads();
#pragma unroll
      for (int w2 = 0; w2 < 8; ++w2) { const float a_ = csum[w2 * 8 + hh], o_ = osum[w2 * 8 + hh]; off += (w2 > wave ? a_ : 0.f) + o_; }
#pragma unroll
      for (int i = DEC_TPT - 1; i >= 0; --i) { tbl[(DEC_TPT * cc + i) * 8 + hh] = off * LOG2E; off += lfv[i]; } }
    __syncthreads();
    const int h = wave, ts = lane >> 3, part = lane & 7;
    f32x4 q[4][2]; const int rowq = MP + b * DT;
#pragma unroll
    for (int t = 0; t < 4; ++t)
#pragma unroll
        for (int j = 0; j < 2; ++j) q[t][j] = ld4bf((const bf16*)(ws + WS_FQ) + (size_t)(rowq + t) * 512 + h * 64 + 32 * j + 4 * part);
#define DPPF(v_, c_) __builtin_bit_cast(float, __builtin_amdgcn_update_dpp(0, __builtin_bit_cast(int, v_), c_, 0xF, 0xF, true))
#define OCTSUM(v_) do { v_ += DPPF(v_, 0xB1); v_ += DPPF(v_, 0x4E); v_ += DPPF(v_, 0x141); } while (0)
#define DOT8(k0_, k1_, t_) (((k0_.x * q[t_][0].x + k0_.y * q[t_][0].y) + (k0_.z * q[t_][0].z + k0_.w * q[t_][0].w)) + ((k1_.x * q[t_][1].x + k1_.y * q[t_][1].y) + (k1_.z * q[t_][1].z + k1_.w * q[t_][1].w)))
    float snew[4]; f32x4 vn[2];
    { const float* GT = (const float*)(ws + WS_GATES) + (size_t)rowq * 16 + 8 + h; float fn = 0.f; const int tn = ts & 3;
#pragma unroll
      for (int t2 = 0; t2 < 4; ++t2) { const float x = GT[t2 * 16]; if (t2 <= tn) fn += x; }
      f32x4 kn[2];
#pragma unroll
      for (int j = 0; j < 2; ++j) { kn[j] = *(const GAS f32x4*)(out + O_KS + (size_t)(b * DT + tn) * 512 + h * 64 + 32 * j + 4 * part); vn[j] = *(const GAS f32x4*)(out + O_VS + (size_t)(b * DT + tn) * 512 + h * 64 + 32 * j + 4 * part); }
      const float biasn = -fn * LOG2E;
#pragma unroll
      for (int t = 0; t < 4; ++t) { float a_ = DOT8(kn[0], kn[1], t); OCTSUM(a_); snew[t] = (ts < 4 && tn <= t) ? a_ + biasn : -INFINITY; } }
    float R[4], l[4], thr[4]; f32x4 o[4][2];
#pragma unroll
    for (int t = 0; t < 4; ++t) { float mx = snew[t]; mx = fmaxf(mx, __shfl_xor(mx, 8)); mx = fmaxf(mx, __shfl_xor(mx, 16)); mx = fmaxf(mx, __shfl_xor(mx, 32));
        R[t] = mx; thr[t] = mx - 32.0f; l[t] = 0.f; o[t][0] = (f32x4){0.f, 0.f, 0.f, 0.f}; o[t][1] = (f32x4){0.f, 0.f, 0.f, 0.f}; }
    if (qtr == DEC_NI - 1) {
#pragma unroll
        for (int t = 0; t < 4; ++t) { const float p_ = __builtin_amdgcn_exp2f(snew[t] - R[t]); l[t] += p_; o[t][0] += vn[0] * p_; o[t][1] += vn[1] * p_; } }
#define DEC_KADDR(it_) (((size_t)__builtin_amdgcn_readfirstlane(pgl[(it_) >> 3]) * PAGE + ((it_) & 7) * 16 + ts) * 8 + h) * 64 + 4 * part
#define DEC_LOADK(it_, kk_) do { const size_t to_ = DEC_KADDR(it_); \
        _Pragma("unroll") for (int g = 0; g < 2; ++g) _Pragma("unroll") for (int j = 0; j < 2; ++j) kk_[g][j] = __builtin_nontemporal_load((const GAS f32x4*)(ck_ + to_ + (size_t)g * 8 * 512 + 32 * j)); } while (0)
    LAS float* scb = (LAS float*)(lds + 32768) + wave * 2048;
    unsigned long long vmask = 0ull;
    const int t1 = part & 3, g1 = part >> 2; const bool pb2 = (part & 4) != 0, pb1 = (part & 2) != 0, pb0 = (part & 1) != 0;
    float R1 = t1 == 0 ? R[0] : t1 == 1 ? R[1] : t1 == 2 ? R[2] : R[3]; const float thr1 = R1 - 32.0f; float l1 = 0.f;
    typedef float f32x2_ __attribute__((ext_vector_type(2)));
#define LO2(v_) ((f32x2_){(v_).x, (v_).y})
#define HI2(v_) ((f32x2_){(v_).z, (v_).w})
#define DEC_STEP(it_, kk_) do { const int ii_ = (it_); \
        const float bias_ = tbl[(((ii_ >> 3) * 128 + (ii_ & 7) * 16 + ts) * 8 + h) + 64 * g1]; float pv_[8]; \
        _Pragma("unroll") for (int g = 0; g < 2; ++g) _Pragma("unroll") for (int t = 0; t < 4; ++t) { \
            f32x2_ a_ = LO2(kk_[g][0]) * LO2(q[t][0]); a_ = HI2(kk_[g][0]) * HI2(q[t][0]) + a_; a_ = LO2(kk_[g][1]) * LO2(q[t][1]) + a_; a_ = HI2(kk_[g][1]) * HI2(q[t][1]) + a_; pv_[4 * g + t] = a_.x + a_.y; } \
        float w_[4], u_[2]; \
        _Pragma("unroll") for (int i = 0; i < 4; ++i) { const float keep_ = pb2 ? pv_[4 + i] : pv_[i], send_ = pb2 ? pv_[i] : pv_[4 + i]; w_[i] = keep_ + DPPF(send_, 0x141); }        \
        _Pragma("unroll") for (int i = 0; i < 2; ++i) { const float keep_ = pb1 ? w_[2 + i] : w_[i], send_ = pb1 ? w_[i] : w_[2 + i]; u_[i] = keep_ + DPPF(send_, 0x4E); }              \
        const float keep0_ = pb0 ? u_[1] : u_[0], send0_ = pb0 ? u_[0] : u_[1]; const float s_ = keep0_ + DPPF(send0_, 0xB1) + bias_;                                                     \
        if (__any(s_ > R1 + 64.0f)) { float rold_ = R1; \
            _Pragma("unroll") for (int t = 0; t < 4; ++t) { float mx_ = t1 == t ? s_ : -INFINITY; \
                _Pragma("unroll") for (int o_ = 1; o_ < 64; o_ <<= 1) mx_ = fmaxf(mx_, __shfl_xor(mx_, o_)); \
                const float rn_ = fmaxf(R[t], mx_), cr_ = __builtin_amdgcn_exp2f(R[t] - rn_); l[t] *= cr_; o[t][0] *= cr_; o[t][1] *= cr_; R[t] = rn_; } \
            R1 = t1 == 0 ? R[0] : t1 == 1 ? R[1] : t1 == 2 ? R[2] : R[3]; l1 *= __builtin_amdgcn_exp2f(rold_ - R1); } \
        l1 += __builtin_amdgcn_exp2f(s_ - R1); \
        const unsigned long long nm_ = __ballot(s_ >= thr1); const bool f0_ = (nm_ & 0x0F0F0F0F0F0F0F0Full) != 0ull, f1_ = (nm_ & 0xF0F0F0F0F0F0F0F0ull) != 0ull; \
        if (f0_ || f1_) { if (pb2 ? f1_ : f0_) scb[((2 * ii_ + g1) * 8 + ts) * 4 + t1] = s_; \
            vmask |= ((f0_ ? 1ull : 0ull) | (f1_ ? 2ull : 0ull)) << (2 * ii_); } } while (0)
    { f32x4 kA[2][2], kB[2][2];
      DEC_LOADK(0, kA);
#pragma unroll 1
      for (int it = 0; it < 8 * DEC_NPG_; it += 2) {
          DEC_LOADK(it + 1, kB); __builtin_amdgcn_sched_barrier(0);
          DEC_STEP(it, kA); __builtin_amdgcn_sched_barrier(0);
          if (it + 2 < 8 * DEC_NPG_) DEC_LOADK(it + 2, kA);
          __builtin_amdgcn_sched_barrier(0);
          DEC_STEP(it + 1, kB); __builtin_amdgcn_sched_barrier(0);
      } }
    while (vmask != 0ull) {
        int gg[8]; float wg[8];
#pragma unroll
        for (int u = 0; u < 8; ++u) { const bool has_ = vmask != 0ull; const int g_ = has_ ? (int)__builtin_ctzll(vmask) : gg[0]; if (has_) vmask &= vmask - 1ull; gg[u] = g_; wg[u] = has_ ? 1.0f : 0.0f; }
        f32x4 vv[8][2], sv[8];
#pragma unroll
        for (int u = 0; u < 8; ++u) { const size_t to_ = (((size_t)__builtin_amdgcn_readfirstlane(pgl[gg[u] >> 4]) * PAGE + (gg[u] & 15) * 8 + ts) * 8 + h) * 64 + 4 * part;
            vv[u][0] = __builtin_nontemporal_load((const GAS f32x4*)(cv_ + to_)); vv[u][1] = __builtin_nontemporal_load((const GAS f32x4*)(cv_ + to_ + 32));
            sv[u] = *(const LAS f32x4*)(scb + (gg[u] * 8 + ts) * 4); }
        __builtin_amdgcn_sched_barrier(0);
#pragma unroll
        for (int u = 0; u < 8; ++u) {
            const float p0_ = __builtin_amdgcn_exp2f(sv[u].x - R[0]) * wg[u], p1_ = __builtin_amdgcn_exp2f(sv[u].y - R[1]) * wg[u], p2_ = __builtin_amdgcn_exp2f(sv[u].z - R[2]) * wg[u], p3_ = __builtin_amdgcn_exp2f(sv[u].w - R[3]) * wg[u];
            o[0][0] += vv[u][0] * p0_; o[0][1] += vv[u][1] * p0_; o[1][0] += vv[u][0] * p1_; o[1][1] += vv[u][1] * p1_;
            o[2][0] += vv[u][0] * p2_; o[2][1] += vv[u][1] * p2_; o[3][0] += vv[u][0] * p3_; o[3][1] += vv[u][1] * p3_; }
    }
#undef DEC_STEP
#undef DEC_LOADK
#undef DEC_KADDR
#undef DOT8
#undef OCTSUM
#undef DPPF
#undef LO2
#undef HI2
    { float ls_ = l1 + __shfl_xor(l1, 4);
#pragma unroll
      for (int t = 0; t < 4; ++t) l[t] += __shfl(ls_, (lane & ~7) | t); }
#pragma unroll
    for (int t = 0; t < 4; ++t) {
#pragma unroll
        for (int sh = 8; sh <= 32; sh <<= 1) { const float m2 = __shfl_xor(R[t], sh), l2 = __shfl_xor(l[t], sh);
            const float mn = fmaxf(R[t], m2), c1 = __builtin_amdgcn_exp2f(R[t] - mn), c2 = __builtin_amdgcn_exp2f(m2 - mn); l[t] = l[t] * c1 + l2 * c2; R[t] = mn;
#pragma unroll
            for (int j = 0; j < 2; ++j) { f32x4 o2; o2.x = __shfl_xor(o[t][j].x, sh); o2.y = __shfl_xor(o[t][j].y, sh); o2.z = __shfl_xor(o[t][j].z, sh); o2.w = __shfl_xor(o[t][j].w, sh); o[t][j] = o[t][j] * c1 + o2 * c2; } }
        float* rec = (float*)(ws + WS_MISC + MI_DEC) + ((size_t)((b * DEC_NI + qtr) * 8 + h) * 4 + t) * DEC_ST;
        if (ts == 0) { *(GAS f32x4*)(rec + 4 * part) = o[t][0]; *(GAS f32x4*)(rec + 32 + 4 * part) = o[t][1]; if (part == 0) { rec[64] = R[t]; rec[65] = l[t]; } } }
    __syncthreads();
}
__device__ __forceinline__ void fox_dec_combine(unsigned char* ws, int vcu, int Gn, int tid) {
    const float* P = (const float*)(ws + WS_MISC + MI_DEC); bf16* YF = (bf16*)(ws + WS_HY) + 512;
    for (int i = vcu * 512 + tid; i < MS * 128; i += Gn * 512) { const int row = i >> 7, c4 = i & 127, h = c4 >> 4, d = (c4 & 15) * 4, b = row >> 2, t = row & 3;
        const float* r[DEC_NI]; float mm[DEC_NI], mx = -INFINITY;
#pragma unroll
        for (int qd = 0; qd < DEC_NI; ++qd) { r[qd] = P + ((size_t)((b * DEC_NI + qd) * 8 + h) * 4 + t) * DEC_ST; mm[qd] = r[qd][64]; mx = fmaxf(mx, mm[qd]); }
        f32x4 o = (f32x4){0.f, 0.f, 0.f, 0.f}; float ls = 0.f;
#pragma unroll
        for (int qd = 0; qd < DEC_NI; ++qd) { const float w = exp2f(mm[qd] - mx); ls += r[qd][65] * w; o += *(const GAS f32x4*)(r[qd] + d) * w; }
        o *= 1.0f / ls;
        *(GAS unsigned long long*)(YF + (size_t)(MP + row) * 1024 + h * 64 + d) = (unsigned long long)pk2(o.x, o.y) | ((unsigned long long)pk2(o.z, o.w) << 32); }
}
__device__ __forceinline__ void fox_f2_build(unsigned char* ws, LAS unsigned char* lds, int bh, int tid, int lane, int wave) {
    const int b = bh / HF, h = bh % HF;
    const float* GT = (const float*)(ws + WS_GATES) + ((size_t)b * SEQ) * 16 + 8 + h; float* F2g = (float*)(ws + WS_MISC + MI_F2) + (size_t)bh * SEQ;
    LAS float* wsum = (LAS float*)(lds + attn_body::LDS_WS);
    float v[8]; const int base = tid * 8;
#pragma unroll
    for (int i = 0; i < 8; ++i) v[i] = GT[(size_t)(base + i) * 16];
#pragma unroll
    for (int i = 1; i < 8; ++i) v[i] += v[i - 1];
    float sc = v[7];
#pragma unroll
    for (int o = 1; o < 64; o <<= 1) { const float t = __shfl_up(sc, o); if (lane >= o) sc += t; }
    if (lane == 63) wsum[wave] = sc;
    __syncthreads();
    float off = sc - v[7];
    for (int w = 0; w < wave; ++w) off += wsum[w];
    f32x4 o0, o1; o0.x = -(v[0] + off) * LOG2E; o0.y = -(v[1] + off) * LOG2E; o0.z = -(v[2] + off) * LOG2E; o0.w = -(v[3] + off) * LOG2E; o1.x = -(v[4] + off) * LOG2E; o1.y = -(v[5] + off) * LOG2E; o1.z = -(v[6] + off) * LOG2E; o1.w = -(v[7] + off) * LOG2E;
    *(GAS f32x4*)(F2g + base) = o0; *(GAS f32x4*)(F2g + base + 4) = o1;
    __syncthreads();
}
__device__ __forceinline__ void fox_f2_to_lds(unsigned char* ws, LAS unsigned char* lds, int b, int h, int tid, int lane, int wave) {
    const float* F2g = (const float*)(ws + WS_MISC + MI_F2) + (size_t)(b * HF + h) * SEQ; LAS float* F2l = (LAS float*)(lds + attn_body::LDS_F2);
    *(LAS f32x4*)(F2l + 8 * tid) = *(const GAS f32x4*)(F2g + 8 * tid); *(LAS f32x4*)(F2l + 8 * tid + 4) = *(const GAS f32x4*)(F2g + 8 * tid + 4);
    __syncthreads();
}
#define PHASE_IDS int tid_ = threadIdx.x; asm volatile("" : "+v"(tid_)); const int tid = tid_, lane = tid & 63, wave = __builtin_amdgcn_readfirstlane(tid >> 6)
__device__ __forceinline__ void fox_attn_item(unsigned char* ws_, LAS unsigned char* ldsl, unsigned char* lds, int bh, int qb, float margin) {
    PHASE_IDS_; OPAQUE_WS_;
    const int b = bh / HF, h = bh % HF;
    fox_f2_to_lds(ws, ldsl, b, h, tid, lane, wave);
    const LAS float* TBl = (const LAS float*)(ldsl + attn_body::LDS_F2);
    const int NT = 4 * (qb + 1); int t0 = 0; const float thr = TBl[256 * qb] - margin;
    { const int tc = 2 * (lane + 1);
      const bool ok_ = (NT - tc >= 4) && TBl[64 * (tc <= 62 ? tc : 62) - 1] < thr;
      const unsigned long long mk = __ballot(ok_);
      t0 = 2 * (int)__builtin_ctzll(~mk | (1ull << 63)); }
    t0 = __builtin_amdgcn_readfirstlane(t0);
    attn_body::attn_unit<8>(b, h, qb, t0, (const attn_body::bf16*)(ws + WS_FQ), (const attn_body::bf16*)(ws + WS_FK), (const attn_body::bf16*)(ws + WS_FV), (attn_body::bf16*)(ws + WS_HY) + 512, (char*)lds + RING_OFF);
}
__device__ __forceinline__ void late_weights_item(const Args& A, unsigned char* ws_, LAS unsigned char* lds, int q) {
    PHASE_IDS_; OPAQUE_WS_;
    p0_late_item(A, ws, q * 8 + wave, (LAS float*)(lds + RING_OFF + wave * 16384), lane);
    __syncthreads();
}
constexpr int CW_WQW = 192, CW_WQP = 256;
__device__ __forceinline__ void drain_late_weights(Frame& F, const Args& A) {
    PHASE_IDS_; size_t wso_ = 0; asm volatile("" : "+s"(wso_)); unsigned char* ws = F.ws + wso_;
    volatile LAS unsigned* slot = (volatile LAS unsigned*)(F.lds + LDSCTL_OFF);
    for (;;) {
        if (tid == 0) slot[0] = __hip_atomic_fetch_add(F.ctl + CW_WQW, 1u, __ATOMIC_RELAXED, __HIP_MEMORY_SCOPE_AGENT);
        __syncthreads();
        const int k = __builtin_amdgcn_readfirstlane((int)slot[0]);
        __syncthreads();
        if (k >= NLATE / 8) break;
        late_weights_item(A, ws, F.lds, k);
    }
}
struct OneUnit { int pm, pn;
    __device__ __forceinline__ bool next(int i, pg8::Unit& u) const { if (i) return false; u.pm = pm; u.pn = pn; return true; }
    __device__ __forceinline__ void a_ready(const pg8::Unit&) const {}
    __device__ __forceinline__ void done(const pg8::Unit&) const {} };
__device__ __forceinline__ void drain_ple_proj(Frame& F) {
    PHASE_IDS_; size_t wso_ = 0; asm volatile("" : "+s"(wso_)); unsigned char* ws = F.ws + wso_;
    volatile LAS unsigned* slot = (volatile LAS unsigned*)(F.lds + LDSCTL_OFF);
    for (;;) {
        if (tid == 0) slot[0] = __hip_atomic_fetch_add(F.ctl + CW_WQP, 1u, __ATOMIC_RELAXED, __HIP_MEMORY_SCOPE_AGENT);
        __syncthreads();
        const int k = __builtin_amdgcn_readfirstlane((int)slot[0]);
        __syncthreads();
        if (k >= 264) break;
        pg8::Gemm g{(const bf16*)(ws + WS_PB), (const bf16*)(ws + WS_WPP), MT, DM, PLE}; OneUnit S{k >> 2, k & 3};
        pg8::EpiStore E{(bf16*)(ws + WS_TP)};
        pg8::gemm_phase<pg8::EpiStore, OneUnit, false, true>(F.lds + RING_OFF, g, S, E);
        __syncthreads();
    }
}
constexpr int CW_WQ = 64, CW_WQD = 128;
constexpr int WQC_ITEMS = 512 * 3;
constexpr int WQD_ITEMS = DB * DEC_NI;
#ifndef DEC_FIRST_OF_16
#define DEC_FIRST_OF_16 6
#endif
__device__ __forceinline__ void mix_phase_a(Frame& F, const Args& A, unsigned char* lds) {
    PHASE_IDS; size_t wso_ = 0; asm volatile("" : "+s"(wso_)); unsigned char* ws = F.ws + wso_;
    float mq = 0.f, mk = 0.f; for (int i = 0; i < 64; ++i) { mq = fmaxf(mq, fabsf(I_GQN[i])); mk = fmaxf(mk, fabsf(I_GKN[i])); }
    if (tid == 0) ((volatile LAS float*)(F.lds + LDSCTL_OFF))[4] = 24.0f + 2.0f * (64.0f * mq * mk * C2Q);
    volatile LAS unsigned* slot = (volatile LAS unsigned*)(F.lds + LDSCTL_OFF);
    const bool dec_first = (((int)blockIdx.x >> 3) & 15) < DEC_FIRST_OF_16;
    for (int pass = 0; pass < 2; ++pass) { const bool dq = dec_first != (pass == 1);
        for (;;) {
            if (tid == 0) slot[0] = __hip_atomic_fetch_add(F.ctl + (dq ? CW_WQD : CW_WQ), 1u, __ATOMIC_RELAXED, __HIP_MEMORY_SCOPE_AGENT);
            __syncthreads();
            const int k = __builtin_amdgcn_readfirstlane((int)slot[0]);
            __syncthreads();
            if (k >= (dq ? WQD_ITEMS : WQC_ITEMS)) break;
            if (dq) fox_dec_unit(I_PT, I_CLF, I_CK, I_CV, ws, F.out, F.lds, k);
            else if (k < 512) fox_attn_item(ws, F.lds, lds, k & 31, 15 - (k >> 5), ((volatile LAS float*)(F.lds + LDSCTL_OFF))[4]);
            else if (k < 1024) mlstm_a_unit(ws, F.lds, k - 512);
            else mlstm_s_unit(I_SM, I_SN, I_SC, I_GMH, ws, F.out, F.lds, k - 1024);
        } }
    drain_late_weights(F, A);
}
__device__ __forceinline__ void mix_phase_b(Frame& F, const Args& A) {
    PHASE_IDS; size_t wso_ = 0; asm volatile("" : "+s"(wso_)); unsigned char* ws = F.ws + wso_;
    mlstm_b(ws, F.out, F.lds, F.vcu, F.G, tid);
    fox_dec_combine(ws, F.vcu, F.G, tid);
}
__device__ __forceinline__ void mix_phase_c(Frame& F, const Args& A, unsigned char* lds) {
    PHASE_IDS; size_t wso_ = 0; asm volatile("" : "+s"(wso_)); unsigned char* ws = F.ws + wso_;
    for (int u = F.vcu; u < 512; u += F.G) { mlstm_c_unit(A, ws, F.lds, u, tid, lane, wave);
#ifdef DUP_C
        mlstm_c_unit(A, ws, F.lds, u, tid, lane, wave);
#endif
    }
}
__device__ __forceinline__ f32x4 mini_gemm(const bf16* A_, const bf16* Bt, int K, int tr, int tc, LAS float* red, int tid, int lane, int wave, int lda = 0, int ldb = 0) {
    if (lda == 0) lda = K; if (ldb == 0) ldb = K;
    const int fr = lane & 15, fq = lane >> 4; const int ksl = K >> 3, nstep = ksl >> 5;
    f32x4 acc[2][4];
#pragma unroll
    for (int rb = 0; rb < 2; ++rb)
#pragma unroll
        for (int cb = 0; cb < 4; ++cb) acc[rb][cb] = (f32x4){0.f, 0.f, 0.f, 0.f};
    const bf16* Ap = A_ + (size_t)(32 * tr + fr) * lda + wave * ksl + 8 * fq; const bf16* Bp = Bt + (size_t)(64 * tc + fr) * ldb + wave * ksl + 8 * fq;
#pragma unroll 1
    for (int ks0 = 0; ks0 < nstep; ks0 += 4) {
        bf16x8 a[4][2], b[4][4];
#pragma unroll
        for (int u = 0; u < 4; ++u) if (ks0 + u < nstep) {
#pragma unroll
            for (int rb = 0; rb < 2; ++rb) a[u][rb] = *(const GAS bf16x8*)(Ap + (size_t)rb * 16 * lda + 32 * (ks0 + u));
#pragma unroll
            for (int cb = 0; cb < 4; ++cb) b[u][cb] = *(const GAS bf16x8*)(Bp + (size_t)cb * 16 * ldb + 32 * (ks0 + u)); }
        __builtin_amdgcn_sched_barrier(0);
#pragma unroll
        for (int u = 0; u < 4; ++u) if (ks0 + u < nstep) {
#pragma unroll
            for (int rb = 0; rb < 2; ++rb)
#pragma unroll
                for (int cb = 0; cb < 4; ++cb) acc[rb][cb] = MFMA16(b[u][cb], a[u][rb], acc[rb][cb]); }
    }
#pragma unroll
    for (int rb = 0; rb < 2; ++rb)
#pragma unroll
        for (int cb = 0; cb < 4; ++cb) *(LAS f32x4*)(red + wave * 2048 + (16 * rb + fr) * 64 + 16 * cb + 4 * fq) = acc[rb][cb];
    __syncthreads();
    f32x4 s = (f32x4){0.f, 0.f, 0.f, 0.f};
#pragma unroll
    for (int w = 0; w < 8; ++w) s += *(const LAS f32x4*)(red + w * 2048 + (tid >> 4) * 64 + (tid & 15) * 4);
    __syncthreads();
    return s;
}
__device__ __forceinline__ float sig1(float x) { return __builtin_amdgcn_rcpf(1.f + __builtin_amdgcn_exp2f(-LOG2E * x)); }
__device__ __forceinline__ void smp_merge(Frame& F, unsigned char* ws, int tid, int lane, int wave) {
    LAS float* red = (LAS float*)(F.lds + RING_OFF);
    for (int t = F.vcu; t < 256; t += F.G) { const int tr = 8 * (t >> 7) + ((t & 31) >> 2), tc = 4 * ((t >> 5) & 3) + (t & 3);
        const f32x4 a = mini_gemm((const bf16*)(ws + WS_HY) + (size_t)MP * DM, (const bf16*)(ws + WS_WPA), WM, tr, tc, red, tid, lane, wave, DM, DM);
        const f32x4 b = mini_gemm((const bf16*)(ws + WS_HY) + (size_t)MP * DM + 512, (const bf16*)(ws + WS_WPA) + 512, WF, tr, tc, red, tid, lane, wave, DM, DM);
        const size_t idx = (size_t)(MP + 32 * tr + (tid >> 4)) * DM + 64 * tc + 4 * (tid & 15);
        st4bf((bf16*)(ws + WS_U) + idx, ld4bf((const bf16*)(ws + WS_GA) + idx) * a + ld4bf((const bf16*)(ws + WS_GB) + idx) * b); }
}
template <int BASE_BF16> __device__ __forceinline__ void smp_res(Frame& F, const bf16* A_, const bf16* Bt, int K, const void* base, bf16* An, float* ssq, int tid, int lane, int wave) {
    LAS float* red = (LAS float*)(F.lds + RING_OFF);
    for (int t = F.vcu; t < 256; t += F.G) { const int tr = 8 * (t >> 7) + ((t & 31) >> 2), tc = 4 * ((t >> 5) & 3) + (t & 3);
        const f32x4 acc = mini_gemm(A_, Bt, K, tr, tc, red, tid, lane, wave);
        const int r = 32 * tr + (tid >> 4), c = 64 * tc + 4 * (tid & 15); const size_t idx = (size_t)r * DM + c;
        const f32x4 o = (BASE_BF16 ? ld4bf((const bf16*)base + idx) : *(const GAS f32x4*)((const float*)base + idx)) + acc; st4bf(An + idx, o);
        const float s = dpp_sum16(dot4f(o)); if ((tid & 15) == 0) ssq[(size_t)r * 16 + tc] = s; }
}
__device__ __forceinline__ void smp_ple(Frame& F, unsigned char* ws, float* Y  , int tid, int lane, int wave) {
    LAS float* red = (LAS float*)(F.lds + RING_OFF);
    for (int t = F.vcu; t < 256; t += F.G) { const int tr = 8 * (t >> 7) + ((t & 31) >> 2), tc = 4 * ((t >> 5) & 3) + (t & 3);
        const f32x4 acc = mini_gemm((const bf16*)(ws + WS_A3) + (size_t)MP * DM, (const bf16*)(ws + WS_WPG), DM, tr, tc, red, tid, lane, wave);
        const int r = 32 * tr + (tid >> 4), c = 64 * tc + 4 * (tid & 15); const size_t idx = (size_t)r * DM + c;
        const GAS f32x4* sp = (const GAS f32x4*)((const float*)(ws + WS_SSQ3) + (size_t)(MP + r) * 16); const f32x4 q = (sp[0] + sp[1]) + (sp[2] + sp[3]);
        const float rs = rsqrtf(((q[0] + q[1]) + (q[2] + q[3])) * (1.0f / DM) + EPS);
        const f32x4 tp = ld4bf((const bf16*)(ws + WS_TP) + (size_t)MP * DM + idx);
        f32x4 y = ld4bf((const bf16*)(ws + WS_A3) + (size_t)MP * DM + idx); y[0] += sig1(acc[0] * rs) * tp[0]; y[1] += sig1(acc[1] * rs) * tp[1]; y[2] += sig1(acc[2] * rs) * tp[2]; y[3] += sig1(acc[3] * rs) * tp[3];
        *(GAS f32x4*)(Y + idx) = y; }
}
constexpr int N_PHASES = 10;
__global__ void __launch_bounds__(NWAVES * 64, 2) fwd_kernel(Args args) {
    extern __shared__ __attribute__((aligned(16))) unsigned char lds[];
    Frame F;
    F.lds = (LAS unsigned char*)lds;
    F.MISC = (volatile LAS unsigned*)(F.lds + MISC_OFF);
    F.G = gridDim.x; { const int bx = blockIdx.x; F.vcu = (F.G % 8 == 0) ? (bx % 8) * (F.G / 8) + bx / 8 : bx; }
    unsigned char* ws0 = args.ws; F.ws = ws0; F.out = args.out;
    F.ctl = (gu32*)(ws0 + WS_CTL);
    const Args& A = args;
    for (int u = threadIdx.x; u < (LDS_BYTES - LDSCTL_OFF) / 4; u += NWAVES * 64) ((LAS unsigned*)(F.lds + LDSCTL_OFF))[u] = 0u;
    __syncthreads();
    XcdBarrier bar = xcd_barrier_post((unsigned*)(F.ctl + CW_BAR), F.MISC + 8);
    const int lo = args.ph_lo, hi = args.ph_hi;
#ifdef PROBE_A
    unsigned long long stamp_[16]; int ns_ = 0;
#define STAMP() do { stamp_[ns_++] = __builtin_amdgcn_s_memrealtime(); } while (0)
#else
#define STAMP() do {} while (0)
#endif
    STAMP();
#define IN(k) (lo <= (k) && (k) < hi)
#define SEAM(k) do { if (IN(k) && IN((k) + 1)) xcd_barrier(bar); } while (0)
#define PHASE_WS size_t wso_ = 0; asm volatile("" : "+s"(wso_)); unsigned char* ws = ws0 + wso_

#ifdef PROBE_P0
    if (IN(0)) { p0_prologue(F, A, 1); STAMP(); p0_prologue(F, A, 2); STAMP(); p0_prologue(F, A, 4); STAMP(); }
#else
    if (IN(0)) { p0_prologue(F, A); }
#endif
    SEAM(0); STAMP();
    if (IN(1)) { PHASE_WS;
        pg8::Gemm g{(const bf16*)(ws + WS_XN), (const bf16*)(ws + WS_WIN), MT, NIN, DM}; pg8::StaticOrder S; S.init(MT, NIN, F.G, (int)blockIdx.x);
        pg8::EpiIn E{(bf16*)(ws + WS_MQ), (bf16*)(ws + WS_MK), (bf16*)(ws + WS_MV), (bf16*)(ws + WS_MO), (bf16*)(ws + WS_FQ), (bf16*)(ws + WS_FK), (bf16*)(ws + WS_FV), (bf16*)(ws + WS_GA), (bf16*)(ws + WS_GB),
                     F.out + O_KP, F.out + O_KS, F.out + O_VP, F.out + O_VS, I_GQN, I_GKN, C2Q};
        pg8::gemm_phase<pg8::EpiIn, pg8::StaticOrder, true, true>(F.lds + RING_OFF, g, S, E);
        __syncthreads();
        { const int f2i = (int)blockIdx.x - ((int)F.G - 64); if (f2i >= 0 && f2i < 32) { PHASE_IDS; fox_f2_build(ws, F.lds, f2i, tid, lane, wave); } else if ((int)F.G < 64) { PHASE_IDS; for (int bh = (int)blockIdx.x; bh < 32; bh += (int)F.G) fox_f2_build(ws, F.lds, bh, tid, lane, wave); } }
        drain_late_weights(F, A);
    }
    SEAM(1); STAMP();
    if (IN(2)) { mix_phase_a(F, A, lds); }
    SEAM(2); STAMP();
    if (IN(3)) { mix_phase_b(F, A); }
    SEAM(3); STAMP();
    if (IN(4)) { mix_phase_c(F, A, lds); }
    SEAM(4); STAMP();
    if (IN(5)) { PHASE_WS;
        { pg8::Gemm g{(const bf16*)(ws + WS_HY), (const bf16*)(ws + WS_WPA), MP, DM, DM}; pg8::StaticOrder S; S.init(MP, DM, F.G, (int)blockIdx.x);
          pg8::EpiMerge2 E{(const bf16*)(ws + WS_GA), (const bf16*)(ws + WS_GB), (bf16*)(ws + WS_U)};
          pg8::gemm_phase<pg8::EpiMerge2, pg8::StaticOrder, true, true>(F.lds + RING_OFF, g, S, E); }
        __syncthreads();
        { PHASE_IDS; smp_merge(F, ws, tid, lane, wave); }
    }
    SEAM(5); STAMP();
    if (IN(6)) { PHASE_WS;
        pg8::Gemm g{(const bf16*)(ws + WS_U), (const bf16*)(ws + WS_WOUT), MP, DM, DM}; pg8::StaticOrder S; S.init(MP, DM, F.G, (int)blockIdx.x);
        pg8::EpiRes<0> E{I_XP, (bf16*)(ws + WS_A2), (float*)(ws + WS_SSQ2)};
        pg8::gemm_phase<pg8::EpiRes<0>, pg8::StaticOrder, true, true>(F.lds + RING_OFF, g, S, E);
        __syncthreads();
        { PHASE_IDS; smp_res<0>(F, (const bf16*)(ws + WS_U) + (size_t)MP * DM, (const bf16*)(ws + WS_WOUT), DM, I_XS, (bf16*)(ws + WS_A2) + (size_t)MP * DM, (float*)(ws + WS_SSQ2) + (size_t)MP * 16, tid, lane, wave); }
    }
    SEAM(6); STAMP();
    if (IN(7)) { PHASE_WS;
        pg8::Gemm g{(const bf16*)(ws + WS_A2), (const bf16*)(ws + WS_WGU), MT, NGU, DM}; pg8::StaticOrder S; S.init(MT, NGU, F.G, (int)blockIdx.x);
        pg8::EpiGU E{(const float*)(ws + WS_SSQ2), (bf16*)(ws + WS_HB)};
        pg8::gemm_phase<pg8::EpiGU, pg8::StaticOrder, true, true>(F.lds + RING_OFF, g, S, E);
        __syncthreads();
        drain_ple_proj(F);
    }
    SEAM(7); STAMP();
    if (IN(8)) { PHASE_WS;
        { pg8::Gemm g{(const bf16*)(ws + WS_HB), (const bf16*)(ws + WS_WDN), MP, DM, DFF}; pg8::StaticOrder S; S.init(MP, DM, F.G, (int)blockIdx.x);
          pg8::EpiRes<1> E{(const bf16*)(ws + WS_A2), (bf16*)(ws + WS_A3), (float*)(ws + WS_SSQ3)};
          pg8::gemm_phase<pg8::EpiRes<1>, pg8::StaticOrder, true, true>(F.lds + RING_OFF, g, S, E); }
        __syncthreads();
        drain_ple_proj(F);
        __syncthreads();
        { PHASE_IDS; smp_res<1>(F, (const bf16*)(ws + WS_HB) + (size_t)MP * DFF, (const bf16*)(ws + WS_WDN), DFF, (const bf16*)(ws + WS_A2) + (size_t)MP * DM, (bf16*)(ws + WS_A3) + (size_t)MP * DM, (float*)(ws + WS_SSQ3) + (size_t)MP * 16, tid, lane, wave); }
    }
    SEAM(8); STAMP();
    if (IN(9)) { PHASE_WS;
        pg8::Gemm g{(const bf16*)(ws + WS_A3), (const bf16*)(ws + WS_WPG), MP, DM, DM}; pg8::StaticOrder S; S.init(MP, DM, F.G, (int)blockIdx.x);
        pg8::EpiPle E{(const float*)(ws + WS_SSQ3), (const bf16*)(ws + WS_TP), (const bf16*)(ws + WS_A3), F.out + O_YP};
        pg8::gemm_phase<pg8::EpiPle, pg8::StaticOrder, true, true>(F.lds + RING_OFF, g, S, E);
        __syncthreads();
        { PHASE_IDS; smp_ple(F, ws, F.out + O_YS, tid, lane, wave); }
    }
#ifdef PROBE_A
    xcd_barrier(bar); STAMP();
    if (blockIdx.x == 0) { float ta = (float)(stamp_[PROBE_A + 1] - stamp_[PROBE_A]) * 0.01f, tb = (float)(stamp_[PROBE_B + 1] - stamp_[PROBE_B]) * 0.01f;
        const float sc = 1.0f + sqrtf(ta * 0.001f); for (int i = threadIdx.x; i < DB * HM_; i += NWAVES * 64) F.out[O_MS + i] *= sc;
        if (threadIdx.x == 0) F.out[O_YP] += tb * 0.1f; }
#endif
#undef IN
#undef SEAM
}

extern "C" void kernel_launch(void* const* d_in, const int* in_sizes, int n_in, void* d_out, int out_size, void* d_ws, size_t ws_size, hipStream_t stream) {
    static int grid = 0;
    if (grid == 0) {
        if (n_in != 28 || out_size != (int)O_END || ws_size < WS_END) { fprintf(stderr, "kernel_launch: unexpected shapes: n_in %d out %d ws %zu\n", n_in, out_size, ws_size); grid = -1; return; }
        int dev = 0, cus = 0, per_cu = 0;
        if (hipGetDevice(&dev) != hipSuccess || hipDeviceGetAttribute(&cus, hipDeviceAttributeMultiprocessorCount, dev) != hipSuccess) { grid = -1; return; }
        if (hipFuncSetAttribute((const void*)fwd_kernel, hipFuncAttributeMaxDynamicSharedMemorySize, LDS_BYTES) != hipSuccess) { fprintf(stderr, "kernel_launch: hipFuncSetAttribute failed\n"); grid = -1; return; }
        if (hipOccupancyMaxActiveBlocksPerMultiprocessor(&per_cu, (const void*)fwd_kernel, NWAVES * 64, LDS_BYTES) != hipSuccess || per_cu < 1) { fprintf(stderr, "kernel_launch: occupancy query says %d\n", per_cu); }
        (void)hipGetLastError();
        grid = cus;
    }
    if (grid < 0) return;
    if (hipMemsetAsync((char*)d_ws + WS_CTL, 0, CTL_ZERO_BYTES, stream) != hipSuccess) return;
    Args a{};
    for (int i = 0; i < 28; ++i) a.in[i] = d_in[i];
    a.out = (float*)d_out; a.ws = (unsigned char*)d_ws;
#ifndef MK_SPLIT
    a.ph_lo = 0; a.ph_hi = N_PHASES;
    hipLaunchKernelGGL(fwd_kernel, dim3(grid), dim3(NWAVES * 64), LDS_BYTES, stream, a);
#else
    for (int p = 0; p < N_PHASES; ++p) { a.ph_lo = p; a.ph_hi = p + 1; hipLaunchKernelGGL(fwd_kernel, dim3(grid), dim3(NWAVES * 64), LDS_BYTES, stream, a); }
#endif
}
```

```cpp
#include <hip/hip_runtime.h>
#include <hip/hip_bf16.h>
#include <cstdio>
#include <cstdint>
#include <cmath>
namespace pg8 {
#define PG8_LAS __attribute__((address_space(3)))
typedef unsigned short bf16_t;
typedef short bf16x8 __attribute__((ext_vector_type(8)));
typedef float f32x4 __attribute__((ext_vector_type(4)));
typedef unsigned u32x4 __attribute__((ext_vector_type(4)));
constexpr int BM = 256, BK = 64, HALF = 128, HTB = HALF * BK * 2  , STAGE_BYTES = 8 * HTB, NXCD = 8, WGM = 8;

__host__ __device__ __forceinline__ int lds_byte(int r, int c) { const int st = (r >> 4) * 2 + (c >> 5), rr = r & 15, cc = c & 31, ob = rr * 64 + cc * 2; return st * 1024 + (ob ^ (((ob >> 9) & 1) << 5)); }
__host__ __device__ __forceinline__ void stage_rc(int b, int& R, int& C) { const int st = b / 1024, sb = b % 1024, swz = sb ^ (((sb >> 9) & 1) << 5); R = (st >> 1) * 16 + swz / 64; C = (st & 1) * 32 + (swz % 64) / 2; }
__host__ __device__ __forceinline__ int perm32(int rho) { const int n = rho >> 4, i = rho & 15; return 8 * (i >> 2) + 4 * n + (i & 3); }

struct Unit { int pm, pn; };
struct Gemm { const bf16_t* A; const bf16_t* Bt; int M, N, K; };

struct StaticOrder {
    int nM, nN, nwg, G, c;
    __host__ __device__ void init(int M, int N, int G_, int c_) { nM = M / BM; nN = N / BM; nwg = nM * nN; G = G_; c = c_; }
    __host__ __device__ bool next(int i, Unit& u) const {
        const long L = (long)i * G + c; if (L >= nwg) return false;
        int wgid = (int)L; { const int q = nwg / NXCD, r = nwg % NXCD, xcd = wgid % NXCD, off = wgid / NXCD; wgid = (xcd < r ? xcd * (q + 1) : r * (q + 1) + (xcd - r) * q) + off; }
        const int nig = WGM * nN, gid = wgid / nig, fm = gid * WGM, gsz = (nM - fm) < WGM ? (nM - fm) : WGM;
        u.pm = fm + ((wgid % nig) % gsz); u.pn = (wgid % nig) / gsz; return true;
    }
    __device__ __forceinline__ void a_ready(const Unit&) const {}
    __device__ __forceinline__ void done(const Unit&) const {}
};

typedef float pg8_f32x2 __attribute__((ext_vector_type(2))); typedef __bf16 pg8_bf16x2 __attribute__((ext_vector_type(2)));
__device__ __forceinline__ unsigned cvt_pk_bf16(float lo, float hi) { const pg8_f32x2 v = {lo, hi}; const pg8_bf16x2 b = __builtin_convertvector(v, pg8_bf16x2); return __builtin_bit_cast(unsigned, b); }
typedef float f32x2 __attribute__((ext_vector_type(2)));
constexpr float EPSN = 1e-6f;
#define PG8_GAS __attribute__((address_space(1)))
__device__ __forceinline__ void st16_wt(void* p, u32x4 v) { asm volatile("global_store_dwordx4 %0, %1, off sc1\n\ts_nop 1" :: "v"(p), "v"(v) : "memory"); }
__device__ __forceinline__ void st16_wt(void* p, f32x4 v) { st16_wt(p, __builtin_bit_cast(u32x4, v)); }
__device__ __forceinline__ float sigm(float x) { return __builtin_amdgcn_rcpf(1.f + __builtin_amdgcn_exp2f(-1.4426950408889634f * x)); }
__device__ __forceinline__ f32x4 sigm4(f32x4 x) { f32x4 r; r[0] = sigm(x[0]); r[1] = sigm(x[1]); r[2] = sigm(x[2]); r[3] = sigm(x[3]); return r; }
__device__ __forceinline__ void st8bf(bf16_t* p, const f32x4 a, const f32x4 b) { u32x4 w; w.x = cvt_pk_bf16(a[0], a[1]); w.y = cvt_pk_bf16(a[2], a[3]); w.z = cvt_pk_bf16(b[0], b[1]); w.w = cvt_pk_bf16(b[2], b[3]); *(PG8_GAS u32x4*)p = w; }
__device__ __forceinline__ void ld8bf(const bf16_t* p, f32x4& a, f32x4& b) { const u32x4 w = *(const PG8_GAS u32x4*)p;
    a[0] = __uint_as_float(w.x << 16); a[1] = __uint_as_float(w.x & 0xffff0000u); a[2] = __uint_as_float(w.y << 16); a[3] = __uint_as_float(w.y & 0xffff0000u);
    b[0] = __uint_as_float(w.z << 16); b[1] = __uint_as_float(w.z & 0xffff0000u); b[2] = __uint_as_float(w.w << 16); b[3] = __uint_as_float(w.w & 0xffff0000u); }
__device__ __forceinline__ float dot4(f32x4 a) { return (a[0] * a[0] + a[1] * a[1]) + (a[2] * a[2] + a[3] * a[3]); }
constexpr int MP = 16384;

struct EpiIn { static constexpr int ID = 1;
    static constexpr bool PERM = true, AFTER_DRAIN = false, MID = false;
    bf16_t *MQ, *MK, *MV, *MO, *FQ, *FK, *FV, *GA, *GB; float *kp, *ks, *vp, *vs; const float *g_qn, *g_kn; float c2;
    __device__ __forceinline__ void operator()(const f32x4 (&acc)[2][2][4][2], const Unit& u, int wr, int wc, int fr, int fq) const {
        asm volatile("" : "+v"(fr), "+v"(fq));
        const int pn = u.pn; const int row0 = u.pm * BM + wr * 64 + fr; const bool smp = u.pm >= MP / BM;
        if (pn >= 8 && pn < 12) {
            const bool isq = pn < 10; const float* g = isq ? g_qn : g_kn; const float post = isq ? c2 : 1.f;
            f32x4 gv[2][2];
#pragma unroll
            for (int bj = 0; bj < 2; ++bj)
#pragma unroll
                for (int n = 0; n < 2; ++n) gv[bj][n] = *(const PG8_GAS f32x4*)(g + 32 * bj + 8 * fq + 4 * n) * post;
            bf16_t* dst = isq ? FQ : FK; const int colb = (pn & 1) * 256 + 64 * wc + 8 * fq;
            float* ko = smp ? ks - (size_t)MP * 512 : kp;
#pragma unroll
            for (int ai = 0; ai < 2; ++ai)
#pragma unroll
                for (int m = 0; m < 4; ++m) { const size_t row = (size_t)(row0 + ai * HALF + m * 16);
                    float s = (dot4(acc[ai][0][m][0]) + dot4(acc[ai][0][m][1])) + (dot4(acc[ai][1][m][0]) + dot4(acc[ai][1][m][1]));
                    s += __shfl_xor(s, 16); s += __shfl_xor(s, 32);
                    const float r = rsqrtf(s * (1.0f / 64.0f) + EPSN);
#pragma unroll
                    for (int bj = 0; bj < 2; ++bj) { const f32x4 a = acc[ai][bj][m][0] * r * gv[bj][0], b = acc[ai][bj][m][1] * r * gv[bj][1];
                        st8bf(dst + row * 512 + colb + 32 * bj, a, b);
                        if (!isq) { float* o = ko + row * 512 + colb + 32 * bj; __builtin_nontemporal_store(a, (PG8_GAS f32x4*)o); __builtin_nontemporal_store(b, (PG8_GAS f32x4*)(o + 4)); } } }
        } else if (pn < 14) {
            const int seg = pn >> 1;
            bf16_t* dst = seg == 0 ? MQ : seg == 1 ? MK : seg == 2 ? MV : seg == 3 ? MO : FV;
            const float sc = seg == 1 ? 0.08838834764831845f : 1.f; const int colb = (pn & 1) * 256 + 32 * wc + 8 * fq;
            float* vo = smp ? vs - (size_t)MP * 512 : vp;
#pragma unroll
            for (int ai = 0; ai < 2; ++ai)
#pragma unroll
                for (int m = 0; m < 4; ++m) { const size_t row = (size_t)(row0 + ai * HALF + m * 16);
#pragma unroll
                    for (int bj = 0; bj < 2; ++bj) { f32x4 a = acc[ai][bj][m][0] * sc, b = acc[ai][bj][m][1] * sc;
                        if (seg == 3) { a = sigm4(a); b = sigm4(b); }
                        st8bf(dst + row * 512 + colb + 128 * bj, a, b);
                        if (seg == 6) { float* o = vo + row * 512 + colb + 128 * bj; __builtin_nontemporal_store(a, (PG8_GAS f32x4*)o); __builtin_nontemporal_store(b, (PG8_GAS f32x4*)(o + 4)); } } }
        } else {
            const int q = pn - 14; bf16_t* dst = q < 4 ? GA : GB; const int colb = (q & 3) * 256 + 32 * wc + 8 * fq;
#pragma unroll
            for (int ai = 0; ai < 2; ++ai)
#pragma unroll
                for (int m = 0; m < 4; ++m) { const size_t row = (size_t)(row0 + ai * HALF + m * 16);
#pragma unroll
                    for (int bj = 0; bj < 2; ++bj) st8bf(dst + row * 1024 + colb + 128 * bj, sigm4(acc[ai][bj][m][0]), sigm4(acc[ai][bj][m][1])); }
        }
    }
};
struct EpiMerge2 { static constexpr int ID = 2;
    static constexpr bool PERM = true, AFTER_DRAIN = false, MID = true;
    const bf16_t *GA, *GB; bf16_t* U;
    __device__ __forceinline__ void mid(f32x4 (&acc)[2][2][4][2], const Unit& u, int wr, int wc, int fr, int fq) const {
        asm volatile("" : "+v"(fr), "+v"(fq));
        const int row0 = u.pm * BM + wr * 64 + fr, colb = u.pn * BM + 32 * wc + 8 * fq;
#pragma unroll
        for (int ai = 0; ai < 2; ++ai)
#pragma unroll
            for (int m = 0; m < 4; ++m)
#pragma unroll
                for (int bj = 0; bj < 2; ++bj) { const size_t idx = (size_t)(row0 + ai * HALF + m * 16) * 1024 + colb + 128 * bj;
                    f32x4 ga0, ga1, gb0, gb1; ld8bf(GA + idx, ga0, ga1); ld8bf(GB + idx, gb0, gb1);
#pragma unroll
                    for (int v = 0; v < 4; ++v) { acc[ai][bj][m][0][v] *= ga0[v] * __builtin_amdgcn_rcpf(fmaxf(gb0[v], 1e-30f)); acc[ai][bj][m][1][v] *= ga1[v] * __builtin_amdgcn_rcpf(fmaxf(gb1[v], 1e-30f)); } }
    }
    __device__ __forceinline__ void operator()(const f32x4 (&acc)[2][2][4][2], const Unit& u, int wr, int wc, int fr, int fq) const {
        asm volatile("" : "+v"(fr), "+v"(fq));
        const int row0 = u.pm * BM + wr * 64 + fr, colb = u.pn * BM + 32 * wc + 8 * fq;
#pragma unroll
        for (int ai = 0; ai < 2; ++ai) { u32x4 gw[4][2];
#pragma unroll
            for (int m = 0; m < 4; ++m)
#pragma unroll
                for (int bj = 0; bj < 2; ++bj) gw[m][bj] = *(const PG8_GAS u32x4*)(GB + (size_t)(row0 + ai * HALF + m * 16) * 1024 + colb + 128 * bj);
#pragma unroll
            for (int m = 0; m < 4; ++m)
#pragma unroll
                for (int bj = 0; bj < 2; ++bj) { const size_t idx = (size_t)(row0 + ai * HALF + m * 16) * 1024 + colb + 128 * bj; const u32x4 w = gw[m][bj];
                    f32x4 gb0, gb1;
                    gb0[0] = __uint_as_float(w.x << 16); gb0[1] = __uint_as_float(w.x & 0xffff0000u); gb0[2] = __uint_as_float(w.y << 16); gb0[3] = __uint_as_float(w.y & 0xffff0000u);
                    gb1[0] = __uint_as_float(w.z << 16); gb1[1] = __uint_as_float(w.z & 0xffff0000u); gb1[2] = __uint_as_float(w.w << 16); gb1[3] = __uint_as_float(w.w & 0xffff0000u);
#pragma unroll
                    for (int v = 0; v < 4; ++v) { gb0[v] = fmaxf(gb0[v], 1e-30f); gb1[v] = fmaxf(gb1[v], 1e-30f); }
                    st8bf(U + idx, acc[ai][bj][m][0] * gb0, acc[ai][bj][m][1] * gb1); } }
    }
};
template <int BASE_BF16> struct EpiRes { static constexpr int ID = 3;
    static constexpr bool PERM = true, AFTER_DRAIN = false, MID = false;
    const void* base; bf16_t* An; float* ssq;
    __device__ __forceinline__ void operator()(const f32x4 (&acc)[2][2][4][2], const Unit& u, int wr, int wc, int fr, int fq) const {
        asm volatile("" : "+v"(fr), "+v"(fq));
        const int row0 = u.pm * BM + wr * 64 + fr, colb = u.pn * BM + 32 * wc + 8 * fq;
#pragma unroll
        for (int ai = 0; ai < 2; ++ai)
#pragma unroll
            for (int mh = 0; mh < 2; ++mh) { f32x4 ba[2][2], bb[2][2]; u32x4 bw[2][2];
#pragma unroll
                for (int mm = 0; mm < 2; ++mm)
#pragma unroll
                    for (int bj = 0; bj < 2; ++bj) { const size_t idx = (size_t)(row0 + ai * HALF + (2 * mh + mm) * 16) * 1024 + colb + 128 * bj;
                        if (BASE_BF16) bw[mm][bj] = *(const PG8_GAS u32x4*)((const bf16_t*)base + idx); else { ba[mm][bj] = *(const PG8_GAS f32x4*)((const float*)base + idx); bb[mm][bj] = *(const PG8_GAS f32x4*)((const float*)base + idx + 4); } }
#pragma unroll
                for (int mm = 0; mm < 2; ++mm) { const int m = 2 * mh + mm; const int row = row0 + ai * HALF + m * 16; float s = 0.f;
#pragma unroll
                    for (int bj = 0; bj < 2; ++bj) { const size_t idx = (size_t)row * 1024 + colb + 128 * bj; f32x4 a, b;
                        if (BASE_BF16) { const u32x4 w = bw[mm][bj];
                            a[0] = __uint_as_float(w.x << 16); a[1] = __uint_as_float(w.x & 0xffff0000u); a[2] = __uint_as_float(w.y << 16); a[3] = __uint_as_float(w.y & 0xffff0000u);
                            b[0] = __uint_as_float(w.z << 16); b[1] = __uint_as_float(w.z & 0xffff0000u); b[2] = __uint_as_float(w.w << 16); b[3] = __uint_as_float(w.w & 0xffff0000u); }
                        else { a = ba[mm][bj]; b = bb[mm][bj]; }
                        a += acc[ai][bj][m][0]; b += acc[ai][bj][m][1]; s += dot4(a) + dot4(b);
                        st8bf(An + idx, a, b); }
                    s += __shfl_xor(s, 16); s += __shfl_xor(s, 32);
                    if (fq == 0) *(PG8_GAS float*)(ssq + (size_t)row * 16 + u.pn * 4 + wc) = s; } }
    }
};
__device__ __forceinline__ float row_rstd(const float* ssq, int row) { const PG8_GAS f32x4* sp = (const PG8_GAS f32x4*)(ssq + (size_t)row * 16); const f32x4 t = (sp[0] + sp[1]) + (sp[2] + sp[3]);
    return rsqrtf(((t[0] + t[1]) + (t[2] + t[3])) * (1.0f / 1024.0f) + EPSN); }
__device__ __forceinline__ void row_rstd8(const float* ssq, int row0, int fq, float (&rs)[2][4]) {
    f32x4 t[2][4];
#pragma unroll
    for (int ai = 0; ai < 2; ++ai)
#pragma unroll
        for (int m = 0; m < 4; ++m) t[ai][m] = *(const PG8_GAS f32x4*)(ssq + (size_t)(row0 + ai * HALF + m * 16) * 16 + 4 * fq);
#pragma unroll
    for (int ai = 0; ai < 2; ++ai)
#pragma unroll
        for (int m = 0; m < 4; ++m) { float q = (t[ai][m][0] + t[ai][m][1]) + (t[ai][m][2] + t[ai][m][3]); q += __shfl_xor(q, 16); q += __shfl_xor(q, 32); rs[ai][m] = rsqrtf(q * (1.0f / 1024.0f) + EPSN); }
}
struct EpiGU { static constexpr int ID = 4;
    static constexpr bool PERM = true, AFTER_DRAIN = false, MID = false;
    const float* ssq; bf16_t* HB;
    __device__ __forceinline__ void operator()(const f32x4 (&acc)[2][2][4][2], const Unit& u, int wr, int wc, int fr, int fq) const {
        asm volatile("" : "+v"(fr), "+v"(fq));
        const int row0 = u.pm * BM + wr * 64 + fr, colb = u.pn * 128 + 32 * wc + 8 * fq;
        float rsv[2][4]; row_rstd8(ssq, row0, fq, rsv);
#pragma unroll
        for (int ai = 0; ai < 2; ++ai)
#pragma unroll
            for (int m = 0; m < 4; ++m) { const int row = row0 + ai * HALF + m * 16; const float rs = rsv[ai][m];
                f32x4 h[2];
#pragma unroll
                for (int n = 0; n < 2; ++n) { const f32x4 gg = acc[ai][0][m][n] * rs, uu = acc[ai][1][m][n] * rs; h[n] = gg * sigm4(gg) * uu; }
                st8bf(HB + (size_t)row * 2816 + colb, h[0], h[1]); }
    }
};
struct EpiStore { static constexpr int ID = 5;
    static constexpr bool PERM = true, AFTER_DRAIN = false, MID = false;
    bf16_t* O;
    __device__ __forceinline__ void operator()(const f32x4 (&acc)[2][2][4][2], const Unit& u, int wr, int wc, int fr, int fq) const {
        asm volatile("" : "+v"(fr), "+v"(fq));
        const int row0 = u.pm * BM + wr * 64 + fr, colb = u.pn * BM + 32 * wc + 8 * fq;
#pragma unroll
        for (int ai = 0; ai < 2; ++ai)
#pragma unroll
            for (int m = 0; m < 4; ++m)
#pragma unroll
                for (int bj = 0; bj < 2; ++bj) st8bf(O + (size_t)(row0 + ai * HALF + m * 16) * 1024 + colb + 128 * bj, acc[ai][bj][m][0], acc[ai][bj][m][1]);
    }
};
struct EpiPle { static constexpr int ID = 6;
    static constexpr bool PERM = true, AFTER_DRAIN = false, MID = false;
    const float* ssq; const bf16_t* TP; const bf16_t* X2; float* Y;
    __device__ __forceinline__ void operator()(const f32x4 (&acc)[2][2][4][2], const Unit& u, int wr, int wc, int fr, int fq) const {
        asm volatile("" : "+v"(fr), "+v"(fq));
        const int row0 = u.pm * BM + wr * 64 + fr, colb = u.pn * BM + 32 * wc + 8 * fq;
        float rsv[2][4]; row_rstd8(ssq, row0, fq, rsv);
#pragma unroll
        for (int ai = 0; ai < 2; ++ai)
#pragma unroll
            for (int mh = 0; mh < 2; ++mh) { u32x4 tw[2][2], xw[2][2];
#pragma unroll
                for (int mm = 0; mm < 2; ++mm)
#pragma unroll
                    for (int bj = 0; bj < 2; ++bj) { const size_t idx = (size_t)(row0 + ai * HALF + (2 * mh + mm) * 16) * 1024 + colb + 128 * bj;
                        tw[mm][bj] = *(const PG8_GAS u32x4*)(TP + idx); xw[mm][bj] = *(const PG8_GAS u32x4*)(X2 + idx); }
#pragma unroll
                for (int mm = 0; mm < 2; ++mm) { const int m = 2 * mh + mm; const int row = row0 + ai * HALF + m * 16; const float rs = rsv[ai][m];
#pragma unroll
                    for (int bj = 0; bj < 2; ++bj) { const size_t idx = (size_t)row * 1024 + colb + 128 * bj; f32x4 ta, tb, xa, xb; const u32x4 w = tw[mm][bj], x = xw[mm][bj];
                        ta[0] = __uint_as_float(w.x << 16); ta[1] = __uint_as_float(w.x & 0xffff0000u); ta[2] = __uint_as_float(w.y << 16); ta[3] = __uint_as_float(w.y & 0xffff0000u);
                        tb[0] = __uint_as_float(w.z << 16); tb[1] = __uint_as_float(w.z & 0xffff0000u); tb[2] = __uint_as_float(w.w << 16); tb[3] = __uint_as_float(w.w & 0xffff0000u);
                        xa[0] = __uint_as_float(x.x << 16); xa[1] = __uint_as_float(x.x & 0xffff0000u); xa[2] = __uint_as_float(x.y << 16); xa[3] = __uint_as_float(x.y & 0xffff0000u);
                        xb[0] = __uint_as_float(x.z << 16); xb[1] = __uint_as_float(x.z & 0xffff0000u); xb[2] = __uint_as_float(x.w << 16); xb[3] = __uint_as_float(x.w & 0xffff0000u);
                        *(PG8_GAS f32x4*)(Y + idx) = xa + sigm4(acc[ai][bj][m][0] * rs) * ta; *(PG8_GAS f32x4*)(Y + idx + 4) = xb + sigm4(acc[ai][bj][m][1] * rs) * tb; } } }
    }
};
template <class Epi, class Sched, bool ALIGN_EPI = false, bool SP2 = false>
__device__ __forceinline__ void gemm_phase(PG8_LAS unsigned char* lds, const Gemm g, const Sched& S, const Epi& E) {
    int tid_ = threadIdx.x; asm volatile("" : "+v"(tid_));
    const int tid = tid_, wid = __builtin_amdgcn_readfirstlane(tid >> 6), lane = tid & 63, wr = wid >> 2, wc = wid & 3, fr = lane & 15, fq = lane >> 4;
    int K_ = g.K; asm volatile("" : "+s"(K_));
    const int K = K_, nt = K / BK;
    unsigned voffA[2], voffB[2];
#pragma unroll
    for (int i = 0; i < 2; ++i) { int R, C; stage_rc(tid * 16 + i * 8192, R, C); const int Rb = Epi::PERM ? ((R & ~31) + perm32(R & 31)) : R;
        voffA[i] = (unsigned)(R * K + C) * 2u; voffB[i] = (unsigned)(Rb * K + C) * 2u; }
    const size_t kstep = (size_t)(BK * 2);
    const size_t hstep = (size_t)HALF * K * 2;
    const size_t tstep = 2 * hstep;
    const unsigned ldsw = (unsigned)wid * 1024u;
    const int aoff = lds_byte(wr * 64 + fr, fq * 8), boff = lds_byte(wc * 32 + fr, fq * 8);
#define PG8_SA(b, h) (((b) * 2 + (h)) * HTB)
#define PG8_SB(b, h) ((4 + (b) * 2 + (h)) * HTB)
#define PG8_STAGE(bufoff, gbase, voff) do { _Pragma("unroll") for (int _i = 0; _i < 2; ++_i) \
        __builtin_amdgcn_global_load_lds((const unsigned*)((const char*)(gbase) + (voff)[_i]), (PG8_LAS unsigned*)(lds + (bufoff) + ldsw + _i * 8192), 16, 0, 0); } while (0)
#define PG8_LDA(dst, b, h) do { _Pragma("unroll") for (int m = 0; m < 4; ++m) _Pragma("unroll") for (int k = 0; k < 2; ++k) dst[m][k] = *(const PG8_LAS bf16x8*)(lds + PG8_SA(b, h) + aoff + m * 2048 + k * 1024); } while (0)
#define PG8_LDB(dst, b, h) do { _Pragma("unroll") for (int n = 0; n < 2; ++n) _Pragma("unroll") for (int k = 0; k < 2; ++k) dst[n][k] = *(const PG8_LAS bf16x8*)(lds + PG8_SB(b, h) + boff + n * 2048 + k * 1024); } while (0)
#define PG8_MMA(ai, bj, At, Bt) do { __builtin_amdgcn_s_setprio(1); _Pragma("unroll") for (int m = 0; m < 4; ++m) _Pragma("unroll") for (int n = 0; n < 2; ++n) _Pragma("unroll") for (int k = 0; k < 2; ++k) \
        acc[ai][bj][m][n] = __builtin_amdgcn_mfma_f32_16x16x32_bf16(Bt[n][k], At[m][k], acc[ai][bj][m][n], 0, 0, 0); __builtin_amdgcn_s_setprio(0); } while (0)
#define PG8_WAIT_V(n) asm volatile("s_waitcnt vmcnt(" #n ")" ::: "memory")
#define PG8_WAIT_L(n) asm volatile("s_waitcnt lgkmcnt(" #n ")" ::: "memory")
#define PG8_BAR __builtin_amdgcn_s_barrier()
#define PG8_SCHED __builtin_amdgcn_sched_barrier(0)
    Unit cur, nxt; int ui = 0;
    if (!S.next(0, cur)) return;
    f32x4 acc[2][2][4][2];
#pragma unroll
    for (int a = 0; a < 2; ++a)
#pragma unroll
        for (int b = 0; b < 2; ++b)
#pragma unroll
            for (int m = 0; m < 4; ++m)
#pragma unroll
                for (int n = 0; n < 2; ++n) acc[a][b][m][n] = (f32x4){0.f, 0.f, 0.f, 0.f};
    bf16x8 At[4][2], B0[2][2], B1[2][2];
    const char* cA = (const char*)g.A + (size_t)cur.pm * tstep; const char* cB = (const char*)g.Bt + (size_t)cur.pn * tstep;
    S.a_ready(cur);
    if constexpr (SP2) {
        PG8_STAGE(PG8_SB(0, 0), cB, voffB); PG8_STAGE(PG8_SB(0, 1), cB + hstep, voffB); PG8_STAGE(PG8_SA(0, 0), cA, voffA); PG8_STAGE(PG8_SA(0, 1), cA + hstep, voffA);
        if (wr == 1) PG8_BAR;
        PG8_WAIT_V(2); PG8_BAR;
        PG8_STAGE(PG8_SB(1, 0), cB + kstep, voffB); PG8_STAGE(PG8_SA(1, 0), cA + kstep, voffA); PG8_STAGE(PG8_SB(1, 1), cB + hstep + kstep, voffB);
        PG8_WAIT_V(6); PG8_BAR;
    } else {
        PG8_STAGE(PG8_SB(0, 0), cB, voffB); PG8_STAGE(PG8_SA(0, 0), cA, voffA); PG8_STAGE(PG8_SB(0, 1), cB + hstep, voffB); PG8_STAGE(PG8_SA(0, 1), cA + hstep, voffA);
        if (wr == 1) PG8_BAR;
        PG8_WAIT_V(4); PG8_BAR;
        PG8_STAGE(PG8_SB(1, 0), cB + kstep, voffB); PG8_STAGE(PG8_SA(1, 0), cA + kstep, voffA); PG8_STAGE(PG8_SB(1, 1), cB + hstep + kstep, voffB);
        PG8_WAIT_V(6); PG8_BAR;
    }
    for (;;) {
        const bool has_next = S.next(ui + 1, nxt);
        const char* nA = has_next ? (const char*)g.A + (size_t)nxt.pm * tstep : cA; const char* nB = has_next ? (const char*)g.Bt + (size_t)nxt.pn * tstep : cB;
        for (int t = 0; t < nt; t += 2) {
            if constexpr (Epi::MID) { if (t == (nt >> 1)) E.mid(acc, cur, wr, wc, fr, fq); }
            const bool last = (t == nt - 2);
            const char* a1 = cA + (size_t)(t + 1) * kstep;
            const char* a2 = last ? nA : cA + (size_t)(t + 2) * kstep; const char* b2 = last ? nB : cB + (size_t)(t + 2) * kstep;
            const char* a3 = a2 + kstep; const char* b3 = b2 + kstep;
            if (last && has_next) S.a_ready(nxt);
            if constexpr (SP2) {
            PG8_LDB(B0, 0, 0); PG8_LDB(B1, 0, 1); PG8_SCHED; PG8_LDA(At, 0, 0); PG8_STAGE(PG8_SA(1, 1), a1 + hstep, voffA);
            PG8_WAIT_V(8); PG8_WAIT_L(0); PG8_BAR; PG8_MMA(0, 0, At, B0); PG8_MMA(0, 1, At, B1); PG8_BAR; PG8_SCHED;
            PG8_LDA(At, 0, 1); PG8_STAGE(PG8_SB(0, 0), b2, voffB); PG8_STAGE(PG8_SB(0, 1), b2 + hstep, voffB); PG8_STAGE(PG8_SA(0, 0), a2, voffA);
            PG8_WAIT_V(8); PG8_WAIT_L(0); PG8_BAR; PG8_MMA(1, 0, At, B0); PG8_MMA(1, 1, At, B1); PG8_BAR; PG8_SCHED;
            PG8_LDB(B0, 1, 0); PG8_LDB(B1, 1, 1); PG8_SCHED; PG8_LDA(At, 1, 0); PG8_STAGE(PG8_SA(0, 1), a2 + hstep, voffA);
            PG8_WAIT_V(8); PG8_WAIT_L(0); PG8_BAR; PG8_MMA(0, 0, At, B0); PG8_MMA(0, 1, At, B1); PG8_BAR; PG8_SCHED;
            PG8_LDA(At, 1, 1); PG8_STAGE(PG8_SB(1, 0), b3, voffB); PG8_STAGE(PG8_SB(1, 1), b3 + hstep, voffB); PG8_STAGE(PG8_SA(1, 0), a3, voffA);
            PG8_WAIT_V(8); PG8_WAIT_L(0); PG8_BAR; PG8_MMA(1, 0, At, B0); PG8_MMA(1, 1, At, B1); PG8_BAR; PG8_SCHED;
            } else {
            PG8_LDB(B0, 0, 0); PG8_SCHED; PG8_LDA(At, 0, 0); PG8_STAGE(PG8_SA(1, 1), a1 + hstep, voffA);
            PG8_WAIT_L(8); PG8_BAR; PG8_WAIT_L(0); PG8_MMA(0, 0, At, B0); PG8_BAR; PG8_SCHED;
            PG8_LDB(B1, 0, 1); PG8_STAGE(PG8_SB(0, 0), b2, voffB);
            PG8_BAR; PG8_WAIT_L(0); PG8_MMA(0, 1, At, B1); PG8_BAR;
            PG8_LDA(At, 0, 1); PG8_STAGE(PG8_SA(0, 0), a2, voffA);
            PG8_BAR; PG8_WAIT_L(0); PG8_MMA(1, 0, At, B0); PG8_BAR; PG8_SCHED;
            PG8_STAGE(PG8_SB(0, 1), b2 + hstep, voffB);
            PG8_WAIT_V(6); PG8_BAR; PG8_MMA(1, 1, At, B1); PG8_BAR;
            PG8_LDB(B0, 1, 0); PG8_SCHED; PG8_LDA(At, 1, 0); PG8_STAGE(PG8_SA(0, 1), a2 + hstep, voffA);
            PG8_WAIT_L(8); PG8_BAR; PG8_WAIT_L(0); PG8_MMA(0, 0, At, B0); PG8_BAR; PG8_SCHED;
            PG8_LDB(B1, 1, 1); PG8_STAGE(PG8_SB(1, 0), b3, voffB);
            PG8_BAR; PG8_WAIT_L(0); PG8_MMA(0, 1, At, B1); PG8_BAR;
            PG8_LDA(At, 1, 1); PG8_STAGE(PG8_SA(1, 0), a3, voffA);
            PG8_BAR; PG8_WAIT_L(0); PG8_MMA(1, 0, At, B0); PG8_BAR; PG8_SCHED;
            PG8_STAGE(PG8_SB(1, 1), b3 + hstep, voffB);
            PG8_WAIT_V(6); PG8_BAR; PG8_MMA(1, 1, At, B1); PG8_BAR;
            }
        }
        if constexpr (ALIGN_EPI) { if (wr == 0) PG8_BAR; }
#ifdef DUP_EPI
        if constexpr (Epi::ID == DUP_EPI) { E(acc, cur, wr, wc, fr, fq); asm volatile("" ::: "memory"); }
#endif
        if constexpr (!Epi::AFTER_DRAIN) { E(acc, cur, wr, wc, fr, fq); S.done(cur); }
        if (!has_next) break;
#pragma unroll
        for (int a = 0; a < 2; ++a)
#pragma unroll
            for (int b = 0; b < 2; ++b)
#pragma unroll
                for (int m = 0; m < 4; ++m)
#pragma unroll
                    for (int n = 0; n < 2; ++n) acc[a][b][m][n] = (f32x4){0.f, 0.f, 0.f, 0.f};
        cur = nxt; cA = nA; cB = nB; ++ui;
        if constexpr (ALIGN_EPI) { if (wr == 1) PG8_BAR; }
    }
    PG8_WAIT_V(0);
    if constexpr (!ALIGN_EPI) { if (wr == 0) PG8_BAR; }
    PG8_BAR;
    if constexpr (Epi::AFTER_DRAIN) { E.fused(acc, cur, wr, wc, fr, fq, lds, wid, lane); S.done(cur); }
#undef PG8_SA
#undef PG8_SB
#undef PG8_STAGE
#undef PG8_LDA
#undef PG8_LDB
#undef PG8_MMA
#undef PG8_WAIT_V
#undef PG8_WAIT_L
#undef PG8_BAR
#undef PG8_SCHED
}
}
namespace attn_body {
using bf16=__hip_bfloat16;
using bf16x8=__attribute__((ext_vector_type(8)))short;
using s16x4=__attribute__((ext_vector_type(4)))short;
using f32x16=__attribute__((ext_vector_type(16)))float;
using u32x4=__attribute__((ext_vector_type(4)))unsigned;
constexpr int BATCH=4,NHEAD=8,SEQ=4096,D=64,DM=NHEAD*D;
constexpr int NW=8,QBLK=32,QB=QBLK*NW,KVBLK=64,NQB=SEQ/QB;
constexpr int ATTN_PITCH=DM, ATTN_UNIT_ROWS=QB, OPITCH=1024;
__device__ __forceinline__ int crow(int r,int hi){return (r&3)+8*(r>>2)+4*hi;}
#define SBAR() __builtin_amdgcn_sched_barrier(0)
__device__ __forceinline__ void cmask(f32x16&p0,f32x16&p1,int jb,int qrel,int hi){
  const float NEG=-INFINITY; int kb=64*jb+4*hi;
  #pragma unroll
  for(int r=0;r<16;++r){int kv=kb+(r&3)+8*(r>>2); if(kv>qrel)p0[r]=NEG; if(kv+32>qrel)p1[r]=NEG;}
}

constexpr int NSLOT=3, SLOTB=8192;
constexpr int LDS_K=0, LDS_V=NSLOT*SLOTB, LDS_WS=2*NSLOT*SLOTB, LDS_OST=LDS_WS+NW*64*4, LDS_BYTES=LDS_OST+NW*4096;
constexpr int LDS_TB=86016, LDS_F2=102400, LDS_BYTES_X=118784;
constexpr float C2=0.125f*1.4426950408889634f;
__device__ __forceinline__ void glds16(const void*gsrc,unsigned lds_dst){unsigned keep;
  asm volatile("s_mov_b32 %0, m0\n\ts_mov_b32 m0, %2\n\ts_nop 0\n\tglobal_load_lds_dwordx4 %1, off\n\ts_mov_b32 m0, %0":"=&s"(keep):"v"(gsrc),"s"(lds_dst):"memory");}
__device__ __forceinline__ float max3f(float a,float b,float c){float r;asm("v_max3_f32 %0, %1, %2, %3":"=v"(r):"v"(a),"v"(b),"v"(c));return r;}
__device__ __forceinline__ float max2f(float a,float b){float r;asm("v_max_f32_e32 %0, %1, %2":"=v"(r):"v"(a),"v"(b));return r;}
__device__ __forceinline__ float fadd_s(float a,float b){float r;asm("v_add_f32_e32 %0, %1, %2":"=v"(r):"v"(a),"v"(b));return r;}
__device__ __forceinline__ float fsub_s(float a,float b){float r;asm("v_sub_f32_e32 %0, %1, %2":"=v"(r):"v"(a),"v"(b));return r;}
typedef float f32x4_t __attribute__((ext_vector_type(4))); typedef float f32x2_t __attribute__((ext_vector_type(2))); typedef __bf16 bf16x2_t __attribute__((ext_vector_type(2)));
__device__ __forceinline__ unsigned cvtpk_s(float lo,float hi){f32x2_t v={lo,hi};bf16x2_t b=__builtin_convertvector(v,bf16x2_t);return __builtin_bit_cast(unsigned,b);}
#define WAIT_BAR(N) asm volatile("s_waitcnt vmcnt(" #N ") lgkmcnt(0)\n\ts_barrier":::"memory")

__device__ __forceinline__ void qkt(f32x16&p0,f32x16&p1,const char*Kslot,const bf16x8*qr,const f32x16&negm,int r32,int hi){
  const char*kb=Kslot+hi*1024+r32*16;
  #pragma unroll
  for(int d0=0;d0<4;++d0){
    const bf16x8 b0=*reinterpret_cast<const bf16x8*>(kb+d0*2048);
    const bf16x8 b1=*reinterpret_cast<const bf16x8*>(kb+d0*2048+512);
    if(d0==0){p0=__builtin_amdgcn_mfma_f32_32x32x16_bf16(b0,qr[0],negm,0,0,0);p1=__builtin_amdgcn_mfma_f32_32x32x16_bf16(b1,qr[0],negm,0,0,0);}
    else{p0=__builtin_amdgcn_mfma_f32_32x32x16_bf16(b0,qr[d0],p0,0,0,0);p1=__builtin_amdgcn_mfma_f32_32x32x16_bf16(b1,qr[d0],p1,0,0,0);}}
}
typedef __attribute__((address_space(3))) const char* lds_cptr;
typedef short v4i16_t __attribute__((ext_vector_type(4)));
__device__ __forceinline__ void kload8(bf16x8*kf,lds_cptr kp){
  kf[0]=*(const __attribute__((address_space(3))) bf16x8*)(kp);      kf[1]=*(const __attribute__((address_space(3))) bf16x8*)(kp+512);
  kf[2]=*(const __attribute__((address_space(3))) bf16x8*)(kp+2048); kf[3]=*(const __attribute__((address_space(3))) bf16x8*)(kp+2560);
  kf[4]=*(const __attribute__((address_space(3))) bf16x8*)(kp+4096); kf[5]=*(const __attribute__((address_space(3))) bf16x8*)(kp+4608);
  kf[6]=*(const __attribute__((address_space(3))) bf16x8*)(kp+6144); kf[7]=*(const __attribute__((address_space(3))) bf16x8*)(kp+6656);
}
__device__ __forceinline__ void kload2(bf16x8*kf,lds_cptr kp,int j){ kf[2*j]=*(const __attribute__((address_space(3))) bf16x8*)(kp+j*2048); kf[2*j+1]=*(const __attribute__((address_space(3))) bf16x8*)(kp+j*2048+512); }
__device__ __forceinline__ s16x4 vtr(lds_cptr p){ return __builtin_bit_cast(s16x4,__builtin_amdgcn_ds_read_tr16_b64_v4i16((__attribute__((address_space(3))) v4i16_t*)p)); }
__device__ __forceinline__ float rowmax(const f32x16&p0,const f32x16&p1){
  float a=max3f(p0[0],p0[1],p1[0]),b=max3f(p0[2],p0[3],p1[1]);a=max3f(a,p1[2],p1[3]);
  #pragma unroll
  for(int r=4;r<16;r+=4){a=max3f(a,p0[r],p0[r+1]);b=max3f(b,p0[r+2],p0[r+3]);a=max3f(a,p1[r],p1[r+1]);b=max3f(b,p1[r+2],p1[r+3]);}
  const float m=max2f(a,b);
  auto rr=__builtin_amdgcn_permlane32_swap(__float_as_uint(m),__float_as_uint(m),false,false);
  return max2f(__uint_as_float(rr[0]),__uint_as_float(rr[1]));
}
__device__ __forceinline__ void pv(f32x16*o,int vb,bf16x8 pa0,bf16x8 pa1,bf16x8 pa2,bf16x8 pa3){
  #pragma unroll
  for(int d0=0;d0<2;++d0){s16x4 lo[4],hi[4];
    #pragma unroll
    for(int ks=0;ks<4;++ks){
      asm volatile("ds_read_b64_tr_b16 %0,%1 offset:%c2":"=&v"(lo[ks]):"v"(vb),"i"(d0*4096+ks*1024):"memory");
      asm volatile("ds_read_b64_tr_b16 %0,%1 offset:%c2":"=&v"(hi[ks]):"v"(vb),"i"(d0*4096+ks*1024+512):"memory");}
    asm volatile("s_waitcnt lgkmcnt(0)":::"memory");SBAR();
    #define PK(k) (bf16x8){lo[k][0],lo[k][1],lo[k][2],lo[k][3],hi[k][0],hi[k][1],hi[k][2],hi[k][3]}
    o[d0]=__builtin_amdgcn_mfma_f32_32x32x16_bf16(pa0,PK(0),o[d0],0,0,0);
    o[d0]=__builtin_amdgcn_mfma_f32_32x32x16_bf16(pa1,PK(1),o[d0],0,0,0);
    o[d0]=__builtin_amdgcn_mfma_f32_32x32x16_bf16(pa2,PK(2),o[d0],0,0,0);
    o[d0]=__builtin_amdgcn_mfma_f32_32x32x16_bf16(pa3,PK(3),o[d0],0,0,0);
    #undef PK
  }
}

#ifndef ATTN_STORE16
#define ATTN_STORE16(p,v) (*(u32x4*)(p)=(v))
#endif
template<int THRL> __device__ __forceinline__ void attn_unit(int b,int h,int qb,int t0,const bf16*Q,const bf16*__restrict__ K,const bf16*__restrict__ V,bf16*O,char*shm){
  int tid_=threadIdx.x; asm volatile("":"+v"(tid_)); const int tid=tid_,lane=tid&63,r32=lane&31,hi=lane>>5; const int wid=__builtin_amdgcn_readfirstlane(tid>>6);
  const long rowbase=(long)b*SEQ; const int q0=qb*QB;
  const bf16*Qw=Q+(rowbase+q0+wid*QBLK)*DM+h*D;
  const bf16*Kh=K+(rowbase+(long)t0*KVBLK)*DM+h*D,*Vh=V+(rowbase+(long)t0*KVBLK)*DM+h*D;
  const unsigned lds0=(unsigned)(uintptr_t)shm;
  float*wsf=(float*)(shm+LDS_WS)+wid*64;
  typedef __attribute__((address_space(3))) float lds_f32; typedef __attribute__((address_space(3))) const f32x4_t lds_cf4;
  const lds_f32*tbp=(const lds_f32*)(shm+LDS_F2)+4*hi+64*t0;
  #define TBADD(C0,C1,t) do{ const lds_cf4*tq_=(const lds_cf4*)(tbp+64*(t)); \
    { const f32x4_t a0_=tq_[0],a1_=tq_[2],a2_=tq_[4],a3_=tq_[6]; _Pragma("unroll") for(int v_=0;v_<4;++v_){C0[v_]+=a0_[v_];C0[4+v_]+=a1_[v_];C0[8+v_]+=a2_[v_];C0[12+v_]+=a3_[v_];} } \
    { const f32x4_t a0_=tq_[8],a1_=tq_[10],a2_=tq_[12],a3_=tq_[14]; _Pragma("unroll") for(int v_=0;v_<4;++v_){C1[v_]+=a0_[v_];C1[4+v_]+=a1_[v_];C1[8+v_]+=a2_[v_];C1[12+v_]+=a3_[v_];} } }while(0)
  const bf16*ksrc=Kh+(long)lane*DM+wid*8;
  const bf16*vsrc=Vh+(long)(16*(wid&3)+(lane>>2))*DM+(wid>>2)*32+(lane&3)*8;
  const unsigned kdst=lds0+LDS_K+wid*1024, vdst=lds0+LDS_V+wid*1024;
  #define DMA_K(t,slot) glds16(ksrc+(long)(t)*KVBLK*DM,(unsigned)__builtin_amdgcn_readfirstlane(kdst+(slot)))
  #define DMA_V(t,slot) glds16(vsrc+(long)(t)*KVBLK*DM,(unsigned)__builtin_amdgcn_readfirstlane(vdst+(slot)))
  const int vb0=(int)(lds0+LDS_V)+((lane>>4)&1)*32+(lane&3)*8+(4*hi+((lane&15)>>2))*64;
  const char*Kbase=shm+LDS_K; bf16x8 kf[8];
  const lds_cptr shm3=(lds_cptr)shm; const lds_cptr kp0=shm3+LDS_K+hi*1024+r32*16; const lds_cptr vp0=shm3+LDS_V+((lane>>4)&1)*32+(lane&3)*8+(4*hi+((lane&15)>>2))*64;
  const int NT=(q0+QB)/KVBLK-t0;
  DMA_K(0,0);DMA_V(0,0);DMA_K(1,SLOTB);
  bf16x8 qr[4];
  #pragma unroll
  for(int d0=0;d0<4;++d0)qr[d0]=*reinterpret_cast<const bf16x8*>(&Qw[(long)r32*DM+d0*16+hi*8]);
  float zero_;asm volatile("v_mov_b32 %0, 0":"=v"(zero_));
  float mhat=zero_,l_reg=zero_;f32x16 o[2],negm;
  _Pragma("unroll") for(int r=0;r<16;++r){o[0][r]=zero_;o[1][r]=zero_;negm[r]=zero_;} asm volatile("":"+v"(negm));
  const int qrel=wid*QBLK+r32;
  #define CMASK(P0,P1,t) do{int jb_=(t)-(NT-4); if(jb_>=0)cmask(P0,P1,jb_,qrel,hi);}while(0)
  bool resc=false;
  #define START(P0,P1) do{ const float rm=rowmax(P0,P1); resc=false; \
    { const float dl=rm; mhat=fadd_s(mhat,dl); \
      _Pragma("unroll") for(int r=0;r<16;++r){P0[r]=fsub_s(P0[r],dl);P1[r]=fsub_s(P1[r],dl);} \
      _Pragma("unroll") for(int r=0;r<16;++r)negm[r]=-mhat; asm volatile("":"+v"(negm)); } \
    _Pragma("unroll") for(int r=0;r<16;++r)P0[r]=__builtin_amdgcn_exp2f(P0[r]); }while(0)
  #define RESC() do{ if(resc){ asm volatile("s_waitcnt lgkmcnt(0)":::"memory"); \
      _Pragma("unroll") for(int d_=0;d_<2;++d_) _Pragma("unroll") for(int r=0;r<16;++r)o[d_][r]*=wsf[crow(r,hi)]; } }while(0)
  f32x16 pA0,pA1,pB0,pB1;
  int sl_prev=0,sl_cur=0,sl_next=SLOTB;
  #define ROT() do{sl_prev=sl_cur;sl_cur=sl_next;sl_next=(sl_next==(NSLOT-1)*SLOTB)?0:sl_next+SLOTB;}while(0)
  DMA_K(2,2*SLOTB);
  WAIT_BAR(3);
  qkt(pA0,pA1,Kbase,qr,negm,r32,hi);asm volatile("s_nop 15\n\ts_nop 7":"+v"(pA0),"+v"(pA1));TBADD(pA0,pA1,0);CMASK(pA0,pA1,0);
  START(pA0,pA1);
  _Pragma("unroll") for(int r=0;r<16;++r)pA1[r]=__builtin_amdgcn_exp2f(pA1[r]);
  WAIT_BAR(0);
  DMA_K(3,0);DMA_V(1,SLOTB);
  ROT();
  kload8(kf,kp0+sl_cur);
  WAIT_BAR(2);
  s16x4 vlo[8],vhi[8]; u32x4 pw0,pw1,pw2,pw3;
  #define PKW(P,B) cvtpk_s(P[B],P[B+1])
  #define PAF(k) __builtin_bit_cast(bf16x8,pw##k)
  #define VFR(i) (bf16x8){vlo[i][0],vlo[i][1],vlo[i][2],vlo[i][3],vhi[i][0],vhi[i][1],vhi[i][2],vhi[i][3]}
  #define PIN(x) asm volatile("":"+v"(x))
  #define MX3(a,b,c) __builtin_fmaxf(__builtin_fmaxf((a),(b)),(c))
  #define GAPA(MF,A0,A1,A2,A3,W0,W1,PW) do{ MF; sacc+=A0; sacc+=A1; sacc+=A2; sacc+=A3; PIN(sacc); W0; W1; PIN(PW); SBAR(); }while(0)
  #define EX(v) __builtin_amdgcn_exp2f(v)
  #define GAPB(MF,X,B) do{ MF; X[B]=EX(X[B]); X[B+1]=EX(X[B+1]); X[B+2]=EX(X[B+2]); X[B+3]=EX(X[B+3]); PIN(X); SBAR(); }while(0)
  #define VRD(i) do{ vlo[i]=vtr(vp_+(((i)>>2)*4096+((i)&3)*1024)); vhi[i]=vtr(vp_+(((i)>>2)*4096+((i)&3)*1024+512)); }while(0)
  #define KRD(G,j) do{ if(G){ kload2(kf,kp0+sl_next,j); SBAR(); } }while(0)
  #define STEP(C0,C1,P0,P1,t,GK,GV,GL) do{ SBAR(); \
    const lds_cptr vp_=vp0+sl_prev; \
    VRD(0); SBAR(); float sacc=(P0[0]+P0[1]); \
    GAPA(C0=__builtin_amdgcn_mfma_f32_32x32x16_bf16(kf[0],qr[0],negm,0,0,0), P0[2],P0[3],P0[4],P0[5],     pw0[0]=PKW(P0,0), pw0[1]=PKW(P0,2), pw0); \
    VRD(4); SBAR(); GAPA(C1=__builtin_amdgcn_mfma_f32_32x32x16_bf16(kf[1],qr[0],negm,0,0,0), P0[6],P0[7],P0[8],P0[9],     pw0[2]=PKW(P0,4), pw0[3]=PKW(P0,6), pw0); \
    VRD(1); SBAR(); GAPA(C0=__builtin_amdgcn_mfma_f32_32x32x16_bf16(kf[2],qr[1],C0,0,0,0),   P0[10],P0[11],P0[12],P0[13], pw1[0]=PKW(P0,8), pw1[1]=PKW(P0,10), pw1); \
    VRD(5); SBAR(); GAPA(C1=__builtin_amdgcn_mfma_f32_32x32x16_bf16(kf[3],qr[1],C1,0,0,0),   P0[14],P0[15],P1[0],P1[1],   pw1[2]=PKW(P0,12),pw1[3]=PKW(P0,14), pw1); \
    VRD(2); SBAR(); GAPA(C0=__builtin_amdgcn_mfma_f32_32x32x16_bf16(kf[4],qr[2],C0,0,0,0),   P1[2],P1[3],P1[4],P1[5],     pw2[0]=PKW(P1,0), pw2[1]=PKW(P1,2), pw2); \
    VRD(6); SBAR(); GAPA(C1=__builtin_amdgcn_mfma_f32_32x32x16_bf16(kf[5],qr[2],C1,0,0,0),   P1[6],P1[7],P1[8],P1[9],     pw2[2]=PKW(P1,4), pw2[3]=PKW(P1,6), pw2); \
    VRD(3); SBAR(); GAPA(C0=__builtin_amdgcn_mfma_f32_32x32x16_bf16(kf[6],qr[3],C0,0,0,0),   P1[10],P1[11],P1[12],P1[13], pw3[0]=PKW(P1,8), pw3[1]=PKW(P1,10), pw3); \
    VRD(7); SBAR(); GAPA(C1=__builtin_amdgcn_mfma_f32_32x32x16_bf16(kf[7],qr[3],C1,0,0,0),   P1[14],P1[15],0.f,0.f,       pw3[2]=PKW(P1,12),pw3[3]=PKW(P1,14), pw3); \
    l_reg+=sacc; \
    if(GK){DMA_K((t)+3,sl_cur);} if(GV){DMA_V((t)+1,sl_next);} \
    TBADD(C0,C1,t); CMASK(C0,C1,t); \
    { float a=MX3(C0[0],C0[1],C1[0]),b=MX3(C0[2],C0[3],C1[1]); a=MX3(a,C1[2],C1[3]); \
      _Pragma("unroll") for(int r=4;r<16;r+=4){a=MX3(a,C0[r],C0[r+1]);b=MX3(b,C0[r+2],C0[r+3]);a=MX3(a,C1[r],C1[r+1]);b=MX3(b,C1[r+2],C1[r+3]);} \
      float rm=__builtin_fmaxf(a,b); { auto rr=__builtin_amdgcn_permlane32_swap(__float_as_uint(rm),__float_as_uint(rm),false,false); rm=__builtin_fmaxf(__uint_as_float(rr[0]),__uint_as_float(rr[1])); } \
      resc=false; \
      if(__builtin_expect(__any(rm>(float)THRL),0)){ const float dl=__builtin_fmaxf(rm,0.f); mhat+=dl; \
        _Pragma("unroll") for(int r=0;r<16;++r){C0[r]-=dl;C1[r]-=dl;} \
        _Pragma("unroll") for(int r=0;r<16;++r)negm[r]=-mhat; asm volatile("":"+v"(negm)); \
        const float f=__builtin_amdgcn_exp2f(-dl); l_reg*=f; if(hi==0)wsf[r32]=f; resc=true; } } \
    SBAR(); \
    GAPB(o[0]=__builtin_amdgcn_mfma_f32_32x32x16_bf16(PAF(0),VFR(0),o[0],0,0,0), C0,0); \
    GAPB(o[1]=__builtin_amdgcn_mfma_f32_32x32x16_bf16(PAF(0),VFR(4),o[1],0,0,0), C0,4); \
    KRD(GL,0); GAPB(o[0]=__builtin_amdgcn_mfma_f32_32x32x16_bf16(PAF(1),VFR(1),o[0],0,0,0), C0,8); \
    KRD(GL,1); GAPB(o[1]=__builtin_amdgcn_mfma_f32_32x32x16_bf16(PAF(1),VFR(5),o[1],0,0,0), C0,12); \
    KRD(GL,2); GAPB(o[0]=__builtin_amdgcn_mfma_f32_32x32x16_bf16(PAF(2),VFR(2),o[0],0,0,0), C1,0); \
    KRD(GL,3); GAPB(o[1]=__builtin_amdgcn_mfma_f32_32x32x16_bf16(PAF(2),VFR(6),o[1],0,0,0), C1,4); \
    GAPB(o[0]=__builtin_amdgcn_mfma_f32_32x32x16_bf16(PAF(3),VFR(3),o[0],0,0,0), C1,8); \
    GAPB(o[1]=__builtin_amdgcn_mfma_f32_32x32x16_bf16(PAF(3),VFR(7),o[1],0,0,0), C1,12); \
    }while(0)
  int t=1;
  #undef CMASK
  #define CMASK(P0,P1,t) do{}while(0)
  for(;t+5<NT;t+=2){
    STEP(pB0,pB1,pA0,pA1,t,true,true,true);     WAIT_BAR(2); RESC(); ROT();
    STEP(pA0,pA1,pB0,pB1,t+1,true,true,true);   WAIT_BAR(2); RESC(); ROT();
  }
  #undef CMASK
  #define CMASK(P0,P1,t) do{int jb_=(t)-(NT-4); if(jb_>=0)cmask(P0,P1,jb_,qrel,hi);}while(0)
  #define ENDW(tt) do{ if((tt)+3<NT){WAIT_BAR(2);} else if((tt)+2<NT){WAIT_BAR(1);} else {WAIT_BAR(0);} }while(0)
  for(;t+1<NT;t+=2){
    STEP(pB0,pB1,pA0,pA1,t,(t+3<NT),(t+1<NT),(t+1<NT));       ENDW(t);   RESC(); ROT();
    STEP(pA0,pA1,pB0,pB1,t+1,(t+4<NT),(t+2<NT),(t+2<NT));     ENDW(t+1); RESC(); ROT();
  }
  STEP(pB0,pB1,pA0,pA1,NT-1,false,false,false); RESC();
  { float sacc=pB0[0]+pB0[1]; _Pragma("unroll") for(int r=2;r<16;++r)sacc+=pB0[r]; _Pragma("unroll") for(int r=0;r<16;++r)sacc+=pB1[r]; l_reg+=sacc;
    pw0=(u32x4){PKW(pB0,0),PKW(pB0,2),PKW(pB0,4),PKW(pB0,6)};pw1=(u32x4){PKW(pB0,8),PKW(pB0,10),PKW(pB0,12),PKW(pB0,14)};pw2=(u32x4){PKW(pB1,0),PKW(pB1,2),PKW(pB1,4),PKW(pB1,6)};pw3=(u32x4){PKW(pB1,8),PKW(pB1,10),PKW(pB1,12),PKW(pB1,14)};
    SBAR(); pv(o,vb0+sl_cur,PAF(0),PAF(1),PAF(2),PAF(3)); }
  #undef PKW
  #undef PAF
  #undef VFR
  #undef PIN
  #undef MX3
  #undef GAPA
  #undef GAPB
  #undef EX
  #undef VRD
  #undef KRD
  #undef STEP
  #undef ENDW
  {auto rr=__builtin_amdgcn_permlane32_swap(__float_as_uint(l_reg),__float_as_uint(l_reg),false,false);l_reg=__uint_as_float(rr[0])+__uint_as_float(rr[1]);}
  if(hi==0)wsf[32+r32]=l_reg;asm volatile("s_waitcnt lgkmcnt(0)":::"memory");
  float rli[16];
  #pragma unroll
  for(int r=0;r<16;++r)rli[r]=__builtin_amdgcn_rcpf(wsf[32+crow(r,hi)]);
  bf16*Ow=O+(rowbase+q0+wid*QBLK)*OPITCH+h*D;
  { bf16*stg=(bf16*)(shm+LDS_OST)+wid*2048;
    #pragma unroll
    for(int r=0;r<16;++r){const int orow=crow(r,hi);
      #pragma unroll
      for(int d0=0;d0<2;++d0)stg[orow*64+d0*32+r32]=__float2bfloat16(o[d0][r]*rli[r]);}
    asm volatile("s_waitcnt lgkmcnt(0)":::"memory");
    int ln2_; asm volatile("v_mbcnt_lo_u32_b32 %0, -1, 0\n\tv_mbcnt_hi_u32_b32 %0, -1, %0":"=v"(ln2_));
    #pragma unroll
    for(int i=0;i<4;++i){const int row=i*8+(ln2_>>3),ch=ln2_&7; const u32x4 v=*(const u32x4*)(stg+row*64+ch*8); ATTN_STORE16(Ow+(long)row*OPITCH+ch*8,v);} }
  asm volatile("s_waitcnt lgkmcnt(0)\n\ts_barrier":::"memory");
  #undef TBADD
  #undef DMA_K
  #undef DMA_V
  #undef CMASK
  #undef START
  #undef RESC
  #undef ROT
}
constexpr int ATTN_LDS_BYTES=LDS_BYTES;
struct AttnTensors { const bf16* Q; const bf16* K; const bf16* V; bf16* O; };
struct AttnUnit { int bh; int qb; };
#undef SBAR
#undef WAIT_BAR
}
constexpr int NWAVES = 8;
constexpr int DM = 1024, MP = 16384, MS = 512, MT = MP + MS;
constexpr int SEQ = 4096, NB = 4, DB = 128, DT = 4;
constexpr int DIN = 5648, NIN = 5632, DFF = 2816, NGU = 5632, PLE = 256;
constexpr int HM_ = 4, DKM = 128, HF = 8, DHF = 64, WM = 512, WF = 512;
constexpr int PAST = 2048, PAGE = 128, NPAGES = 16;
constexpr float EPS = 1e-6f;
constexpr float LOG2E = 1.4426950408889634f;
constexpr float C2Q = 0.125f * LOG2E;
constexpr size_t O_YP = 0, O_YS = (size_t)MP * DM, O_KP = O_YS + (size_t)MS * DM, O_VP = O_KP + (size_t)MP * 512, O_LFP = O_VP + (size_t)MP * 512,
    O_CP = O_LFP + (size_t)MP * 8, O_NP = O_CP + (size_t)NB * HM_ * 128 * 128, O_MPR = O_NP + (size_t)NB * HM_ * 128, O_KS = O_MPR + NB * HM_,
    O_VS = O_KS + (size_t)MS * 512, O_LFS = O_VS + (size_t)MS * 512, O_CS = O_LFS + (size_t)MS * 8, O_NS = O_CS + (size_t)DB * HM_ * 128 * 128,
    O_MS = O_NS + (size_t)DB * HM_ * 128, O_END = O_MS + (size_t)DB * HM_;
static_assert(O_END == 43457040, "d_out size");
constexpr size_t MiB = 1u << 20;
constexpr size_t WS_CTL = 0, CTL_ZERO_BYTES = 1 * MiB;
constexpr size_t WS_WIN = 2 * MiB, WS_WGU = 13 * MiB, WS_WDN = 24 * MiB, WS_WOUT = 30 * MiB, WS_WPG = 32 * MiB, WS_WPA = 34 * MiB, WS_WPB = 35 * MiB, WS_WPP = 36 * MiB;
constexpr size_t WS_GATES = 38 * MiB, WS_SSQ2 = 40 * MiB, WS_SSQ3 = 42 * MiB, WS_MISC = 44 * MiB;
constexpr size_t WS_XN = 64 * MiB, WS_PB = 98 * MiB, WS_MQ = 108 * MiB, WS_MK = 125 * MiB, WS_MV = 142 * MiB, WS_MO = 159 * MiB, WS_FQ = 176 * MiB, WS_FK = 193 * MiB, WS_FV = 210 * MiB,
    WS_HM = 227 * MiB, WS_YF = 244 * MiB, WS_GA = 262 * MiB, WS_GB = 296 * MiB, WS_U = 330 * MiB, WS_X1 = 364 * MiB, WS_A2 = 431 * MiB, WS_HB = 465 * MiB, WS_A3 = 557 * MiB, WS_TP = 591 * MiB,
    WS_LT = 625 * MiB, WS_CT = 658 * MiB, WS_HY = 680 * MiB, WS_END = 714 * MiB;
constexpr size_t MI_CHS = 0;
constexpr size_t MI_MC = 8192;
constexpr size_t MI_NL = 16384;
constexpr size_t MI_NC = MI_NL + 512 * 128 * 4;
constexpr size_t MI_F2 = 12 * MiB;
constexpr size_t MI_DEC = 1 * MiB;
constexpr int CW_TMO = 0, CW_CODE = 1, CW_BAR = 4096;

constexpr int RING_OFF = 0, RING_BYTES = 131072;
constexpr int LDSCTL_OFF = RING_BYTES, MISC_OFF = LDSCTL_OFF + 320;
constexpr int LDS_BYTES = 147456;
#define GAS __attribute__((address_space(1)))
#define LAS __attribute__((address_space(3)))
typedef unsigned short bf16;
typedef unsigned v4u __attribute__((ext_vector_type(4)));
typedef float f32x4 __attribute__((ext_vector_type(4)));
typedef short bf16x8 __attribute__((ext_vector_type(8)));
typedef GAS unsigned gu32;
typedef GAS unsigned long long gu64;
#define RLX_AGENT __ATOMIC_RELAXED, __HIP_MEMORY_SCOPE_AGENT
#define LDS_WAIT() asm volatile("s_waitcnt lgkmcnt(0)" ::: "memory")
#define VM_WAIT() asm volatile("s_waitcnt vmcnt(0)" ::: "memory")
__device__ __forceinline__ unsigned long long rt() { return __builtin_amdgcn_s_memrealtime(); }
__device__ __forceinline__ unsigned f2bf(float f) { unsigned u = __builtin_bit_cast(unsigned, f); return (u + 0x7fffu + ((u >> 16) & 1u)) >> 16; }
__device__ __forceinline__ unsigned pk2(float lo, float hi) { return f2bf(lo) | (f2bf(hi) << 16); }

#define XB_TMO      128
#define XB_XCNT(j)  (256  + 64 * (j))
#define XB_XSUB(j)  (1280 + 64 * (j))
#define XB_XGEN(j)  (2304 + 64 * (j))
#define XB_TOP      3328
#define XB_TOPGEN   3392
#define XCD_BAR_WORDS 3456
#define XB_SPIN_CAP (1u << 18)

__device__ __forceinline__ unsigned xb_ld(unsigned* p)              { return __hip_atomic_load(p, __ATOMIC_RELAXED, __HIP_MEMORY_SCOPE_AGENT); }
__device__ __forceinline__ unsigned xb_add(unsigned* p, unsigned v) { return __hip_atomic_fetch_add(p, v, __ATOMIC_RELAXED, __HIP_MEMORY_SCOPE_AGENT); }
__device__ __forceinline__ unsigned xb_xcc_id() { return (unsigned)__builtin_amdgcn_s_getreg((3 << 11) | 20) & 0xFu; }
#define XB_SPIN(cond, bar) do { unsigned _sp = 0; while (cond) { __builtin_amdgcn_s_sleep(1); \
    if ((++_sp & 255u) == 0u) { if (xb_ld(&(bar)[XB_TMO])) break; if (_sp > XB_SPIN_CAP) { atomicAdd(&(bar)[XB_TMO], 1u); break; } } } } while (0)

struct XcdBarrier {
    unsigned* bar; unsigned x;
    volatile LAS unsigned* st;
};

__device__ __forceinline__ XcdBarrier xcd_barrier_post(unsigned* bar, volatile LAS unsigned* st) {
    XcdBarrier b; b.bar = bar; b.x = xb_xcc_id(); b.st = st;
    if (threadIdx.x == 0) (void)xb_add(&bar[XB_XCNT(b.x)], 1u);
    return b;
}
__device__ __forceinline__ void xcd_barrier_complete(unsigned* bar, unsigned x, unsigned& nloc, unsigned& nx) {
    const unsigned G = gridDim.x * gridDim.y * gridDim.z;
    unsigned sum, cnt, mine, sp = 0u;
    for (;;) {
        sum = 0u; cnt = 0u; mine = 0u;
#pragma unroll
        for (unsigned j = 0; j < 16; ++j) { const unsigned c = xb_ld(&bar[XB_XCNT(j)]); sum += c; cnt += (c > 0u) ? 1u : 0u; mine = (j == x) ? c : mine; }
        if (sum == G) break;
        __builtin_amdgcn_s_sleep(1);
        if ((++sp & 255u) == 0u) { if (xb_ld(&bar[XB_TMO])) break; if (sp > XB_SPIN_CAP) { atomicAdd(&bar[XB_TMO], 1u); break; } }
    }
    nloc = mine > 0u ? mine : 1u; nx = cnt > 0u ? cnt : 1u;
}

__device__ __forceinline__ void xcd_barrier(const XcdBarrier& b) {
    asm volatile("s_waitcnt vmcnt(0)" ::: "memory");
    __syncthreads();
    if (threadIdx.x == 0) {
        unsigned* bar = b.bar;
        __builtin_amdgcn_s_waitcnt(0);
        unsigned nloc = b.st[0], nx = b.st[1];
        if (nloc == 0u) { xcd_barrier_complete(bar, b.x, nloc, nx); b.st[0] = nloc; b.st[1] = nx; }
        const unsigned old = xb_add(&bar[XB_XSUB(b.x)], 1u);
        const unsigned gen = old / nloc;
        if (old + 1u == (gen + 1u) * nloc) {
            __builtin_amdgcn_fence(__ATOMIC_RELEASE, "agent");
            asm volatile("s_waitcnt vmcnt(0)" ::: "memory");
            const unsigned og = xb_add(&bar[XB_TOP], 1u);
            const unsigned tg = og / nx;
            if (og + 1u == (tg + 1u) * nx) xb_add(&bar[XB_TOPGEN], 1u);
            else XB_SPIN(xb_ld(&bar[XB_TOPGEN]) == tg, bar);
            __builtin_amdgcn_fence(__ATOMIC_ACQUIRE, "agent");
            xb_add(&bar[XB_XGEN(b.x)], 1u);
            asm volatile("s_waitcnt vmcnt(0)" ::: "memory");
        } else {
            XB_SPIN(xb_ld(&bar[XB_XGEN(b.x)]) == gen, bar);
            __builtin_amdgcn_fence(__ATOMIC_ACQUIRE, "agent");
            asm volatile("s_waitcnt vmcnt(0)" ::: "memory");
        }
    }
    __syncthreads();
}
struct Frame {
    LAS unsigned char* lds;
    volatile LAS unsigned* MISC;
    gu32* ctl;
    int vcu, G;
    float* out; unsigned char* ws;
};
struct Args { const void* in[28]; float* out; unsigned char* ws; int ph_lo, ph_hi; };
#define IN_F(k) ((const float*)A.in[k])
#define I_XP IN_F(0)
#define I_XS IN_F(1)
#define I_PP IN_F(2)
#define I_PS IN_F(3)
#define I_CK IN_F(4)
#define I_CV IN_F(5)
#define I_CLF IN_F(6)
#define I_SC IN_F(7)
#define I_SN IN_F(8)
#define I_SM IN_F(9)
#define I_PT ((const int*)A.in[10])
#define I_GMIX IN_F(11)
#define I_WIN IN_F(12)
#define I_BMI IN_F(13)
#define I_BMF IN_F(14)
#define I_BFF IN_F(15)
#define I_GMH IN_F(16)
#define I_GQN IN_F(17)
#define I_GKN IN_F(18)
#define I_WPA IN_F(19)
#define I_WPB IN_F(20)
#define I_WOUT IN_F(21)
#define I_GFFN IN_F(22)
#define I_WGU IN_F(23)
#define I_WDN IN_F(24)
#define I_GPLE IN_F(25)
#define I_WPG IN_F(26)
#define I_WPP IN_F(27)
__device__ __forceinline__ float wave_sum(float v) {
#pragma unroll
    for (int o = 1; o < 64; o <<= 1) v += __shfl_xor(v, o);
    return v;
}
__device__ __forceinline__ float dot4f(f32x4 a) { return (a[0] * a[0] + a[1] * a[1]) + (a[2] * a[2] + a[3] * a[3]); }
__device__ __forceinline__ float logsig(float x) { return fminf(x, 0.f) - log1pf(expf(-fabsf(x))); }
__device__ __forceinline__ void p0_transpose_load(float (&wv_)[32], const float* W, int ldw, int src_col0, int k0, int lane) {
#pragma unroll
    for (int i = 0; i < 32; ++i) { const int kk = 2 * i + (lane >> 5); wv_[i] = W[(size_t)(k0 + kk) * ldw + src_col0 + (lane & 31)]; }
}
__device__ __forceinline__ void p0_transpose_finish(const float (&wv_)[32], int K, bf16* WT, int dst_row0, int k0, LAS float* scr, int lane, const float* kscale = nullptr, int dko = 0) {
#pragma unroll
    for (int i = 0; i < 32; ++i) { const int kk = 2 * i + (lane >> 5); float w = wv_[i]; if (kscale) w *= kscale[k0 + kk]; scr[kk * 33 + (lane & 31)] = w; }
    LDS_WAIT(); asm volatile("" ::: "memory");
    const int c = lane & 7;
#pragma unroll
    for (int j = 0; j < 4; ++j) { const int n = (lane >> 3) + 8 * j; const LAS float* s = scr + (8 * c) * 33 + n;
        v4u o; o.x = pk2(s[0 * 33], s[1 * 33]); o.y = pk2(s[2 * 33], s[3 * 33]); o.z = pk2(s[4 * 33], s[5 * 33]); o.w = pk2(s[6 * 33], s[7 * 33]);
        *(GAS v4u*)(WT + (size_t)(dst_row0 + n) * K + dko + k0 + 8 * c) = o; }
    LDS_WAIT(); asm volatile("" ::: "memory");
}
__device__ __forceinline__ void p0_transpose_item(const float* W, int ldw, int K, bf16* WT, int src_col0, int dst_row0, int k0, LAS float* scr, int lane, const float* kscale = nullptr, int dko = 0) {
    float wv_[32];
    p0_transpose_load(wv_, W, ldw, src_col0, k0, lane);
    p0_transpose_finish(wv_, K, WT, dst_row0, k0, scr, lane, kscale, dko);
}
__device__ __forceinline__ int hperm(int f) { return 256 * (f >> 8) + 128 * ((f & 63) >> 5) + 32 * ((f & 255) >> 6) + (f & 31); }
__device__ __forceinline__ void p0_win_item(int r, int& src, int& dst, int& k0) {
    const int blk = r >> 4, kb = r & 15; k0 = 64 * kb;
    if (blk < 64) { src = 32 * blk; dst = 32 * blk; }
    else if (blk < 80) { const int f = 32 * (blk - 64); src = 2056 + f; dst = 2048 + hperm(f); }
    else if (blk < 96) { const int f = 32 * (blk - 80); src = 2568 + f; dst = 2560 + hperm(f); }
    else if (blk < 112) { const int f = 32 * (blk - 96); src = 3080 + f; dst = 3072 + f; }
    else { const int f = 32 * (blk - 112); src = 3600 + f; dst = 3584 + f; }
}
__device__ __forceinline__ const float* xrow_ptr(const Args& A, int r) { return r < MP ? I_XP + (size_t)r * DM : I_XS + (size_t)(r - MP) * DM; }

constexpr int NI_IN = 176 * 16, NI_GU = 176 * 16, NI_DN = 32 * 44, NI_OUT = 32 * 16, NI_PG = 32 * 16, NI_PA = 32 * 8, NI_PB = 32 * 8, NI_PP = 32 * 4;
constexpr int NLATE = NI_GU + NI_DN + NI_OUT + NI_PG + NI_PA + NI_PB + NI_PP;
__device__ __forceinline__ void p0_late_item(const Args& A, unsigned char* ws, int r, LAS float* scr, int lane) {
    bf16* WGU = (bf16*)(ws + WS_WGU); bf16* WDN = (bf16*)(ws + WS_WDN); bf16* WOUT = (bf16*)(ws + WS_WOUT); bf16* WPG = (bf16*)(ws + WS_WPG); bf16* WPA = (bf16*)(ws + WS_WPA); bf16* WPB = (bf16*)(ws + WS_WPB); bf16* WPP = (bf16*)(ws + WS_WPP);
    do {
        if (r < NI_GU) { const int db = r >> 4, kb = r & 15; const int pn = db >> 3, q = db & 7, bj = q >> 2, wc = q & 3;
            p0_transpose_item(I_WGU, NGU, DM, WGU, bj * DFF + 128 * pn + 32 * wc, 32 * db, 64 * kb, scr, lane, I_GFFN); break; } r -= NI_GU;
        if (r < NI_DN) { const int blk = r / 44, kb = r % 44; p0_transpose_item(I_WDN, DM, DFF, WDN, 32 * blk, 32 * blk, 64 * kb, scr, lane); break; } r -= NI_DN;
        if (r < NI_OUT) { p0_transpose_item(I_WOUT, DM, DM, WOUT, 32 * (r >> 4), 32 * (r >> 4), 64 * (r & 15), scr, lane); break; } r -= NI_OUT;
        if (r < NI_PG) { p0_transpose_item(I_WPG, DM, DM, WPG, 32 * (r >> 4), 32 * (r >> 4), 64 * (r & 15), scr, lane, I_GPLE); break; } r -= NI_PG;
        if (r < NI_PA) { p0_transpose_item(I_WPA, DM, DM, WPA, 32 * (r >> 3), 32 * (r >> 3), 64 * (r & 7), scr, lane, nullptr, 0); break; } r -= NI_PA;
        if (r < NI_PB) { p0_transpose_item(I_WPB, DM, DM, WPA, 32 * (r >> 3), 32 * (r >> 3), 64 * (r & 7), scr, lane, nullptr, 512); break; } r -= NI_PB;
        p0_transpose_item(I_WPP, DM, PLE, WPP, 32 * (r >> 2), 32 * (r >> 2), 64 * (r & 3), scr, lane);
    } while (0);
}
template <int NR, bool PRE> __device__ __forceinline__ void p0_rows_trip(Frame& F, const Args& A, const int r0, const int lane, const LAS float* wl, bf16* XN, float* GT, const f32x4 (&xp)[4]) {
    const GAS f32x4* xr[NR];
#pragma unroll
    for (int q = 0; q < NR; ++q) xr[q] = (const GAS f32x4*)xrow_ptr(A, r0 + q) + lane;
    f32x4 xv[NR][4]; float ss[NR];
#pragma unroll
    for (int q = 0; q < NR; ++q) ss[q] = 0.f;
#pragma unroll
    for (int j = 0; j < 4; ++j)
#pragma unroll
        for (int q = 0; q < NR; ++q) { if constexpr (PRE) xv[q][j] = xp[j]; else xv[q][j] = xr[q][64 * j]; ss[q] += dot4f(xv[q][j]); }
    float rr[NR];
#pragma unroll
    for (int q = 0; q < NR; ++q) rr[q] = rsqrtf(wave_sum(ss[q]) * (1.f / DM) + EPS);
    float v[16 * NR];
#pragma unroll
    for (int c = 0; c < 16 * NR; ++c) v[c] = 0.f;
#pragma unroll
    for (int j = 0; j < 4; ++j) { const f32x4 gmj = ((const GAS f32x4*)I_GMIX)[64 * j + lane]; f32x4 vx[NR];
#pragma unroll
        for (int q = 0; q < NR; ++q) { vx[q] = xv[q][j] * rr[q] * gmj;
            ((GAS unsigned long long*)(XN + (size_t)(r0 + q) * DM) + lane)[64 * j] = (unsigned long long)pk2(vx[q].x, vx[q].y) | ((unsigned long long)pk2(vx[q].z, vx[q].w) << 32); }
#pragma unroll
        for (int e = 0; e < 4; ++e) { const LAS f32x4* wp = (const LAS f32x4*)(wl + 4352 * j + 16 * e);
#pragma unroll
            for (int qq = 0; qq < 4; ++qq) { const f32x4 w = wp[qq];
#pragma unroll
                for (int q = 0; q < NR; ++q) { const float xs = vx[q][e];
#pragma unroll
                    for (int t = 0; t < 4; ++t) v[16 * q + 4 * qq + t] += xs * w[t]; } }
            asm volatile("" ::: "memory"); } }
    if constexpr (NR == 4) {
#pragma unroll
        for (int i = 0; i < 32; ++i) { const bool up = (lane & 32) != 0; const float keep = up ? v[32 + i] : v[i], send = up ? v[i] : v[32 + i]; v[i] = keep + __shfl_xor(send, 32); }
#pragma unroll
        for (int i = 0; i < 16; ++i) { const bool up = (lane & 16) != 0; const float keep = up ? v[16 + i] : v[i], send = up ? v[i] : v[16 + i]; v[i] = keep + __shfl_xor(send, 16); }
    } else {
#pragma unroll
        for (int i = 0; i < 16; ++i) { v[i] += __shfl_xor(v[i], 32); v[i] += __shfl_xor(v[i], 16); }
    }
#pragma unroll
    for (int i = 0; i < 8; ++i) { const bool up = (lane & 8) != 0; const float keep = up ? v[8 + i] : v[i], send = up ? v[i] : v[8 + i]; v[i] = keep + __shfl_xor(send, 8); }
#pragma unroll
    for (int i = 0; i < 4; ++i) { const bool up = (lane & 4) != 0; const float keep = up ? v[4 + i] : v[i], send = up ? v[i] : v[4 + i]; v[i] = keep + __shfl_xor(send, 4); }
#pragma unroll
    for (int i = 0; i < 2; ++i) { const bool up = (lane & 2) != 0; const float keep = up ? v[2 + i] : v[i], send = up ? v[i] : v[2 + i]; v[i] = keep + __shfl_xor(send, 2); }
    { const bool up = (lane & 1) != 0; const float keep = up ? v[1] : v[0], send = up ? v[0] : v[1]; v[0] = keep + __shfl_xor(send, 1); }
    if (NR == 4 || lane < 16) { const int row = r0 + (NR == 4 ? (lane >> 4) : 0), c = lane & 15; float z = v[0], val;
        if (c < 4) val = z + I_BMI[c]; else if (c < 8) val = logsig(z + I_BMF[c - 4]); else { val = logsig(z + I_BFF[c - 8]);
            if (row < MP) F.out[O_LFP + (size_t)row * 8 + (c - 8)] = val; else F.out[O_LFS + (size_t)(row - MP) * 8 + (c - 8)] = val; }
        GT[(size_t)row * 16 + c] = val; }
}
__device__ __forceinline__ void p0_prologue(Frame& F, const Args& A, const int parts = 7) {
    int tid_ = threadIdx.x; asm volatile("" : "+v"(tid_)); const int tid = tid_, lane = tid & 63, wave = __builtin_amdgcn_readfirstlane(tid >> 6);
    LAS float* scr = (LAS float*)(F.lds + RING_OFF + wave * 16384);
    const int gw = F.vcu * NWAVES + wave, NGW = F.G * NWAVES;
    bf16* WIN = (bf16*)(F.ws + WS_WIN);
    if (parts & 1) {
        for (int it = gw; it < NI_IN; it += 2 * NGW) {
            const int it2 = it + NGW; const bool two = it2 < NI_IN; int s0, d0, k0, s1, d1, k1; p0_win_item(it, s0, d0, k0); p0_win_item(two ? it2 : it, s1, d1, k1);
            float wa[32], wb[32];
            p0_transpose_load(wa, I_WIN, DIN, s0, k0, lane); if (two) p0_transpose_load(wb, I_WIN, DIN, s1, k1, lane);
            p0_transpose_finish(wa, DM, WIN, d0, k0, scr, lane); if (two) p0_transpose_finish(wb, DM, WIN, d1, k1, scr, lane);
        }
    }
    f32x4 gw0[4], gw1[4];
    if (parts & 4) {
#pragma unroll
      for (int u = 0; u < 4; ++u) { const int i = tid + u * (NWAVES * 64), k = i >> 1, g = i & 1; const GAS f32x4* sp = (const GAS f32x4*)(I_WIN + (size_t)k * DIN + (g ? 3592 : 2048)); gw0[u] = sp[0]; gw1[u] = sp[1]; } }
    if (parts & 2) { bf16* PB = (bf16*)(F.ws + WS_PB); const int gt = F.vcu * (NWAVES * 64) + tid, NGT = F.G * NWAVES * 64;
      constexpr int NPB = MT * PLE / 4;
      for (int i0 = gt; i0 < NPB; i0 += 9 * NGT) { f32x4 v[9];
#pragma unroll
          for (int u = 0; u < 9; ++u) { const int i = i0 + u * NGT; const int e = (i < NPB ? i : gt) * 4; const float* src = e < MP * PLE ? I_PP + e : I_PS + (e - MP * PLE); v[u] = *(const GAS f32x4*)src; }
#pragma unroll
          for (int u = 0; u < 9; ++u) { const int i = i0 + u * NGT; if (i < NPB) *(GAS unsigned long long*)(PB + (size_t)i * 4) = (unsigned long long)pk2(v[u].x, v[u].y) | ((unsigned long long)pk2(v[u].z, v[u].w) << 32); } } }
    if (!(parts & 4)) return;
    __syncthreads();
    LAS float* wg = (LAS float*)(F.lds + RING_OFF);
    {
#pragma unroll
      for (int u = 0; u < 4; ++u) { const int i = tid + u * (NWAVES * 64), k = i >> 1, g = i & 1; LAS f32x4* dp = (LAS f32x4*)(wg + 16 * k + 4 * ((k >> 2) & 15) + 64 * (k >> 6) + 8 * g); dp[0] = gw0[u]; dp[1] = gw1[u]; } }
    __syncthreads();
    {
        bf16* XN = (bf16*)(F.ws + WS_XN); float* GT = (float*)(F.ws + WS_GATES);
        const LAS float* wl = wg + 64 * lane + 64 * (lane >> 4) + 4 * (lane & 15);
        const bool has1 = wave < 2 && 2 * F.vcu + wave < MS; const int r1 = MP + 2 * F.vcu + wave; f32x4 x1[4];
#pragma unroll
        for (int j = 0; j < 4; ++j) x1[j] = ((const GAS f32x4*)xrow_ptr(A, has1 ? r1 : MP) + lane)[64 * j];
        for (int pr = gw; pr < MP / 4; pr += NGW) p0_rows_trip<4, false>(F, A, 4 * pr, lane, wl, XN, GT, x1);
        if (has1) p0_rows_trip<1, true>(F, A, r1, lane, wl, XN, GT, x1);
        if (F.G * 2 < MS) for (int r = F.G * 2 + gw; r < MS; r += NGW) p0_rows_trip<1, false>(F, A, MP + r, lane, wl, XN, GT, x1);
    }
}
#define PHASE_IDS_ int tid_ = threadIdx.x; asm volatile("" : "+v"(tid_)); const int tid = tid_, lane = tid & 63, wave = __builtin_amdgcn_readfirstlane(tid >> 6)
#define OPAQUE_WS_ size_t wsoo_ = 0; asm volatile("" : "+s"(wsoo_)); unsigned char* ws = ws_ + wsoo_
typedef short s16x4v __attribute__((ext_vector_type(4)));
typedef short v4i16_t __attribute__((ext_vector_type(4)));
__device__ __forceinline__ s16x4v tr4(const LAS unsigned char* p) { return __builtin_bit_cast(s16x4v, __builtin_amdgcn_ds_read_tr16_b64_v4i16((LAS v4i16_t*)p)); }
__device__ __forceinline__ bf16x8 join8(s16x4v lo, s16x4v hi) { return (bf16x8){lo[0], lo[1], lo[2], lo[3], hi[0], hi[1], hi[2], hi[3]}; }
#define MFMA16(X, Y, C) __builtin_amdgcn_mfma_f32_16x16x32_bf16(X, Y, C, 0, 0, 0)
__device__ __forceinline__ float bflo(unsigned u) { return __uint_as_float(u << 16); }
__device__ __forceinline__ float bfhi(unsigned u) { return __uint_as_float(u & 0xffff0000u); }
__device__ __forceinline__ float bf2f(bf16 v) { return __uint_as_float(((unsigned)v) << 16); }
__device__ __forceinline__ void st4bf(bf16* p, f32x4 v) { *(GAS unsigned long long*)p = (unsigned long long)pk2(v.x, v.y) | ((unsigned long long)pk2(v.z, v.w) << 32); }
__device__ __forceinline__ f32x4 ld4bf(const bf16* p) { const unsigned long long w = *(const GAS unsigned long long*)p; return (f32x4){bflo((unsigned)w), bfhi((unsigned)w), bflo((unsigned)(w >> 32)), bfhi((unsigned)(w >> 32))}; }
constexpr int TP_ = 272;

__device__ __forceinline__ void chunk_scan(const float* GT  , int h, int tid, int lane, int wave, LAS float* sc, float& bj, float& gj, float& gpre, float& G, float& bend) {
    float lf = 0.f, ig = 0.f;
    if (tid < 128) { lf = GT[(size_t)tid * 16 + 4 + h]; ig = GT[(size_t)tid * 16 + h]; }
    float s = lf;
#pragma unroll
    for (int o = 1; o < 64; o <<= 1) { const float t = __shfl_up(s, o); if (lane >= o) s += t; }
    if (tid < 128 && lane == 63) sc[wave] = s;
    __syncthreads();
    if (wave == 1) s += sc[0];
    bj = s; gj = ig - bj;
    float pm = gj;
#pragma unroll
    for (int o = 1; o < 64; o <<= 1) { const float t = __shfl_up(pm, o); if (lane >= o) pm = fmaxf(pm, t); }
    if (tid < 128 && lane == 63) sc[2 + wave] = pm;
    if (tid == 127) sc[4] = s;
    __syncthreads();
    if (wave == 1) pm = fmaxf(pm, sc[2]);
    gpre = pm; G = fmaxf(sc[2], sc[3]); bend = sc[4];
}
struct KVRegs { v4u k[4], v[4]; };
__device__ __forceinline__ void load_kv(KVRegs& R, const bf16* MKp, const bf16* MVp, int tid) {
#pragma unroll
    for (int i = 0; i < 4; ++i) { const int s = (tid >> 4) + 32 * i, c16 = tid & 15; R.k[i] = *(const GAS v4u*)(MKp + (size_t)s * 512 + 8 * c16); R.v[i] = *(const GAS v4u*)(MVp + (size_t)s * 512 + 8 * c16); }
}
__device__ __forceinline__ void store_kv(const KVRegs& R, LAS unsigned char* KT, LAS unsigned char* VT, const LAS float* wkl, int tid) {
#pragma unroll
    for (int i = 0; i < 4; ++i) { const int s = (tid >> 4) + 32 * i, c16 = tid & 15; const v4u kv = R.k[i]; const float w = wkl[s];
        v4u o; o.x = pk2(bflo(kv.x) * w, bfhi(kv.x) * w); o.y = pk2(bflo(kv.y) * w, bfhi(kv.y) * w); o.z = pk2(bflo(kv.z) * w, bfhi(kv.z) * w); o.w = pk2(bflo(kv.w) * w, bfhi(kv.w) * w);
        *(LAS v4u*)(KT + s * TP_ + c16 * 16) = o; *(LAS v4u*)(VT + s * TP_ + c16 * 16) = R.v[i]; }
}
__device__ __forceinline__ void mlstm_a_unit(unsigned char* ws_, LAS unsigned char* lds, int u) {
    PHASE_IDS_; OPAQUE_WS_;
    const int bh = u >> 5, c = u & 31, b = bh >> 2, h = bh & 3; const int r0 = b * SEQ + c * 128;
    LAS unsigned char* KT = lds; LAS unsigned char* VT = lds + 128 * TP_; LAS float* wkl = (LAS float*)(lds + 2 * 128 * TP_); LAS float* sc = wkl + 128;
    KVRegs R; load_kv(R, (const bf16*)(ws + WS_MK) + (size_t)r0 * 512 + h * 128, (const bf16*)(ws + WS_MV) + (size_t)r0 * 512 + h * 128, tid);
    float bj, gj, gpre, G, bend; chunk_scan((const float*)(ws + WS_GATES) + (size_t)r0 * 16, h, tid, lane, wave, sc, bj, gj, gpre, G, bend);
    if (tid < 128) wkl[tid] = expf(gj - G);
    if (tid == 0) { float* chs = (float*)(ws + WS_MISC + MI_CHS) + u * 2; chs[0] = G; chs[1] = bend; }
    __syncthreads();
    store_kv(R, KT, VT, wkl, tid);
    __syncthreads();
    const int fr = lane & 15, fq = lane >> 4, q4 = (lane & 15) >> 2, p4 = lane & 3;
    f32x4 acc[8], accn = (f32x4){0.f, 0.f, 0.f, 0.f};
#pragma unroll
    for (int i = 0; i < 8; ++i) acc[i] = (f32x4){0.f, 0.f, 0.f, 0.f};
    const short one = fr == 0 ? (short)0x3F80 : (short)0; const bf16x8 ones = (bf16x8){one, one, one, one, one, one, one, one};
#pragma unroll
    for (int ks = 0; ks < 4; ++ks) { const int row = 32 * ks + 8 * fq + q4;
        const bf16x8 Y = join8(tr4(VT + row * TP_ + (16 * wave + 4 * p4) * 2), tr4(VT + (row + 4) * TP_ + (16 * wave + 4 * p4) * 2));
#pragma unroll
        for (int di = 0; di < 8; ++di) { const bf16x8 X = join8(tr4(KT + row * TP_ + (16 * di + 4 * p4) * 2), tr4(KT + (row + 4) * TP_ + (16 * di + 4 * p4) * 2));
            acc[di] = MFMA16(X, Y, acc[di]); if (di == wave) accn = MFMA16(X, ones, accn); } }
    float* LT = (float*)(ws + WS_LT) + (size_t)u * 16384;
#pragma unroll
    for (int di = 0; di < 8; ++di) *(GAS f32x4*)(LT + (16 * wave + fr) * 128 + 16 * di + 4 * fq) = acc[di];
    if (fr == 0) *(GAS f32x4*)((float*)(ws + WS_MISC + MI_NL) + (size_t)u * 128 + 16 * wave + 4 * fq) = accn;
    __syncthreads();
}
__device__ __forceinline__ void mlstm_b(unsigned char* ws, float* out, LAS unsigned char* lds, int vcu, int Gn, int tid) {
    const float* LTb = (const float*)(ws + WS_LT); bf16* CTb = (bf16*)(ws + WS_CT); const float* NL = (const float*)(ws + WS_MISC + MI_NL); float* NC = (float*)(ws + WS_MISC + MI_NC);
    for (int it = vcu; it < 256; it += Gn) { const int bh = it >> 4, part = it & 15;
        LAS float* decl = (LAS float*)lds; LAS float* fl = decl + 32; LAS float* chl = decl + 64; LAS float* mcl = decl + 128;
        if (tid < 64) chl[tid] = ((const float*)(ws + WS_MISC + MI_CHS) + (size_t)bh * 64)[tid];
        __syncthreads();
        if (tid == 0) { float m = 0.f;
            for (int c = 0; c < 32; ++c) { const float Gc = chl[2 * c], be = chl[2 * c + 1], Mx = fmaxf(m, Gc); decl[c] = expf(m - Mx); fl[c] = expf(Gc - Mx); mcl[c] = m; m = be + Mx; }
            mcl[32] = m; }
        __syncthreads();
        if (part == 0 && tid < 33) { ((float*)(ws + WS_MISC + MI_MC) + bh * 33)[tid] = mcl[tid]; if (tid == 32) out[O_MPR + bh] = mcl[32]; }
#pragma unroll
        for (int e2 = 0; e2 < 2; ++e2) { const int idx = part * 1024 + e2 * 512 + tid; float Cs = 0.f; const float* lt = LTb + (size_t)bh * 32 * 16384 + idx; bf16* ct = CTb + (size_t)bh * 32 * 16384 + idx;
            float ltv[32];
#pragma unroll
            for (int c = 0; c < 32; ++c) ltv[c] = lt[(size_t)c * 16384];
#pragma unroll
            for (int c = 0; c < 32; ++c) { ct[(size_t)c * 16384] = (bf16)f2bf(Cs); Cs = decl[c] * Cs + fl[c] * ltv[c]; }
            const int e = idx >> 7, d = idx & 127; out[O_CP + (size_t)bh * 16384 + d * 128 + e] = Cs; }
        if (part == 0 && tid < 128) { float ns = 0.f; float nlv[32];
#pragma unroll
            for (int c = 0; c < 32; ++c) nlv[c] = NL[(size_t)(bh * 32 + c) * 128 + tid];
#pragma unroll
            for (int c = 0; c < 32; ++c) { NC[(size_t)(bh * 32 + c) * 128 + tid] = ns; ns = decl[c] * ns + fl[c] * nlv[c]; }
            out[O_NP + bh * 128 + tid] = ns; }
        __syncthreads();
    }
}
__device__ __forceinline__ void mlstm_c_unit(const Args& A, unsigned char* ws, LAS unsigned char* lds, int u, int tid, int lane, int wave) {
    const int bh = u >> 5, c = u & 31, b = bh >> 2, h = bh & 3; const int r0 = b * SEQ + c * 128;
    LAS unsigned char* KT = lds; LAS unsigned char* VT = lds + 128 * TP_; LAS unsigned char* CTt = lds + 2 * 128 * TP_;
    LAS float* wkl = (LAS float*)(lds + (2 * 128 + 144) * TP_); LAS float* rjl = wkl + 128; LAS float* wil = rjl + 128; LAS float* eml = wil + 128; LAS float* sc = eml + 128;
    KVRegs R; load_kv(R, (const bf16*)(ws + WS_MK) + (size_t)r0 * 512 + h * 128, (const bf16*)(ws + WS_MV) + (size_t)r0 * 512 + h * 128, tid);
    v4u ctr[4]; { const bf16* CTg = (const bf16*)(ws + WS_CT) + (size_t)u * 16384;
#pragma unroll
      for (int i = 0; i < 4; ++i) ctr[i] = *(const GAS v4u*)(CTg + (size_t)((tid >> 4) + 32 * i) * 128 + 8 * (tid & 15)); }
    const float mc = ((const float*)(ws + WS_MISC + MI_MC))[bh * 33 + c];
    f32x4 nca = (f32x4){0.f, 0.f, 0.f, 0.f}, ncb = nca; { const float* NCg = (const float*)(ws + WS_MISC + MI_NC) + (size_t)u * 128; if (tid < 16) { nca = *(const GAS f32x4*)(NCg + 8 * tid); ncb = *(const GAS f32x4*)(NCg + 8 * tid + 4); } }
    float bj, gj, gpre, G, bend; chunk_scan((const float*)(ws + WS_GATES) + (size_t)r0 * 16, h, tid, lane, wave, sc, bj, gj, gpre, G, bend);
    if (tid < 128) { const float Mj = fmaxf(mc, gpre); wkl[tid] = expf(gj - G); rjl[tid] = expf(G - Mj); wil[tid] = expf(mc - Mj); eml[tid] = expf(-(bj + Mj)); }
    __syncthreads();
    store_kv(R, KT, VT, wkl, tid);
    {
#pragma unroll
      for (int i = 0; i < 4; ++i) { const int e = (tid >> 4) + 32 * i, c16 = tid & 15; *(LAS v4u*)(CTt + e * TP_ + c16 * 16) = ctr[i]; }
      if (tid < 256) { const int rr = tid >> 4, c16 = tid & 15; v4u o = (v4u){0u, 0u, 0u, 0u};
          if (rr == 0) { o.x = pk2(nca.x, nca.y); o.y = pk2(nca.z, nca.w); o.z = pk2(ncb.x, ncb.y); o.w = pk2(ncb.z, ncb.w); }
          *(LAS v4u*)(CTt + (128 + rr) * TP_ + c16 * 16) = o; } }
    const int fr = lane & 15, fq = lane >> 4, q4 = (lane & 15) >> 2, p4 = lane & 3; const int j = 16 * wave + fr;
    bf16x8 qf[4];
    { const bf16* Qg = (const bf16*)(ws + WS_MQ) + (size_t)(r0 + j) * 512 + h * 128 + 8 * fq;
#pragma unroll
      for (int kd = 0; kd < 4; ++kd) qf[kd] = *(const GAS bf16x8*)(Qg + 32 * kd); }
    const float* gmh = I_GMH + h * 128 + 4 * fq; const bf16* MOg = (const bf16*)(ws + WS_MO) + (size_t)(r0 + j) * 512 + h * 128 + 4 * fq;
    f32x4 gmv[8]; unsigned long long mov[8];
#pragma unroll
    for (int eb = 0; eb < 8; ++eb) { gmv[eb] = *(const GAS f32x4*)(gmh + 16 * eb); mov[eb] = *(const GAS unsigned long long*)(MOg + 16 * eb); }
    __syncthreads();
    f32x4 O[9];
#pragma unroll
    for (int eb = 0; eb < 9; ++eb) { O[eb] = (f32x4){0.f, 0.f, 0.f, 0.f};
#pragma unroll
        for (int kd = 0; kd < 4; ++kd) { const bf16x8 X = *(const LAS bf16x8*)(CTt + (16 * eb + fr) * TP_ + (32 * kd + 8 * fq) * 2); O[eb] = MFMA16(X, qf[kd], O[eb]); } }
    { const float wi = wil[j];
#pragma unroll
      for (int eb = 0; eb < 9; ++eb) O[eb] *= wi; }
    f32x4 S[8]; const float rj = rjl[j];
#pragma unroll
    for (int sb = 0; sb < 8; ++sb) { S[sb] = (f32x4){0.f, 0.f, 0.f, 0.f};
        if (sb <= wave) {
#pragma unroll
            for (int kd = 0; kd < 4; ++kd) { const bf16x8 X = *(const LAS bf16x8*)(KT + (16 * sb + fr) * TP_ + (32 * kd + 8 * fq) * 2); S[sb] = MFMA16(X, qf[kd], S[sb]); }
#pragma unroll
            for (int v = 0; v < 4; ++v) S[sb][v] = (16 * sb + 4 * fq + v <= j) ? S[sb][v] * rj : 0.f; } }
    const short one = fr == 0 ? (short)0x3F80 : (short)0; const bf16x8 ones = (bf16x8){one, one, one, one, one, one, one, one};
#pragma unroll
    for (int kp = 0; kp < 4; ++kp) if (2 * kp <= wave) {
        v4u pw; pw.x = pk2(S[2 * kp][0], S[2 * kp][1]); pw.y = pk2(S[2 * kp][2], S[2 * kp][3]); pw.z = pk2(S[2 * kp + 1][0], S[2 * kp + 1][1]); pw.w = pk2(S[2 * kp + 1][2], S[2 * kp + 1][3]);
        const bf16x8 Y = __builtin_bit_cast(bf16x8, pw); const int row = 32 * kp + 4 * fq + q4;
#pragma unroll
        for (int eb = 0; eb < 8; ++eb) { const bf16x8 X = join8(tr4(VT + row * TP_ + (16 * eb + 4 * p4) * 2), tr4(VT + (row + 16) * TP_ + (16 * eb + 4 * p4) * 2)); O[eb] = MFMA16(X, Y, O[eb]); }
        O[8] = MFMA16(ones, Y, O[8]); }
    const float den = __shfl(O[8][0], fr); const float hd = 1.0f / fmaxf(fabsf(den), eml[j]);
    float ssq = 0.f;
#pragma unroll
    for (int eb = 0; eb < 8; ++eb) { O[eb] *= hd; ssq += dot4f(O[eb]); }
    ssq += __shfl_xor(ssq, 16); ssq += __shfl_xor(ssq, 32);
    const float rstd = rsqrtf(ssq * (1.0f / 128.0f) + EPS);
    bf16* HMg = (bf16*)(ws + WS_HY) + (size_t)(r0 + j) * 1024 + h * 128 + 4 * fq;
#pragma unroll
    for (int eb = 0; eb < 8; ++eb) { const f32x4 g = gmv[eb]; const unsigned long long mo = mov[eb]; const unsigned m0 = (unsigned)mo, m1 = (unsigned)(mo >> 32);
        const f32x4 o = O[eb] * rstd * g; *(GAS unsigned long long*)(HMg + 16 * eb) = (unsigned long long)pk2(o.x * bflo(m0), o.y * bfhi(m0)) | ((unsigned long long)pk2(o.z * bflo(m1), o.w * bfhi(m1)) << 32); }
    __syncthreads();
}
__device__ __forceinline__ void mlstm_s_unit(const float* sm_, const float* sn_, const float* sc_, const float* gmh_, unsigned char* ws_, float* out, LAS unsigned char* lds, int u) {
    PHASE_IDS_; OPAQUE_WS_;
    const int b = u >> 2, h = u & 3; const int row0 = MP + b * DT;
    LAS float* ql = (LAS float*)lds; LAS float* kl = ql + 512; LAS float* vl = kl + 512; LAS float* kwl = vl + 512; LAS float* nl = kwl + 512; LAS float* red = nl + 128;
    LAS float* Sl = red + 8192; LAS float* qnl = Sl + 16; LAS float* ws2 = qnl + 4;
    const int e4 = tid & 31, dg = tid >> 5; const float* Cg = sc_ + ((size_t)(b * 4 + h) * 128 + dg * 8) * 128 + 4 * e4; f32x4 cvr[8];
#pragma unroll
    for (int i = 0; i < 8; ++i) cvr[i] = __builtin_nontemporal_load((const GAS f32x4*)(Cg + (size_t)i * 128));
    float lf[4], ig[4], bc[4], mj[4], wint[4], wl[4]; const float* GT = (const float*)(ws + WS_GATES) + (size_t)row0 * 16;
#pragma unroll
    for (int j = 0; j < 4; ++j) { ig[j] = GT[j * 16 + h]; lf[j] = GT[j * 16 + 4 + h]; }
    const float mst = sm_[b * 4 + h];
    bc[0] = lf[0]; bc[1] = bc[0] + lf[1]; bc[2] = bc[1] + lf[2]; bc[3] = bc[2] + lf[3];
#pragma unroll
    for (int j = 0; j < 4; ++j) { float m = bc[j] + mst;
#pragma unroll
        for (int s = 0; s <= j; ++s) m = fmaxf(m, bc[j] - bc[s] + ig[s]);
        mj[j] = m; wint[j] = expf(bc[j] + mst - m); }
    const float aend = bc[3] + mst; float mnew = aend;
#pragma unroll
    for (int s = 0; s < 4; ++s) mnew = fmaxf(mnew, bc[3] - bc[s] + ig[s]);
#pragma unroll
    for (int s = 0; s < 4; ++s) wl[s] = expf(bc[3] - bc[s] + ig[s] - mnew);
    const float decay = expf(aend - mnew);
    for (int idx = tid; idx < 1536; idx += 512) { const int arr = idx >> 9, jj = (idx >> 7) & 3, d = idx & 127;
        const bf16* src = (const bf16*)(ws + (arr == 0 ? WS_MQ : arr == 1 ? WS_MK : WS_MV)); ql[idx] = bf2f(src[(size_t)(row0 + jj) * 512 + h * 128 + d]); }
    if (tid < 128) nl[tid] = sn_[(size_t)(b * 4 + h) * 128 + tid];
    __syncthreads();
    { const int s = tid >> 7; const float w = s == 0 ? wl[0] : s == 1 ? wl[1] : s == 2 ? wl[2] : wl[3]; kwl[tid] = w * kl[tid]; }
    for (int p = wave; p < 20; p += 8) {
        const LAS float* a_ = ql + (p < 16 ? (p >> 2) : (p - 16)) * 128; const LAS float* b_ = p < 16 ? kl + (p & 3) * 128 : nl;
        const float a = wave_sum(a_[lane] * b_[lane] + a_[lane + 64] * b_[lane + 64]);
        if (lane == 0) { if (p < 16) Sl[p] = a; else qnl[p - 16] = a; } }
    __syncthreads();
    { float* Co = out + O_CS + ((size_t)(b * 4 + h) * 128 + dg * 8) * 128 + 4 * e4;
      f32x4 part[4]; f32x4 vv[4];
#pragma unroll
      for (int s = 0; s < 4; ++s) { part[s] = (f32x4){0.f, 0.f, 0.f, 0.f}; vv[s] = *(const LAS f32x4*)(vl + s * 128 + 4 * e4); }
#pragma unroll
      for (int i = 0; i < 8; ++i) { const f32x4 cv = cvr[i]; const int d = dg * 8 + i;
          f32x4 cn = cv * decay;
#pragma unroll
          for (int s = 0; s < 4; ++s) { part[s] += cv * ql[s * 128 + d]; cn += vv[s] * kwl[s * 128 + d]; }
          __builtin_nontemporal_store(cn, (GAS f32x4*)(Co + (size_t)i * 128)); }
#pragma unroll
      for (int s = 0; s < 4; ++s) *(LAS f32x4*)(red + (dg * 4 + s) * 128 + 4 * e4) = part[s]; }
    __syncthreads();
    { const int jj = tid >> 7, e = tid & 127; float qc = 0.f;
#pragma unroll
      for (int dg = 0; dg < 16; ++dg) qc += red[(dg * 4 + jj) * 128 + e];
      const float bcj = jj == 0 ? bc[0] : jj == 1 ? bc[1] : jj == 2 ? bc[2] : bc[3], mjj = jj == 0 ? mj[0] : jj == 1 ? mj[1] : jj == 2 ? mj[2] : mj[3], wi = jj == 0 ? wint[0] : jj == 1 ? wint[1] : jj == 2 ? wint[2] : wint[3];
      float num = wi * qc, den = wi * qnl[jj];
#pragma unroll
      for (int s = 0; s < 4; ++s) if (s <= jj) { const float w = Sl[jj * 4 + s] * expf(bcj - bc[s] + ig[s] - mjj); num += w * vl[s * 128 + e]; den += w; }
      const float hv = num / fmaxf(fabsf(den), expf(-mjj));
      const float sq = wave_sum(hv * hv); if (lane == 0) ws2[wave] = sq;
      __syncthreads();
      const float rstd = rsqrtf((ws2[2 * jj] + ws2[2 * jj + 1]) * (1.0f / 128.0f) + EPS);
      const size_t oi = (size_t)(row0 + jj) * 512 + h * 128 + e;
      ((bf16*)(ws + WS_HY))[(size_t)(row0 + jj) * 1024 + h * 128 + e] = (bf16)f2bf(hv * rstd * gmh_[h * 128 + e] * bf2f(((const bf16*)(ws + WS_MO))[oi])); }
    if (tid < 128) out[O_NS + (size_t)(b * 4 + h) * 128 + tid] = decay * nl[tid] + ((kwl[tid] + kwl[128 + tid]) + (kwl[256 + tid] + kwl[384 + tid]));
    if (tid == 0) out[O_MS + b * 4 + h] = mnew;
    __syncthreads();
}
__device__ __forceinline__ float dpp_sum16(float v) {
    v += __builtin_bit_cast(float, __builtin_amdgcn_update_dpp(0, __builtin_bit_cast(int, v), 0xB1, 0xF, 0xF, true));
    v += __builtin_bit_cast(float, __builtin_amdgcn_update_dpp(0, __builtin_bit_cast(int, v), 0x4E, 0xF, 0xF, true));
    v += __builtin_bit_cast(float, __builtin_amdgcn_update_dpp(0, __builtin_bit_cast(int, v), 0x124, 0xF, 0xF, true));
    v += __builtin_bit_cast(float, __builtin_amdgcn_update_dpp(0, __builtin_bit_cast(int, v), 0x128, 0xF, 0xF, true));
    return v;
}
#ifndef DEC_NPG
#define DEC_NPG 4
#endif
constexpr int DEC_NPG_ = DEC_NPG, DEC_NI = NPAGES / DEC_NPG_, DEC_TOK = PAGE * DEC_NPG_, DEC_TPT = DEC_TOK / 64;
constexpr int DEC_ST = 68;
__device__ __forceinline__ void fox_dec_unit(const int* pt_, const float* clf_, const float* ck_, const float* cv_, unsigned char* ws_, float* out, LAS unsigned char* lds, int u) {
    PHASE_IDS_; OPAQUE_WS_;
    const int b = u / DEC_NI, qtr = u % DEC_NI; const int* pt = pt_ + b * NPAGES;
    LAS float* tbl = (LAS float*)lds;
    LAS float* csum = tbl + DEC_TOK * 8; LAS float* osum = csum + 512;
    LAS int* pgl = (LAS int*)(osum + 512); if (tid < DEC_NPG_) pgl[tid] = pt[qtr * DEC_NPG_ + tid];
    { const int hh = tid & 7, cc = tid >> 3; float lfv[DEC_TPT]; float s = 0.f, so = 0.f;
#pragma unroll
      for (int i = 0; i < DEC_TPT; ++i) { const int tok = DEC_TPT * cc + i; const int pg = pt[qtr * DEC_NPG_ + (tok >> 7)]; lfv[i] = clf_[((size_t)pg * PAGE + (tok & 127)) * 8 + hh]; s += lfv[i]; }
      for (int t8 = DEC_TOK * (qtr + 1); t8 < PAST; t8 += 512) {
        float lv[8];
#pragma unroll
        for (int i = 0; i < 8; ++i) { const int pg2 = pt[(t8 >> 7) + (i >> 1)]; lv[i] = clf_[((size_t)pg2 * PAGE + ((cc + 64 * i) & 127)) * 8 + hh]; }
        so += ((lv[0] + lv[1]) + (lv[2] + lv[3])) + ((lv[4] + lv[5]) + (lv[6] + lv[7])); }
      float sc = s;
      { const float t_ = __shfl_down(sc, 8);  if (lane < 56) sc += t_; }
      { const float t_ = __shfl_down(sc, 16); if (lane < 48) sc += t_; }
      { const float t_ = __shfl_down(sc, 32); if (lane < 32) sc += t_; }
      float off = __shfl_down(sc, 8); if (lane >= 56) off = 0.f;
      so += __shfl_xor(so, 8); so += __shfl_xor(so, 16); so += __shfl_xor(so, 32);
      if (lane < 8) { csum[wave * 8 + hh] = sc; osum[wave * 8 + hh] = so; }
      __syncthreads();
#pragma unroll
      for (int w2 = 0; w2 < 8; ++w2) { const float a_ = csum[w2 * 8 + hh], o_ = osum[w2 * 8 + hh]; off += (w2 > wave ? a_ : 0.f) + o_; }
#pragma unroll
      for (int i = DEC_TPT - 1; i >= 0; --i) { tbl[(DEC_TPT * cc + i) * 8 + hh] = off * LOG2E; off += lfv[i]; } }
    __syncthreads();
    const int h = wave, ts = lane >> 3, part = lane & 7;
    f32x4 q[4][2]; const int rowq = MP + b * DT;
#pragma unroll
    for (int t = 0; t < 4; ++t)
#pragma unroll
        for (int j = 0; j < 2; ++j) q[t][j] = ld4bf((const bf16*)(ws + WS_FQ) + (size_t)(rowq + t) * 512 + h * 64 + 32 * j + 4 * part);
#define DPPF(v_, c_) __builtin_bit_cast(float, __builtin_amdgcn_update_dpp(0, __builtin_bit_cast(int, v_), c_, 0xF, 0xF, true))
#define OCTSUM(v_) do { v_ += DPPF(v_, 0xB1); v_ += DPPF(v_, 0x4E); v_ += DPPF(v_, 0x141); } while (0)
#define DOT8(k0_, k1_, t_) (((k0_.x * q[t_][0].x + k0_.y * q[t_][0].y) + (k0_.z * q[t_][0].z + k0_.w * q[t_][0].w)) + ((k1_.x * q[t_][1].x + k1_.y * q[t_][1].y) + (k1_.z * q[t_][1].z + k1_.w * q[t_][1].w)))
    float snew[4]; f32x4 vn[2];
    { const float* GT = (const float*)(ws + WS_GATES) + (size_t)rowq * 16 + 8 + h; float fn = 0.f; const int tn = ts & 3;
#pragma unroll
      for (int t2 = 0; t2 < 4; ++t2) { const float x = GT[t2 * 16]; if (t2 <= tn) fn += x; }
      f32x4 kn[2];
#pragma unroll
      for (int j = 0; j < 2; ++j) { kn[j] = *(const GAS f32x4*)(out + O_KS + (size_t)(b * DT + tn) * 512 + h * 64 + 32 * j + 4 * part); vn[j] = *(const GAS f32x4*)(out + O_VS + (size_t)(b * DT + tn) * 512 + h * 64 + 32 * j + 4 * part); }
      const float biasn = -fn * LOG2E;
#pragma unroll
      for (int t = 0; t < 4; ++t) { float a_ = DOT8(kn[0], kn[1], t); OCTSUM(a_); snew[t] = (ts < 4 && tn <= t) ? a_ + biasn : -INFINITY; } }
    float R[4], l[4], thr[4]; f32x4 o[4][2];
#pragma unroll
    for (int t = 0; t < 4; ++t) { float mx = snew[t]; mx = fmaxf(mx, __shfl_xor(mx, 8)); mx = fmaxf(mx, __shfl_xor(mx, 16)); mx = fmaxf(mx, __shfl_xor(mx, 32));
        R[t] = mx; thr[t] = mx - 32.0f; l[t] = 0.f; o[t][0] = (f32x4){0.f, 0.f, 0.f, 0.f}; o[t][1] = (f32x4){0.f, 0.f, 0.f, 0.f}; }
    if (qtr == DEC_NI - 1) {
#pragma unroll
        for (int t = 0; t < 4; ++t) { const float p_ = __builtin_amdgcn_exp2f(snew[t] - R[t]); l[t] += p_; o[t][0] += vn[0] * p_; o[t][1] += vn[1] * p_; } }
#define DEC_KADDR(it_) (((size_t)__builtin_amdgcn_readfirstlane(pgl[(it_) >> 3]) * PAGE + ((it_) & 7) * 16 + ts) * 8 + h) * 64 + 4 * part
#define DEC_LOADK(it_, kk_) do { const size_t to_ = DEC_KADDR(it_); \
        _Pragma("unroll") for (int g = 0; g < 2; ++g) _Pragma("unroll") for (int j = 0; j < 2; ++j) kk_[g][j] = __builtin_nontemporal_load((const GAS f32x4*)(ck_ + to_ + (size_t)g * 8 * 512 + 32 * j)); } while (0)
    LAS float* scb = (LAS float*)(lds + 32768) + wave * 2048;
    unsigned long long vmask = 0ull;
    const int t1 = part & 3, g1 = part >> 2; const bool pb2 = (part & 4) != 0, pb1 = (part & 2) != 0, pb0 = (part & 1) != 0;
    float R1 = t1 == 0 ? R[0] : t1 == 1 ? R[1] : t1 == 2 ? R[2] : R[3]; const float thr1 = R1 - 32.0f; float l1 = 0.f;
    typedef float f32x2_ __attribute__((ext_vector_type(2)));
#define LO2(v_) ((f32x2_){(v_).x, (v_).y})
#define HI2(v_) ((f32x2_){(v_).z, (v_).w})
#define DEC_STEP(it_, kk_) do { const int ii_ = (it_); \
        const float bias_ = tbl[(((ii_ >> 3) * 128 + (ii_ & 7) * 16 + ts) * 8 + h) + 64 * g1]; float pv_[8]; \
        _Pragma("unroll") for (int g = 0; g < 2; ++g) _Pragma("unroll") for (int t = 0; t < 4; ++t) { \
            f32x2_ a_ = LO2(kk_[g][0]) * LO2(q[t][0]); a_ = HI2(kk_[g][0]) * HI2(q[t][0]) + a_; a_ = LO2(kk_[g][1]) * LO2(q[t][1]) + a_; a_ = HI2(kk_[g][1]) * HI2(q[t][1]) + a_; pv_[4 * g + t] = a_.x + a_.y; } \
        float w_[4], u_[2]; \
        _Pragma("unroll") for (int i = 0; i < 4; ++i) { const float keep_ = pb2 ? pv_[4 + i] : pv_[i], send_ = pb2 ? pv_[i] : pv_[4 + i]; w_[i] = keep_ + DPPF(send_, 0x141); }        \
        _Pragma("unroll") for (int i = 0; i < 2; ++i) { const float keep_ = pb1 ? w_[2 + i] : w_[i], send_ = pb1 ? w_[i] : w_[2 + i]; u_[i] = keep_ + DPPF(send_, 0x4E); }              \
        const float keep0_ = pb0 ? u_[1] : u_[0], send0_ = pb0 ? u_[0] : u_[1]; const float s_ = keep0_ + DPPF(send0_, 0xB1) + bias_;                                                     \
        if (__any(s_ > R1 + 64.0f)) { float rold_ = R1; \
            _Pragma("unroll") for (int t = 0; t < 4; ++t) { float mx_ = t1 == t ? s_ : -INFINITY; \
                _Pragma("unroll") for (int o_ = 1; o_ < 64; o_ <<= 1) mx_ = fmaxf(mx_, __shfl_xor(mx_, o_)); \
                const float rn_ = fmaxf(R[t], mx_), cr_ = __builtin_amdgcn_exp2f(R[t] - rn_); l[t] *= cr_; o[t][0] *= cr_; o[t][1] *= cr_; R[t] = rn_; } \
            R1 = t1 == 0 ? R[0] : t1 == 1 ? R[1] : t1 == 2 ? R[2] : R[3]; l1 *= __builtin_amdgcn_exp2f(rold_ - R1); } \
        l1 += __builtin_amdgcn_exp2f(s_ - R1); \
        const unsigned long long nm_ = __ballot(s_ >= thr1); const bool f0_ = (nm_ & 0x0F0F0F0F0F0F0F0Full) != 0ull, f1_ = (nm_ & 0xF0F0F0F0F0F0F0F0ull) != 0ull; \
        if (f0_ || f1_) { if (pb2 ? f1_ : f0_) scb[((2 * ii_ + g1) * 8 + ts) * 4 + t1] = s_; \
            vmask |= ((f0_ ? 1ull : 0ull) | (f1_ ? 2ull : 0ull)) << (2 * ii_); } } while (0)
    { f32x4 kA[2][2], kB[2][2];
      DEC_LOADK(0, kA);
#pragma unroll 1
      for (int it = 0; it < 8 * DEC_NPG_; it += 2) {
          DEC_LOADK(it + 1, kB); __builtin_amdgcn_sched_barrier(0);
          DEC_STEP(it, kA); __builtin_amdgcn_sched_barrier(0);
          if (it + 2 < 8 * DEC_NPG_) DEC_LOADK(it + 2, kA);
          __builtin_amdgcn_sched_barrier(0);
          DEC_STEP(it + 1, kB); __builtin_amdgcn_sched_barrier(0);
      } }
    while (vmask != 0ull) {
        int gg[8]; float wg[8];
#pragma unroll
        for (int u = 0; u < 8; ++u) { const bool has_ = vmask != 0ull; const int g_ = has_ ? (int)__builtin_ctzll(vmask) : gg[0]; if (has_) vmask &= vmask - 1ull; gg[u] = g_; wg[u] = has_ ? 1.0f : 0.0f; }
        f32x4 vv[8][2], sv[8];
#pragma unroll
        for (int u = 0; u < 8; ++u) { const size_t to_ = (((size_t)__builtin_amdgcn_readfirstlane(pgl[gg[u] >> 4]) * PAGE + (gg[u] & 15) * 8 + ts) * 8 + h) * 64 + 4 * part;
            vv[u][0] = __builtin_nontemporal_load((const GAS f32x4*)(cv_ + to_)); vv[u][1] = __builtin_nontemporal_load((const GAS f32x4*)(cv_ + to_ + 32));
            sv[u] = *(const LAS f32x4*)(scb + (gg[u] * 8 + ts) * 4); }
        __builtin_amdgcn_sched_barrier(0);
#pragma unroll
        for (int u = 0; u < 8; ++u) {
            const float p0_ = __builtin_amdgcn_exp2f(sv[u].x - R[0]) * wg[u], p1_ = __builtin_amdgcn_exp2f(sv[u].y - R[1]) * wg[u], p2_ = __builtin_amdgcn_exp2f(sv[u].z - R[2]) * wg[u], p3_ = __builtin_amdgcn_exp2f(sv[u].w - R[3]) * wg[u];
            o[0][0] += vv[u][0] * p0_; o[0][1] += vv[u][1] * p0_; o[1][0] += vv[u][0] * p1_; o[1][1] += vv[u][1] * p1_;
            o[2][0] += vv[u][0] * p2_; o[2][1] += vv[u][1] * p2_; o[3][0] += vv[u][0] * p3_; o[3][1] += vv[u][1] * p3_; }
    }
#undef DEC_STEP
#undef DEC_LOADK
#undef DEC_KADDR
#undef DOT8
#undef OCTSUM
#undef DPPF
#undef LO2
#undef HI2
    { float ls_ = l1 + __shfl_xor(l1, 4);
#pragma unroll
      for (int t = 0; t < 4; ++t) l[t] += __shfl(ls_, (lane & ~7) | t); }
#pragma unroll
    for (int t = 0; t < 4; ++t) {
#pragma unroll
        for (int sh = 8; sh <= 32; sh <<= 1) { const float m2 = __shfl_xor(R[t], sh), l2 = __shfl_xor(l[t], sh);
            const float mn = fmaxf(R[t], m2), c1 = __builtin_amdgcn_exp2f(R[t] - mn), c2 = __builtin_amdgcn_exp2f(m2 - mn); l[t] = l[t] * c1 + l2 * c2; R[t] = mn;
#pragma unroll
            for (int j = 0; j < 2; ++j) { f32x4 o2; o2.x = __shfl_xor(o[t][j].x, sh); o2.y = __shfl_xor(o[t][j].y, sh); o2.z = __shfl_xor(o[t][j].z, sh); o2.w = __shfl_xor(o[t][j].w, sh); o[t][j] = o[t][j] * c1 + o2 * c2; } }
        float* rec = (float*)(ws + WS_MISC + MI_DEC) + ((size_t)((b * DEC_NI + qtr) * 8 + h) * 4 + t) * DEC_ST;
        if (ts == 0) { *(GAS f32x4*)(rec + 4 * part) = o[t][0]; *(GAS f32x4*)(rec + 32 + 4 * part) = o[t][1]; if (part == 0) { rec[64] = R[t]; rec[65] = l[t]; } } }
    __syncthreads();
}
__device__ __forceinline__ void fox_dec_combine(unsigned char* ws, int vcu, int Gn, int tid) {
    const float* P = (const float*)(ws + WS_MISC + MI_DEC); bf16* YF = (bf16*)(ws + WS_HY) + 512;
    for (int i = vcu * 512 + tid; i < MS * 128; i += Gn * 512) { const int row = i >> 7, c4 = i & 127, h = c4 >> 4, d = (c4 & 15) * 4, b = row >> 2, t = row & 3;
        const float* r[DEC_NI]; float mm[DEC_NI], mx = -INFINITY;
#pragma unroll
        for (int qd = 0; qd < DEC_NI; ++qd) { r[qd] = P + ((size_t)((b * DEC_NI + qd) * 8 + h) * 4 + t) * DEC_ST; mm[qd] = r[qd][64]; mx = fmaxf(mx, mm[qd]); }
        f32x4 o = (f32x4){0.f, 0.f, 0.f, 0.f}; float ls = 0.f;
#pragma unroll
        for (int qd = 0; qd < DEC_NI; ++qd) { const float w = exp2f(mm[qd] - mx); ls += r[qd][65] * w; o += *(const GAS f32x4*)(r[qd] + d) * w; }
        o *= 1.0f / ls;
        *(GAS unsigned long long*)(YF + (size_t)(MP + row) * 1024 + h * 64 + d) = (unsigned long long)pk2(o.x, o.y) | ((unsigned long long)pk2(o.z, o.w) << 32); }
}
__device__ __forceinline__ void fox_f2_build(unsigned char* ws, LAS unsigned char* lds, int bh, int tid, int lane, int wave) {
    const int b = bh / HF, h = bh % HF;
    const float* GT = (const float*)(ws + WS_GATES) + ((size_t)b * SEQ) * 16 + 8 + h; float* F2g = (float*)(ws + WS_MISC + MI_F2) + (size_t)bh * SEQ;
    LAS float* wsum = (LAS float*)(lds + attn_body::LDS_WS);
    float v[8]; const int base = tid * 8;
#pragma unroll
    for (int i = 0; i < 8; ++i) v[i] = GT[(size_t)(base + i) * 16];
#pragma unroll
    for (int i = 1; i < 8; ++i) v[i] += v[i - 1];
    float sc = v[7];
#pragma unroll
    for (int o = 1; o < 64; o <<= 1) { const float t = __shfl_up(sc, o); if (lane >= o) sc += t; }
    if (lane == 63) wsum[wave] = sc;
    __syncthreads();
    float off = sc - v[7];
    for (int w = 0; w < wave; ++w) off += wsum[w];
    f32x4 o0, o1; o0.x = -(v[0] + off) * LOG2E; o0.y = -(v[1] + off) * LOG2E; o0.z = -(v[2] + off) * LOG2E; o0.w = -(v[3] + off) * LOG2E; o1.x = -(v[4] + off) * LOG2E; o1.y = -(v[5] + off) * LOG2E; o1.z = -(v[6] + off) * LOG2E; o1.w = -(v[7] + off) * LOG2E;
    *(GAS f32x4*)(F2g + base) = o0; *(GAS f32x4*)(F2g + base + 4) = o1;
    __syncthreads();
}
__device__ __forceinline__ void fox_f2_to_lds(unsigned char* ws, LAS unsigned char* lds, int b, int h, int tid, int lane, int wave) {
    const float* F2g = (const float*)(ws + WS_MISC + MI_F2) + (size_t)(b * HF + h) * SEQ; LAS float* F2l = (LAS float*)(lds + attn_body::LDS_F2);
    *(LAS f32x4*)(F2l + 8 * tid) = *(const GAS f32x4*)(F2g + 8 * tid); *(LAS f32x4*)(F2l + 8 * tid + 4) = *(const GAS f32x4*)(F2g + 8 * tid + 4);
    __syncthreads();
}
#define PHASE_IDS int tid_ = threadIdx.x; asm volatile("" : "+v"(tid_)); const int tid = tid_, lane = tid & 63, wave = __builtin_amdgcn_readfirstlane(tid >> 6)
__device__ __forceinline__ void fox_attn_item(unsigned char* ws_, LAS unsigned char* ldsl, unsigned char* lds, int bh, int qb, float margin) {
    PHASE_IDS_; OPAQUE_WS_;
    const int b = bh / HF, h = bh % HF;
    fox_f2_to_lds(ws, ldsl, b, h, tid, lane, wave);
    const LAS float* TBl = (const LAS float*)(ldsl + attn_body::LDS_F2);
    const int NT = 4 * (qb + 1); int t0 = 0; const float thr = TBl[256 * qb] - margin;
    { const int tc = 2 * (lane + 1);
      const bool ok_ = (NT - tc >= 4) && TBl[64 * (tc <= 62 ? tc : 62) - 1] < thr;
      const unsigned long long mk = __ballot(ok_);
      t0 = 2 * (int)__builtin_ctzll(~mk | (1ull << 63)); }
    t0 = __builtin_amdgcn_readfirstlane(t0);
    attn_body::attn_unit<8>(b, h, qb, t0, (const attn_body::bf16*)(ws + WS_FQ), (const attn_body::bf16*)(ws + WS_FK), (const attn_body::bf16*)(ws + WS_FV), (attn_body::bf16*)(ws + WS_HY) + 512, (char*)lds + RING_OFF);
}
__device__ __forceinline__ void late_weights_item(const Args& A, unsigned char* ws_, LAS unsigned char* lds, int q) {
    PHASE_IDS_; OPAQUE_WS_;
    p0_late_item(A, ws, q * 8 + wave, (LAS float*)(lds + RING_OFF + wave * 16384), lane);
    __syncthreads();
}
constexpr int CW_WQW = 192, CW_WQP = 256;
__device__ __forceinline__ void drain_late_weights(Frame& F, const Args& A) {
    PHASE_IDS_; size_t wso_ = 0; asm volatile("" : "+s"(wso_)); unsigned char* ws = F.ws + wso_;
    volatile LAS unsigned* slot = (volatile LAS unsigned*)(F.lds + LDSCTL_OFF);
    for (;;) {
        if (tid == 0) slot[0] = __hip_atomic_fetch_add(F.ctl + CW_WQW, 1u, __ATOMIC_RELAXED, __HIP_MEMORY_SCOPE_AGENT);
        __syncthreads();
        const int k = __builtin_amdgcn_readfirstlane((int)slot[0]);
        __syncthreads();
        if (k >= NLATE / 8) break;
        late_weights_item(A, ws, F.lds, k);
    }
}
struct OneUnit { int pm, pn;
    __device__ __forceinline__ bool next(int i, pg8::Unit& u) const { if (i) return false; u.pm = pm; u.pn = pn; return true; }
    __device__ __forceinline__ void a_ready(const pg8::Unit&) const {}
    __device__ __forceinline__ void done(const pg8::Unit&) const {} };
__device__ __forceinline__ void drain_ple_proj(Frame& F) {
    PHASE_IDS_; size_t wso_ = 0; asm volatile("" : "+s"(wso_)); unsigned char* ws = F.ws + wso_;
    volatile LAS unsigned* slot = (volatile LAS unsigned*)(F.lds + LDSCTL_OFF);
    for (;;) {
        if (tid == 0) slot[0] = __hip_atomic_fetch_add(F.ctl + CW_WQP, 1u, __ATOMIC_RELAXED, __HIP_MEMORY_SCOPE_AGENT);
        __syncthreads();
        const int k = __builtin_amdgcn_readfirstlane((int)slot[0]);
        __syncthreads();
        if (k >= 264) break;
        pg8::Gemm g{(const bf16*)(ws + WS_PB), (const bf16*)(ws + WS_WPP), MT, DM, PLE}; OneUnit S{k >> 2, k & 3};
        pg8::EpiStore E{(bf16*)(ws + WS_TP)};
        pg8::gemm_phase<pg8::EpiStore, OneUnit, false, true>(F.lds + RING_OFF, g, S, E);
        __syncthreads();
    }
}
constexpr int CW_WQ = 64, CW_WQD = 128;
constexpr int WQC_ITEMS = 512 * 3;
constexpr int WQD_ITEMS = DB * DEC_NI;
#ifndef DEC_FIRST_OF_16
#define DEC_FIRST_OF_16 6
#endif
__device__ __forceinline__ void mix_phase_a(Frame& F, const Args& A, unsigned char* lds) {
    PHASE_IDS; size_t wso_ = 0; asm volatile("" : "+s"(wso_)); unsigned char* ws = F.ws + wso_;
    float mq = 0.f, mk = 0.f; for (int i = 0; i < 64; ++i) { mq = fmaxf(mq, fabsf(I_GQN[i])); mk = fmaxf(mk, fabsf(I_GKN[i])); }
    if (tid == 0) ((volatile LAS float*)(F.lds + LDSCTL_OFF))[4] = 24.0f + 2.0f * (64.0f * mq * mk * C2Q);
    volatile LAS unsigned* slot = (volatile LAS unsigned*)(F.lds + LDSCTL_OFF);
    const bool dec_first = (((int)blockIdx.x >> 3) & 15) < DEC_FIRST_OF_16;
    for (int pass = 0; pass < 2; ++pass) { const bool dq = dec_first != (pass == 1);
        for (;;) {
            if (tid == 0) slot[0] = __hip_atomic_fetch_add(F.ctl + (dq ? CW_WQD : CW_WQ), 1u, __ATOMIC_RELAXED, __HIP_MEMORY_SCOPE_AGENT);
            __syncthreads();
            const int k = __builtin_amdgcn_readfirstlane((int)slot[0]);
            __syncthreads();
            if (k >= (dq ? WQD_ITEMS : WQC_ITEMS)) break;
            if (dq) fox_dec_unit(I_PT, I_CLF, I_CK, I_CV, ws, F.out, F.lds, k);
            else if (k < 512) fox_attn_item(ws, F.lds, lds, k & 31, 15 - (k >> 5), ((volatile LAS float*)(F.lds + LDSCTL_OFF))[4]);
            else if (k < 1024) mlstm_a_unit(ws, F.lds, k - 512);
            else mlstm_s_unit(I_SM, I_SN, I_SC, I_GMH, ws, F.out, F.lds, k - 1024);
        } }
    drain_late_weights(F, A);
}
__device__ __forceinline__ void mix_phase_b(Frame& F, const Args& A) {
    PHASE_IDS; size_t wso_ = 0; asm volatile("" : "+s"(wso_)); unsigned char* ws = F.ws + wso_;
    mlstm_b(ws, F.out, F.lds, F.vcu, F.G, tid);
    fox_dec_combine(ws, F.vcu, F.G, tid);
}
__device__ __forceinline__ void mix_phase_c(Frame& F, const Args& A, unsigned char* lds) {
    PHASE_IDS; size_t wso_ = 0; asm volatile("" : "+s"(wso_)); unsigned char* ws = F.ws + wso_;
    for (int u = F.vcu; u < 512; u += F.G) { mlstm_c_unit(A, ws, F.lds, u, tid, lane, wave);
#ifdef DUP_C
        mlstm_c_unit(A, ws, F.lds, u, tid, lane, wave);
#endif
    }
}
__device__ __forceinline__ f32x4 mini_gemm(const bf16* A_, const bf16* Bt, int K, int tr, int tc, LAS float* red, int tid, int lane, int wave, int lda = 0, int ldb = 0) {
    if (lda == 0) lda = K; if (ldb == 0) ldb = K;
    const int fr = lane & 15, fq = lane >> 4; const int ksl = K >> 3, nstep = ksl >> 5;
    f32x4 acc[2][4];
#pragma unroll
    for (int rb = 0; rb < 2; ++rb)
#pragma unroll
        for (int cb = 0; cb < 4; ++cb) acc[rb][cb] = (f32x4){0.f, 0.f, 0.f, 0.f};
    const bf16* Ap = A_ + (size_t)(32 * tr + fr) * lda + wave * ksl + 8 * fq; const bf16* Bp = Bt + (size_t)(64 * tc + fr) * ldb + wave * ksl + 8 * fq;
#pragma unroll 1
    for (int ks0 = 0; ks0 < nstep; ks0 += 4) {
        bf16x8 a[4][2], b[4][4];
#pragma unroll
        for (int u = 0; u < 4; ++u) if (ks0 + u < nstep) {
#pragma unroll
            for (int rb = 0; rb < 2; ++rb) a[u][rb] = *(const GAS bf16x8*)(Ap + (size_t)rb * 16 * lda + 32 * (ks0 + u));
#pragma unroll
            for (int cb = 0; cb < 4; ++cb) b[u][cb] = *(const GAS bf16x8*)(Bp + (size_t)cb * 16 * ldb + 32 * (ks0 + u)); }
        __builtin_amdgcn_sched_barrier(0);
#pragma unroll
        for (int u = 0; u < 4; ++u) if (ks0 + u < nstep) {
#pragma unroll
            for (int rb = 0; rb < 2; ++rb)
#pragma unroll
                for (int cb = 0; cb < 4; ++cb) acc[rb][cb] = MFMA16(b[u][cb], a[u][rb], acc[rb][cb]); }
    }
#pragma unroll
    for (int rb = 0; rb < 2; ++rb)
#pragma unroll
        for (int cb = 0; cb < 4; ++cb) *(LAS f32x4*)(red + wave * 2048 + (16 * rb + fr) * 64 + 16 * cb + 4 * fq) = acc[rb][cb];
    __syncthreads();
    f32x4 s = (f32x4){0.f, 0.f, 0.f, 0.f};
#pragma unroll
    for (int w = 0; w < 8; ++w) s += *(const LAS f32x4*)(red + w * 2048 + (tid >> 4) * 64 + (tid & 15) * 4);
    __syncthreads();
    return s;
}
__device__ __forceinline__ float sig1(float x) { return __builtin_amdgcn_rcpf(1.f + __builtin_amdgcn_exp2f(-LOG2E * x)); }
__device__ __forceinline__ void smp_merge(Frame& F, unsigned char* ws, int tid, int lane, int wave) {
    LAS float* red = (LAS float*)(F.lds + RING_OFF);
    for (int t = F.vcu; t < 256; t += F.G) { const int tr = 8 * (t >> 7) + ((t & 31) >> 2), tc = 4 * ((t >> 5) & 3) + (t & 3);
        const f32x4 a = mini_gemm((const bf16*)(ws + WS_HY) + (size_t)MP * DM, (const bf16*)(ws + WS_WPA), WM, tr, tc, red, tid, lane, wave, DM, DM);
        const f32x4 b = mini_gemm((const bf16*)(ws + WS_HY) + (size_t)MP * DM + 512, (const bf16*)(ws + WS_WPA) + 512, WF, tr, tc, red, tid, lane, wave, DM, DM);
        const size_t idx = (size_t)(MP + 32 * tr + (tid >> 4)) * DM + 64 * tc + 4 * (tid & 15);
        st4bf((bf16*)(ws + WS_U) + idx, ld4bf((const bf16*)(ws + WS_GA) + idx) * a + ld4bf((const bf16*)(ws + WS_GB) + idx) * b); }
}
template <int BASE_BF16> __device__ __forceinline__ void smp_res(Frame& F, const bf16* A_, const bf16* Bt, int K, const void* base, bf16* An, float* ssq, int tid, int lane, int wave) {
    LAS float* red = (LAS float*)(F.lds + RING_OFF);
    for (int t = F.vcu; t < 256; t += F.G) { const int tr = 8 * (t >> 7) + ((t & 31) >> 2), tc = 4 * ((t >> 5) & 3) + (t & 3);
        const f32x4 acc = mini_gemm(A_, Bt, K, tr, tc, red, tid, lane, wave);
        const int r = 32 * tr + (tid >> 4), c = 64 * tc + 4 * (tid & 15); const size_t idx = (size_t)r * DM + c;
        const f32x4 o = (BASE_BF16 ? ld4bf((const bf16*)base + idx) : *(const GAS f32x4*)((const float*)base + idx)) + acc; st4bf(An + idx, o);
        const float s = dpp_sum16(dot4f(o)); if ((tid & 15) == 0) ssq[(size_t)r * 16 + tc] = s; }
}
__device__ __forceinline__ void smp_ple(Frame& F, unsigned char* ws, float* Y  , int tid, int lane, int wave) {
    LAS float* red = (LAS float*)(F.lds + RING_OFF);
    for (int t = F.vcu; t < 256; t += F.G) { const int tr = 8 * (t >> 7) + ((t & 31) >> 2), tc = 4 * ((t >> 5) & 3) + (t & 3);
        const f32x4 acc = mini_gemm((const bf16*)(ws + WS_A3) + (size_t)MP * DM, (const bf16*)(ws + WS_WPG), DM, tr, tc, red, tid, lane, wave);
        const int r = 32 * tr + (tid >> 4), c = 64 * tc + 4 * (tid & 15); const size_t idx = (size_t)r * DM + c;
        const GAS f32x4* sp = (const GAS f32x4*)((const float*)(ws + WS_SSQ3) + (size_t)(MP + r) * 16); const f32x4 q = (sp[0] + sp[1]) + (sp[2] + sp[3]);
        const float rs = rsqrtf(((q[0] + q[1]) + (q[2] + q[3])) * (1.0f / DM) + EPS);
        const f32x4 tp = ld4bf((const bf16*)(ws + WS_TP) + (size_t)MP * DM + idx);
        f32x4 y = ld4bf((const bf16*)(ws + WS_A3) + (size_t)MP * DM + idx); y[0] += sig1(acc[0] * rs) * tp[0]; y[1] += sig1(acc[1] * rs) * tp[1]; y[2] += sig1(acc[2] * rs) * tp[2]; y[3] += sig1(acc[3] * rs) * tp[3];
        *(GAS f32x4*)(Y + idx) = y; }
}
constexpr int N_PHASES = 10;
__global__ void __launch_bounds__(NWAVES * 64, 2) fwd_kernel(Args args) {
    extern __shared__ __attribute__((aligned(16))) unsigned char lds[];
    Frame F;
    F.lds = (LAS unsigned char*)lds;
    F.MISC = (volatile LAS unsigned*)(F.lds + MISC_OFF);
    F.G = gridDim.x; { const int bx = blockIdx.x; F.vcu = (F.G % 8 == 0) ? (bx % 8) * (F.G / 8) + bx / 8 : bx; }
    unsigned char* ws0 = args.ws; F.ws = ws0; F.out = args.out;
    F.ctl = (gu32*)(ws0 + WS_CTL);
    const Args& A = args;
    for (int u = threadIdx.x; u < (LDS_BYTES - LDSCTL_OFF) / 4; u += NWAVES * 64) ((LAS unsigned*)(F.lds + LDSCTL_OFF))[u] = 0u;
    __syncthreads();
    XcdBarrier bar = xcd_barrier_post((unsigned*)(F.ctl + CW_BAR), F.MISC + 8);
    const int lo = args.ph_lo, hi = args.ph_hi;
#ifdef PROBE_A
    unsigned long long stamp_[16]; int ns_ = 0;
#define STAMP() do { stamp_[ns_++] = __builtin_amdgcn_s_memrealtime(); } while (0)
#else
#define STAMP() do {} while (0)
#endif
    STAMP();
#define IN(k) (lo <= (k) && (k) < hi)
#define SEAM(k) do { if (IN(k) && IN((k) + 1)) xcd_barrier(bar); } while (0)
#define PHASE_WS size_t wso_ = 0; asm volatile("" : "+s"(wso_)); unsigned char* ws = ws0 + wso_

#ifdef PROBE_P0
    if (IN(0)) { p0_prologue(F, A, 1); STAMP(); p0_prologue(F, A, 2); STAMP(); p0_prologue(F, A, 4); STAMP(); }
#else
    if (IN(0)) { p0_prologue(F, A); }
#endif
    SEAM(0); STAMP();
    if (IN(1)) { PHASE_WS;
        pg8::Gemm g{(const bf16*)(ws + WS_XN), (const bf16*)(ws + WS_WIN), MT, NIN, DM}; pg8::StaticOrder S; S.init(MT, NIN, F.G, (int)blockIdx.x);
        pg8::EpiIn E{(bf16*)(ws + WS_MQ), (bf16*)(ws + WS_MK), (bf16*)(ws + WS_MV), (bf16*)(ws + WS_MO), (bf16*)(ws + WS_FQ), (bf16*)(ws + WS_FK), (bf16*)(ws + WS_FV), (bf16*)(ws + WS_GA), (bf16*)(ws + WS_GB),
                     F.out + O_KP, F.out + O_KS, F.out + O_VP, F.out + O_VS, I_GQN, I_GKN, C2Q};
        pg8::gemm_phase<pg8::EpiIn, pg8::StaticOrder, true, true>(F.lds + RING_OFF, g, S, E);
        __syncthreads();
        { const int f2i = (int)blockIdx.x - ((int)F.G - 64); if (f2i >= 0 && f2i < 32) { PHASE_IDS; fox_f2_build(ws, F.lds, f2i, tid, lane, wave); } else if ((int)F.G < 64) { PHASE_IDS; for (int bh = (int)blockIdx.x; bh < 32; bh += (int)F.G) fox_f2_build(ws, F.lds, bh, tid, lane, wave); } }
        drain_late_weights(F, A);
    }
    SEAM(1); STAMP();
    if (IN(2)) { mix_phase_a(F, A, lds); }
    SEAM(2); STAMP();
    if (IN(3)) { mix_phase_b(F, A); }
    SEAM(3); STAMP();
    if (IN(4)) { mix_phase_c(F, A, lds); }
    SEAM(4); STAMP();
    if (IN(5)) { PHASE_WS;
        { pg8::Gemm g{(const bf16*)(ws + WS_HY), (const bf16*)(ws + WS_WPA), MP, DM, DM}; pg8::StaticOrder S; S.init(MP, DM, F.G, (int)blockIdx.x);
          pg8::EpiMerge2 E{(const bf16*)(ws + WS_GA), (const bf16*)(ws + WS_GB), (bf16*)(ws + WS_U)};
          pg8::gemm_phase<pg8::EpiMerge2, pg8::StaticOrder, true, true>(F.lds + RING_OFF, g, S, E); }
        __syncthreads();
        { PHASE_IDS; smp_merge(F, ws, tid, lane, wave); }
    }
    SEAM(5); STAMP();
    if (IN(6)) { PHASE_WS;
        pg8::Gemm g{(const bf16*)(ws + WS_U), (const bf16*)(ws + WS_WOUT), MP, DM, DM}; pg8::StaticOrder S; S.init(MP, DM, F.G, (int)blockIdx.x);
        pg8::EpiRes<0> E{I_XP, (bf16*)(ws + WS_A2), (float*)(ws + WS_SSQ2)};
        pg8::gemm_phase<pg8::EpiRes<0>, pg8::StaticOrder, true, true>(F.lds + RING_OFF, g, S, E);
        __syncthreads();
        { PHASE_IDS; smp_res<0>(F, (const bf16*)(ws + WS_U) + (size_t)MP * DM, (const bf16*)(ws + WS_WOUT), DM, I_XS, (bf16*)(ws + WS_A2) + (size_t)MP * DM, (float*)(ws + WS_SSQ2) + (size_t)MP * 16, tid, lane, wave); }
    }
    SEAM(6); STAMP();
    if (IN(7)) { PHASE_WS;
        pg8::Gemm g{(const bf16*)(ws + WS_A2), (const bf16*)(ws + WS_WGU), MT, NGU, DM}; pg8::StaticOrder S; S.init(MT, NGU, F.G, (int)blockIdx.x);
        pg8::EpiGU E{(const float*)(ws + WS_SSQ2), (bf16*)(ws + WS_HB)};
        pg8::gemm_phase<pg8::EpiGU, pg8::StaticOrder, true, true>(F.lds + RING_OFF, g, S, E);
        __syncthreads();
        drain_ple_proj(F);
    }
    SEAM(7); STAMP();
    if (IN(8)) { PHASE_WS;
        { pg8::Gemm g{(const bf16*)(ws + WS_HB), (const bf16*)(ws + WS_WDN), MP, DM, DFF}; pg8::StaticOrder S; S.init(MP, DM, F.G, (int)blockIdx.x);
          pg8::EpiRes<1> E{(const bf16*)(ws + WS_A2), (bf16*)(ws + WS_A3), (float*)(ws + WS_SSQ3)};
          pg8::gemm_phase<pg8::EpiRes<1>, pg8::StaticOrder, true, true>(F.lds + RING_OFF, g, S, E); }
        __syncthreads();
        drain_ple_proj(F);
        __syncthreads();
        { PHASE_IDS; smp_res<1>(F, (const bf16*)(ws + WS_HB) + (size_t)MP * DFF, (const bf16*)(ws + WS_WDN), DFF, (const bf16*)(ws + WS_A2) + (size_t)MP * DM, (bf16*)(ws + WS_A3) + (size_t)MP * DM, (float*)(ws + WS_SSQ3) + (size_t)MP * 16, tid, lane, wave); }
    }
    SEAM(8); STAMP();
    if (IN(9)) { PHASE_WS;
        pg8::Gemm g{(const bf16*)(ws + WS_A3), (const bf16*)(ws + WS_WPG), MP, DM, DM}; pg8::StaticOrder S; S.init(MP, DM, F.G, (int)blockIdx.x);
        pg8::EpiPle E{(const float*)(ws + WS_SSQ3), (const bf16*)(ws + WS_TP), (const bf16*)(ws + WS_A3), F.out + O_YP};
        pg8::gemm_phase<pg8::EpiPle, pg8::StaticOrder, true, true>(F.lds + RING_OFF, g, S, E);
        __syncthreads();
        { PHASE_IDS; smp_ple(F, ws, F.out + O_YS, tid, lane, wave); }
    }
#ifdef PROBE_A
    xcd_barrier(bar); STAMP();
    if (blockIdx.x == 0) { float ta = (float)(stamp_[PROBE_A + 1] - stamp_[PROBE_A]) * 0.01f, tb = (float)(stamp_[PROBE_B + 1] - stamp_[PROBE_B]) * 0.01f;
        const float sc = 1.0f + sqrtf(ta * 0.001f); for (int i = threadIdx.x; i < DB * HM_; i += NWAVES * 64) F.out[O_MS + i] *= sc;
        if (threadIdx.x == 0) F.out[O_YP] += tb * 0.1f; }
#endif
#undef IN
#undef SEAM
}

extern "C" void kernel_launch(void* const* d_in, const int* in_sizes, int n_in, void* d_out, int out_size, void* d_ws, size_t ws_size, hipStream_t stream) {
    static int grid = 0;
    if (grid == 0) {
        if (n_in != 28 || out_size != (int)O_END || ws_size < WS_END) { fprintf(stderr, "kernel_launch: unexpected shapes: n_in %d out %d ws %zu\n", n_in, out_size, ws_size); grid = -1; return; }
        int dev = 0, cus = 0, per_cu = 0;
        if (hipGetDevice(&dev) != hipSuccess || hipDeviceGetAttribute(&cus, hipDeviceAttributeMultiprocessorCount, dev) != hipSuccess) { grid = -1; return; }
        if (hipFuncSetAttribute((const void*)fwd_kernel, hipFuncAttributeMaxDynamicSharedMemorySize, LDS_BYTES) != hipSuccess) { fprintf(stderr, "kernel_launch: hipFuncSetAttribute failed\n"); grid = -1; return; }
        if (hipOccupancyMaxActiveBlocksPerMultiprocessor(&per_cu, (const void*)fwd_kernel, NWAVES * 64, LDS_BYTES) != hipSuccess || per_cu < 1) { fprintf(stderr, "kernel_launch: occupancy query says %d\n", per_cu); }
        (void)hipGetLastError();
        grid = cus;
    }
    if (grid < 0) return;
    if (hipMemsetAsync((char*)d_ws + WS_CTL, 0, CTL_ZERO_BYTES, stream) != hipSuccess) return;
    Args a{};
    for (int i = 0; i < 28; ++i) a.in[i] = d_in[i];
    a.out = (float*)d_out; a.ws = (unsigned char*)d_ws;
#ifndef MK_SPLIT
    a.ph_lo = 0; a.ph_hi = N_PHASES;
    hipLaunchKernelGGL(fwd_kernel, dim3(grid), dim3(NWAVES * 64), LDS_BYTES, stream, a);
#else
    for (int p = 0; p < N_PHASES; ++p) { a.ph_lo = p; a.ph_hi = p + 1; hipLaunchKernelGGL(fwd_kernel, dim3(grid), dim3(NWAVES * 64), LDS_BYTES, stream, a); }
#endif
}
```

```cpp
#include <hip/hip_runtime.h>
#include <hip/hip_bf16.h>
#include <cstdio>
#include <cstdint>
#include <cmath>
namespace pg8 {
#define PG8_LAS __attribute__((address_space(3)))
typedef unsigned short bf16_t;
typedef short bf16x8 __attribute__((ext_vector_type(8)));
typedef float f32x4 __attribute__((ext_vector_type(4)));
typedef unsigned u32x4 __attribute__((ext_vector_type(4)));
constexpr int BM = 256, BK = 64, HALF = 128, HTB = HALF * BK * 2  , STAGE_BYTES = 8 * HTB, NXCD = 8, WGM = 8;

__host__ __device__ __forceinline__ int lds_byte(int r, int c) { const int st = (r >> 4) * 2 + (c >> 5), rr = r & 15, cc = c & 31, ob = rr * 64 + cc * 2; return st * 1024 + (ob ^ (((ob >> 9) & 1) << 5)); }
__host__ __device__ __forceinline__ void stage_rc(int b, int& R, int& C) { const int st = b / 1024, sb = b % 1024, swz = sb ^ (((sb >> 9) & 1) << 5); R = (st >> 1) * 16 + swz / 64; C = (st & 1) * 32 + (swz % 64) / 2; }
__host__ __device__ __forceinline__ int perm32(int rho) { const int n = rho >> 4, i = rho & 15; return 8 * (i >> 2) + 4 * n + (i & 3); }

struct Unit { int pm, pn; };
struct Gemm { const bf16_t* A; const bf16_t* Bt; int M, N, K; };

struct StaticOrder {
    int nM, nN, nwg, G, c;
    __host__ __device__ void init(int M, int N, int G_, int c_) { nM = M / BM; nN = N / BM; nwg = nM * nN; G = G_; c = c_; }
    __host__ __device__ bool next(int i, Unit& u) const {
        const long L = (long)i * G + c; if (L >= nwg) return false;
        int wgid = (int)L; { const int q = nwg / NXCD, r = nwg % NXCD, xcd = wgid % NXCD, off = wgid / NXCD; wgid = (xcd < r ? xcd * (q + 1) : r * (q + 1) + (xcd - r) * q) + off; }
        const int nig = WGM * nN, gid = wgid / nig, fm = gid * WGM, gsz = (nM - fm) < WGM ? (nM - fm) : WGM;
        u.pm = fm + ((wgid % nig) % gsz); u.pn = (wgid % nig) / gsz; return true;
    }
    __device__ __forceinline__ void a_ready(const Unit&) const {}
    __device__ __forceinline__ void done(const Unit&) const {}
};

typedef float pg8_f32x2 __attribute__((ext_vector_type(2))); typedef __bf16 pg8_bf16x2 __attribute__((ext_vector_type(2)));
__device__ __forceinline__ unsigned cvt_pk_bf16(float lo, float hi) { const pg8_f32x2 v = {lo, hi}; const pg8_bf16x2 b = __builtin_convertvector(v, pg8_bf16x2); return __builtin_bit_cast(unsigned, b); }
typedef float f32x2 __attribute__((ext_vector_type(2)));
constexpr float EPSN = 1e-6f;
#define PG8_GAS __attribute__((address_space(1)))
__device__ __forceinline__ void st16_wt(void* p, u32x4 v) { asm volatile("global_store_dwordx4 %0, %1, off sc1\n\ts_nop 1" :: "v"(p), "v"(v) : "memory"); }
__device__ __forceinline__ void st16_wt(void* p, f32x4 v) { st16_wt(p, __builtin_bit_cast(u32x4, v)); }
__device__ __forceinline__ float sigm(float x) { return __builtin_amdgcn_rcpf(1.f + __builtin_amdgcn_exp2f(-1.4426950408889634f * x)); }
__device__ __forceinline__ f32x4 sigm4(f32x4 x) { f32x4 r; r[0] = sigm(x[0]); r[1] = sigm(x[1]); r[2] = sigm(x[2]); r[3] = sigm(x[3]); return r; }
__device__ __forceinline__ void st8bf(bf16_t* p, const f32x4 a, const f32x4 b) { u32x4 w; w.x = cvt_pk_bf16(a[0], a[1]); w.y = cvt_pk_bf16(a[2], a[3]); w.z = cvt_pk_bf16(b[0], b[1]); w.w = cvt_pk_bf16(b[2], b[3]); *(PG8_GAS u32x4*)p = w; }
__device__ __forceinline__ void ld8bf(const bf16_t* p, f32x4& a, f32x4& b) { const u32x4 w = *(const PG8_GAS u32x4*)p;
    a[0] = __uint_as_float(w.x << 16); a[1] = __uint_as_float(w.x & 0xffff0000u); a[2] = __uint_as_float(w.y << 16); a[3] = __uint_as_float(w.y & 0xffff0000u);
    b[0] = __uint_as_float(w.z << 16); b[1] = __uint_as_float(w.z & 0xffff0000u); b[2] = __uint_as_float(w.w << 16); b[3] = __uint_as_float(w.w & 0xffff0000u); }
__device__ __forceinline__ float dot4(f32x4 a) { return (a[0] * a[0] + a[1] * a[1]) + (a[2] * a[2] + a[3] * a[3]); }
constexpr int MP = 16384;

struct EpiIn { static constexpr int ID = 1;
    static constexpr bool PERM = true, AFTER_DRAIN = false, MID = false;
    bf16_t *MQ, *MK, *MV, *MO, *FQ, *FK, *FV, *GA, *GB; float *kp, *ks, *vp, *vs; const float *g_qn, *g_kn; float c2;
    __device__ __forceinline__ void operator()(const f32x4 (&acc)[2][2][4][2], const Unit& u, int wr, int wc, int fr, int fq) const {
        asm volatile("" : "+v"(fr), "+v"(fq));
        const int pn = u.pn; const int row0 = u.pm * BM + wr * 64 + fr; const bool smp = u.pm >= MP / BM;
        if (pn >= 8 && pn < 12) {
            const bool isq = pn < 10; const float* g = isq ? g_qn : g_kn; const float post = isq ? c2 : 1.f;
            f32x4 gv[2][2];
#pragma unroll
            for (int bj = 0; bj < 2; ++bj)
#pragma unroll
                for (int n = 0; n < 2; ++n) gv[bj][n] = *(const PG8_GAS f32x4*)(g + 32 * bj + 8 * fq + 4 * n) * post;
            bf16_t* dst = isq ? FQ : FK; const int colb = (pn & 1) * 256 + 64 * wc + 8 * fq;
            float* ko = smp ? ks - (size_t)MP * 512 : kp;
#pragma unroll
            for (int ai = 0; ai < 2; ++ai)
#pragma unroll
                for (int m = 0; m < 4; ++m) { const size_t row = (size_t)(row0 + ai * HALF + m * 16);
                    float s = (dot4(acc[ai][0][m][0]) + dot4(acc[ai][0][m][1])) + (dot4(acc[ai][1][m][0]) + dot4(acc[ai][1][m][1]));
                    s += __shfl_xor(s, 16); s += __shfl_xor(s, 32);
                    const float r = rsqrtf(s * (1.0f / 64.0f) + EPSN);
#pragma unroll
                    for (int bj = 0; bj < 2; ++bj) { const f32x4 a = acc[ai][bj][m][0] * r * gv[bj][0], b = acc[ai][bj][m][1] * r * gv[bj][1];
                        st8bf(dst + row * 512 + colb + 32 * bj, a, b);
                        if (!isq) { float* o = ko + row * 512 + colb + 32 * bj; *(PG8_GAS f32x4*)o = a; *(PG8_GAS f32x4*)(o + 4) = b; } } }
        } else if (pn < 14) {
            const int seg = pn >> 1;
            bf16_t* dst = seg == 0 ? MQ : seg == 1 ? MK : seg == 2 ? MV : seg == 3 ? MO : FV;
            const float sc = seg == 1 ? 0.08838834764831845f : 1.f; const int colb = (pn & 1) * 256 + 32 * wc + 8 * fq;
            float* vo = smp ? vs - (size_t)MP * 512 : vp;
#pragma unroll
            for (int ai = 0; ai < 2; ++ai)
#pragma unroll
                for (int m = 0; m < 4; ++m) { const size_t row = (size_t)(row0 + ai * HALF + m * 16);
#pragma unroll
                    for (int bj = 0; bj < 2; ++bj) { f32x4 a = acc[ai][bj][m][0] * sc, b = acc[ai][bj][m][1] * sc;
                        if (seg == 3) { a = sigm4(a); b = sigm4(b); }
                        st8bf(dst + row * 512 + colb + 128 * bj, a, b);
                        if (seg == 6) { float* o = vo + row * 512 + colb + 128 * bj; *(PG8_GAS f32x4*)o = a; *(PG8_GAS f32x4*)(o + 4) = b; } } }
        } else {
            const int q = pn - 14; bf16_t* dst = q < 4 ? GA : GB; const int colb = (q & 3) * 256 + 32 * wc + 8 * fq;
#pragma unroll
            for (int ai = 0; ai < 2; ++ai)
#pragma unroll
                for (int m = 0; m < 4; ++m) { const size_t row = (size_t)(row0 + ai * HALF + m * 16);
#pragma unroll
                    for (int bj = 0; bj < 2; ++bj) st8bf(dst + row * 1024 + colb + 128 * bj, sigm4(acc[ai][bj][m][0]), sigm4(acc[ai][bj][m][1])); }
        }
    }
};
struct EpiMerge2 { static constexpr int ID = 2;
    static constexpr bool PERM = true, AFTER_DRAIN = false, MID = true;
    const bf16_t *GA, *GB; bf16_t* U;
    __device__ __forceinline__ void mid(f32x4 (&acc)[2][2][4][2], const Unit& u, int wr, int wc, int fr, int fq) const {
        asm volatile("" : "+v"(fr), "+v"(fq));
        const int row0 = u.pm * BM + wr * 64 + fr, colb = u.pn * BM + 32 * wc + 8 * fq;
#pragma unroll
        for (int ai = 0; ai < 2; ++ai)
#pragma unroll
            for (int m = 0; m < 4; ++m)
#pragma unroll
                for (int bj = 0; bj < 2; ++bj) { const size_t idx = (size_t)(row0 + ai * HALF + m * 16) * 1024 + colb + 128 * bj;
                    f32x4 ga0, ga1, gb0, gb1; ld8bf(GA + idx, ga0, ga1); ld8bf(GB + idx, gb0, gb1);
#pragma unroll
                    for (int v = 0; v < 4; ++v) { acc[ai][bj][m][0][v] *= ga0[v] * __builtin_amdgcn_rcpf(fmaxf(gb0[v], 1e-30f)); acc[ai][bj][m][1][v] *= ga1[v] * __builtin_amdgcn_rcpf(fmaxf(gb1[v], 1e-30f)); } }
    }
    __device__ __forceinline__ void operator()(const f32x4 (&acc)[2][2][4][2], const Unit& u, int wr, int wc, int fr, int fq) const {
        asm volatile("" : "+v"(fr), "+v"(fq));
        const int row0 = u.pm * BM + wr * 64 + fr, colb = u.pn * BM + 32 * wc + 8 * fq;
#pragma unroll
        for (int ai = 0; ai < 2; ++ai) { u32x4 gw[4][2];
#pragma unroll
            for (int m = 0; m < 4; ++m)
#pragma unroll
                for (int bj = 0; bj < 2; ++bj) gw[m][bj] = *(const PG8_GAS u32x4*)(GB + (size_t)(row0 + ai * HALF + m * 16) * 1024 + colb + 128 * bj);
#pragma unroll
            for (int m = 0; m < 4; ++m)
#pragma unroll
                for (int bj = 0; bj < 2; ++bj) { const size_t idx = (size_t)(row0 + ai * HALF + m * 16) * 1024 + colb + 128 * bj; const u32x4 w = gw[m][bj];
                    f32x4 gb0, gb1;
                    gb0[0] = __uint_as_float(w.x << 16); gb0[1] = __uint_as_float(w.x & 0xffff0000u); gb0[2] = __uint_as_float(w.y << 16); gb0[3] = __uint_as_float(w.y & 0xffff0000u);
                    gb1[0] = __uint_as_float(w.z << 16); gb1[1] = __uint_as_float(w.z & 0xffff0000u); gb1[2] = __uint_as_float(w.w << 16); gb1[3] = __uint_as_float(w.w & 0xffff0000u);
#pragma unroll
                    for (int v = 0; v < 4; ++v) { gb0[v] = fmaxf(gb0[v], 1e-30f); gb1[v] = fmaxf(gb1[v], 1e-30f); }
                    st8bf(U + idx, acc[ai][bj][m][0] * gb0, acc[ai][bj][m][1] * gb1); } }
    }
};
template <int BASE_BF16> struct EpiRes { static constexpr int ID = 3;
    static constexpr bool PERM = true, AFTER_DRAIN = false, MID = false;
    const void* base; bf16_t* An; float* ssq;
    __device__ __forceinline__ void operator()(const f32x4 (&acc)[2][2][4][2], const Unit& u, int wr, int wc, int fr, int fq) const {
        asm volatile("" : "+v"(fr), "+v"(fq));
        const int row0 = u.pm * BM + wr * 64 + fr, colb = u.pn * BM + 32 * wc + 8 * fq;
#pragma unroll
        for (int ai = 0; ai < 2; ++ai)
#pragma unroll
            for (int mh = 0; mh < 2; ++mh) { f32x4 ba[2][2], bb[2][2]; u32x4 bw[2][2];
#pragma unroll
                for (int mm = 0; mm < 2; ++mm)
#pragma unroll
                    for (int bj = 0; bj < 2; ++bj) { const size_t idx = (size_t)(row0 + ai * HALF + (2 * mh + mm) * 16) * 1024 + colb + 128 * bj;
                        if (BASE_BF16) bw[mm][bj] = *(const PG8_GAS u32x4*)((const bf16_t*)base + idx); else { ba[mm][bj] = *(const PG8_GAS f32x4*)((const float*)base + idx); bb[mm][bj] = *(const PG8_GAS f32x4*)((const float*)base + idx + 4); } }
#pragma unroll
                for (int mm = 0; mm < 2; ++mm) { const int m = 2 * mh + mm; const int row = row0 + ai * HALF + m * 16; float s = 0.f;
#pragma unroll
                    for (int bj = 0; bj < 2; ++bj) { const size_t idx = (size_t)row * 1024 + colb + 128 * bj; f32x4 a, b;
                        if (BASE_BF16) { const u32x4 w = bw[mm][bj];
                            a[0] = __uint_as_float(w.x << 16); a[1] = __uint_as_float(w.x & 0xffff0000u); a[2] = __uint_as_float(w.y << 16); a[3] = __uint_as_float(w.y & 0xffff0000u);
                            b[0] = __uint_as_float(w.z << 16); b[1] = __uint_as_float(w.z & 0xffff0000u); b[2] = __uint_as_float(w.w << 16); b[3] = __uint_as_float(w.w & 0xffff0000u); }
                        else { a = ba[mm][bj]; b = bb[mm][bj]; }
                        a += acc[ai][bj][m][0]; b += acc[ai][bj][m][1]; s += dot4(a) + dot4(b);
                        st8bf(An + idx, a, b); }
                    s += __shfl_xor(s, 16); s += __shfl_xor(s, 32);
                    if (fq == 0) *(PG8_GAS float*)(ssq + (size_t)row * 16 + u.pn * 4 + wc) = s; } }
    }
};
__device__ __forceinline__ float row_rstd(const float* ssq, int row) { const PG8_GAS f32x4* sp = (const PG8_GAS f32x4*)(ssq + (size_t)row * 16); const f32x4 t = (sp[0] + sp[1]) + (sp[2] + sp[3]);
    return rsqrtf(((t[0] + t[1]) + (t[2] + t[3])) * (1.0f / 1024.0f) + EPSN); }
__device__ __forceinline__ void row_rstd8(const float* ssq, int row0, int fq, float (&rs)[2][4]) {
    f32x4 t[2][4];
#pragma unroll
    for (int ai = 0; ai < 2; ++ai)
#pragma unroll
        for (int m = 0; m < 4; ++m) t[ai][m] = *(const PG8_GAS f32x4*)(ssq + (size_t)(row0 + ai * HALF + m * 16) * 16 + 4 * fq);
#pragma unroll
    for (int ai = 0; ai < 2; ++ai)
#pragma unroll
        for (int m = 0; m < 4; ++m) { float q = (t[ai][m][0] + t[ai][m][1]) + (t[ai][m][2] + t[ai][m][3]); q += __shfl_xor(q, 16); q += __shfl_xor(q, 32); rs[ai][m] = rsqrtf(q * (1.0f / 1024.0f) + EPSN); }
}
struct EpiGU { static constexpr int ID = 4;
    static constexpr bool PERM = true, AFTER_DRAIN = false, MID = false;
    const float* ssq; bf16_t* HB;
    __device__ __forceinline__ void operator()(const f32x4 (&acc)[2][2][4][2], const Unit& u, int wr, int wc, int fr, int fq) const {
        asm volatile("" : "+v"(fr), "+v"(fq));
        const int row0 = u.pm * BM + wr * 64 + fr, colb = u.pn * 128 + 32 * wc + 8 * fq;
        float rsv[2][4]; row_rstd8(ssq, row0, fq, rsv);
#pragma unroll
        for (int ai = 0; ai < 2; ++ai)
#pragma unroll
            for (int m = 0; m < 4; ++m) { const int row = row0 + ai * HALF + m * 16; const float rs = rsv[ai][m];
                f32x4 h[2];
#pragma unroll
                for (int n = 0; n < 2; ++n) { const f32x4 gg = acc[ai][0][m][n] * rs, uu = acc[ai][1][m][n] * rs; h[n] = gg * sigm4(gg) * uu; }
                st8bf(HB + (size_t)row * 2816 + colb, h[0], h[1]); }
    }
};
struct EpiStore { static constexpr int ID = 5;
    static constexpr bool PERM = true, AFTER_DRAIN = false, MID = false;
    bf16_t* O;
    __device__ __forceinline__ void operator()(const f32x4 (&acc)[2][2][4][2], const Unit& u, int wr, int wc, int fr, int fq) const {
        asm volatile("" : "+v"(fr), "+v"(fq));
        const int row0 = u.pm * BM + wr * 64 + fr, colb = u.pn * BM + 32 * wc + 8 * fq;
#pragma unroll
        for (int ai = 0; ai < 2; ++ai)
#pragma unroll
            for (int m = 0; m < 4; ++m)
#pragma unroll
                for (int bj = 0; bj < 2; ++bj) st8bf(O + (size_t)(row0 + ai * HALF + m * 16) * 1024 + colb + 128 * bj, acc[ai][bj][m][0], acc[ai][bj][m][1]);
    }
};
struct EpiPle { static constexpr int ID = 6;
    static constexpr bool PERM = true, AFTER_DRAIN = false, MID = false;
    const float* ssq; const bf16_t* TP; const bf16_t* X2; float* Y;
    __device__ __forceinline__ void operator()(const f32x4 (&acc)[2][2][4][2], const Unit& u, int wr, int wc, int fr, int fq) const {
        asm volatile("" : "+v"(fr), "+v"(fq));
        const int row0 = u.pm * BM + wr * 64 + fr, colb = u.pn * BM + 32 * wc + 8 * fq;
        float rsv[2][4]; row_rstd8(ssq, row0, fq, rsv);
#pragma unroll
        for (int ai = 0; ai < 2; ++ai)
#pragma unroll
            for (int mh = 0; mh < 2; ++mh) { u32x4 tw[2][2], xw[2][2];
#pragma unroll
                for (int mm = 0; mm < 2; ++mm)
#pragma unroll
                    for (int bj = 0; bj < 2; ++bj) { const size_t idx = (size_t)(row0 + ai * HALF + (2 * mh + mm) * 16) * 1024 + colb + 128 * bj;
                        tw[mm][bj] = *(const PG8_GAS u32x4*)(TP + idx); xw[mm][bj] = *(const PG8_GAS u32x4*)(X2 + idx); }
#pragma unroll
                for (int mm = 0; mm < 2; ++mm) { const int m = 2 * mh + mm; const int row = row0 + ai * HALF + m * 16; const float rs = rsv[ai][m];
#pragma unroll
                    for (int bj = 0; bj < 2; ++bj) { const size_t idx = (size_t)row * 1024 + colb + 128 * bj; f32x4 ta, tb, xa, xb; const u32x4 w = tw[mm][bj], x = xw[mm][bj];
                        ta[0] = __uint_as_float(w.x << 16); ta[1] = __uint_as_float(w.x & 0xffff0000u); ta[2] = __uint_as_float(w.y << 16); ta[3] = __uint_as_float(w.y & 0xffff0000u);
                        tb[0] = __uint_as_float(w.z << 16); tb[1] = __uint_as_float(w.z & 0xffff0000u); tb[2] = __uint_as_float(w.w << 16); tb[3] = __uint_as_float(w.w & 0xffff0000u);
                        xa[0] = __uint_as_float(x.x << 16); xa[1] = __uint_as_float(x.x & 0xffff0000u); xa[2] = __uint_as_float(x.y << 16); xa[3] = __uint_as_float(x.y & 0xffff0000u);
                        xb[0] = __uint_as_float(x.z << 16); xb[1] = __uint_as_float(x.z & 0xffff0000u); xb[2] = __uint_as_float(x.w << 16); xb[3] = __uint_as_float(x.w & 0xffff0000u);
                        *(PG8_GAS f32x4*)(Y + idx) = xa + sigm4(acc[ai][bj][m][0] * rs) * ta; *(PG8_GAS f32x4*)(Y + idx + 4) = xb + sigm4(acc[ai][bj][m][1] * rs) * tb; } } }
    }
};
template <class Epi, class Sched, bool ALIGN_EPI = false, bool SP2 = false>
__device__ __forceinline__ void gemm_phase(PG8_LAS unsigned char* lds, const Gemm g, const Sched& S, const Epi& E) {
    int tid_ = threadIdx.x; asm volatile("" : "+v"(tid_));
    const int tid = tid_, wid = __builtin_amdgcn_readfirstlane(tid >> 6), lane = tid & 63, wr = wid >> 2, wc = wid & 3, fr = lane & 15, fq = lane >> 4;
    int K_ = g.K; asm volatile("" : "+s"(K_));
    const int K = K_, nt = K / BK;
    unsigned voffA[2], voffB[2];
#pragma unroll
    for (int i = 0; i < 2; ++i) { int R, C; stage_rc(tid * 16 + i * 8192, R, C); const int Rb = Epi::PERM ? ((R & ~31) + perm32(R & 31)) : R;
        voffA[i] = (unsigned)(R * K + C) * 2u; voffB[i] = (unsigned)(Rb * K + C) * 2u; }
    const size_t kstep = (size_t)(BK * 2);
    const size_t hstep = (size_t)HALF * K * 2;
    const size_t tstep = 2 * hstep;
    const unsigned ldsw = (unsigned)wid * 1024u;
    const int aoff = lds_byte(wr * 64 + fr, fq * 8), boff = lds_byte(wc * 32 + fr, fq * 8);
#define PG8_SA(b, h) (((b) * 2 + (h)) * HTB)
#define PG8_SB(b, h) ((4 + (b) * 2 + (h)) * HTB)
#define PG8_STAGE(bufoff, gbase, voff) do { _Pragma("unroll") for (int _i = 0; _i < 2; ++_i) \
        __builtin_amdgcn_global_load_lds((const unsigned*)((const char*)(gbase) + (voff)[_i]), (PG8_LAS unsigned*)(lds + (bufoff) + ldsw + _i * 8192), 16, 0, 0); } while (0)
#define PG8_LDA(dst, b, h) do { _Pragma("unroll") for (int m = 0; m < 4; ++m) _Pragma("unroll") for (int k = 0; k < 2; ++k) dst[m][k] = *(const PG8_LAS bf16x8*)(lds + PG8_SA(b, h) + aoff + m * 2048 + k * 1024); } while (0)
#define PG8_LDB(dst, b, h) do { _Pragma("unroll") for (int n = 0; n < 2; ++n) _Pragma("unroll") for (int k = 0; k < 2; ++k) dst[n][k] = *(const PG8_LAS bf16x8*)(lds + PG8_SB(b, h) + boff + n * 2048 + k * 1024); } while (0)
#define PG8_MMA(ai, bj, At, Bt) do { __builtin_amdgcn_s_setprio(1); _Pragma("unroll") for (int m = 0; m < 4; ++m) _Pragma("unroll") for (int n = 0; n < 2; ++n) _Pragma("unroll") for (int k = 0; k < 2; ++k) \
        acc[ai][bj][m][n] = __builtin_amdgcn_mfma_f32_16x16x32_bf16(Bt[n][k], At[m][k], acc[ai][bj][m][n], 0, 0, 0); __builtin_amdgcn_s_setprio(0); } while (0)
#define PG8_WAIT_V(n) asm volatile("s_waitcnt vmcnt(" #n ")" ::: "memory")
#define PG8_WAIT_L(n) asm volatile("s_waitcnt lgkmcnt(" #n ")" ::: "memory")
#define PG8_BAR __builtin_amdgcn_s_barrier()
#define PG8_SCHED __builtin_amdgcn_sched_barrier(0)
    Unit cur, nxt; int ui = 0;
    if (!S.next(0, cur)) return;
    f32x4 acc[2][2][4][2];
#pragma unroll
    for (int a = 0; a < 2; ++a)
#pragma unroll
        for (int b = 0; b < 2; ++b)
#pragma unroll
            for (int m = 0; m < 4; ++m)
#pragma unroll
                for (int n = 0; n < 2; ++n) acc[a][b][m][n] = (f32x4){0.f, 0.f, 0.f, 0.f};
    bf16x8 At[4][2], B0[2][2], B1[2][2];
    const char* cA = (const char*)g.A + (size_t)cur.pm * tstep; const char* cB = (const char*)g.Bt + (size_t)cur.pn * tstep;
    S.a_ready(cur);
    if constexpr (SP2) {
        PG8_STAGE(PG8_SB(0, 0), cB, voffB); PG8_STAGE(PG8_SB(0, 1), cB + hstep, voffB); PG8_STAGE(PG8_SA(0, 0), cA, voffA); PG8_STAGE(PG8_SA(0, 1), cA + hstep, voffA);
        if (wr == 1) PG8_BAR;
        PG8_WAIT_V(2); PG8_BAR;
        PG8_STAGE(PG8_SB(1, 0), cB + kstep, voffB); PG8_STAGE(PG8_SA(1, 0), cA + kstep, voffA); PG8_STAGE(PG8_SB(1, 1), cB + hstep + kstep, voffB);
        PG8_WAIT_V(6); PG8_BAR;
    } else {
        PG8_STAGE(PG8_SB(0, 0), cB, voffB); PG8_STAGE(PG8_SA(0, 0), cA, voffA); PG8_STAGE(PG8_SB(0, 1), cB + hstep, voffB); PG8_STAGE(PG8_SA(0, 1), cA + hstep, voffA);
        if (wr == 1) PG8_BAR;
        PG8_WAIT_V(4); PG8_BAR;
        PG8_STAGE(PG8_SB(1, 0), cB + kstep, voffB); PG8_STAGE(PG8_SA(1, 0), cA + kstep, voffA); PG8_STAGE(PG8_SB(1, 1), cB + hstep + kstep, voffB);
        PG8_WAIT_V(6); PG8_BAR;
    }
    for (;;) {
        const bool has_next = S.next(ui + 1, nxt);
        const char* nA = has_next ? (const char*)g.A + (size_t)nxt.pm * tstep : cA; const char* nB = has_next ? (const char*)g.Bt + (size_t)nxt.pn * tstep : cB;
        for (int t = 0; t < nt; t += 2) {
            if constexpr (Epi::MID) { if (t == (nt >> 1)) E.mid(acc, cur, wr, wc, fr, fq); }
            const bool last = (t == nt - 2);
            const char* a1 = cA + (size_t)(t + 1) * kstep;
            const char* a2 = last ? nA : cA + (size_t)(t + 2) * kstep; const char* b2 = last ? nB : cB + (size_t)(t + 2) * kstep;
            const char* a3 = a2 + kstep; const char* b3 = b2 + kstep;
            if (last && has_next) S.a_ready(nxt);
            if constexpr (SP2) {
            PG8_LDB(B0, 0, 0); PG8_LDB(B1, 0, 1); PG8_SCHED; PG8_LDA(At, 0, 0); PG8_STAGE(PG8_SA(1, 1), a1 + hstep, voffA);
            PG8_WAIT_V(8); PG8_WAIT_L(0); PG8_BAR; PG8_MMA(0, 0, At, B0); PG8_MMA(0, 1, At, B1); PG8_BAR; PG8_SCHED;
            PG8_LDA(At, 0, 1); PG8_STAGE(PG8_SB(0, 0), b2, voffB); PG8_STAGE(PG8_SB(0, 1), b2 + hstep, voffB); PG8_STAGE(PG8_SA(0, 0), a2, voffA);
            PG8_WAIT_V(8); PG8_WAIT_L(0); PG8_BAR; PG8_MMA(1, 0, At, B0); PG8_MMA(1, 1, At, B1); PG8_BAR; PG8_SCHED;
            PG8_LDB(B0, 1, 0); PG8_LDB(B1, 1, 1); PG8_SCHED; PG8_LDA(At, 1, 0); PG8_STAGE(PG8_SA(0, 1), a2 + hstep, voffA);
            PG8_WAIT_V(8); PG8_WAIT_L(0); PG8_BAR; PG8_MMA(0, 0, At, B0); PG8_MMA(0, 1, At, B1); PG8_BAR; PG8_SCHED;
            PG8_LDA(At, 1, 1); PG8_STAGE(PG8_SB(1, 0), b3, voffB); PG8_STAGE(PG8_SB(1, 1), b3 + hstep, voffB); PG8_STAGE(PG8_SA(1, 0), a3, voffA);
            PG8_WAIT_V(8); PG8_WAIT_L(0); PG8_BAR; PG8_MMA(1, 0, At, B0); PG8_MMA(1, 1, At, B1); PG8_BAR; PG8_SCHED;
            } else {
            PG8_LDB(B0, 0, 0); PG8_SCHED; PG8_LDA(At, 0, 0); PG8_STAGE(PG8_SA(1, 1), a1 + hstep, voffA);
            PG8_WAIT_L(8); PG8_BAR; PG8_WAIT_L(0); PG8_MMA(0, 0, At, B0); PG8_BAR; PG8_SCHED;
            PG8_LDB(B1, 0, 1); PG8_STAGE(PG8_SB(0, 0), b2, voffB);
            PG8_BAR; PG8_WAIT_L(0); PG8_MMA(0, 1, At, B1); PG8_BAR;
            PG8_LDA(At, 0, 1); PG8_STAGE(PG8_SA(0, 0), a2, voffA);
            PG8_BAR; PG8_WAIT_L(0); PG8_MMA(1, 0, At, B0); PG8_BAR; PG8_SCHED;
            PG8_STAGE(PG8_SB(0, 1), b2 + hstep, voffB);
            PG8_WAIT_V(6); PG8_BAR; PG8_MMA(1, 1, At, B1); PG8_BAR;
            PG8_LDB(B0, 1, 0); PG8_SCHED; PG8_LDA(At, 1, 0); PG8_STAGE(PG8_SA(0, 1), a2 + hstep, voffA);
            PG8_WAIT_L(8); PG8_BAR; PG8_WAIT_L(0); PG8_MMA(0, 0, At, B0); PG8_BAR; PG8_SCHED;
            PG8_LDB(B1, 1, 1); PG8_STAGE(PG8_SB(1, 0), b3, voffB);
            PG8_BAR; PG8_WAIT_L(0); PG8_MMA(0, 1, At, B1); PG8_BAR;
            PG8_LDA(At, 1, 1); PG8_STAGE(PG8_SA(1, 0), a3, voffA);
            PG8_BAR; PG8_WAIT_L(0); PG8_MMA(1, 0, At, B0); PG8_BAR; PG8_SCHED;
            PG8_STAGE(PG8_SB(1, 1), b3 + hstep, voffB);
            PG8_WAIT_V(6); PG8_BAR; PG8_MMA(1, 1, At, B1); PG8_BAR;
            }
        }
        if constexpr (ALIGN_EPI) { if (wr == 0) PG8_BAR; }
#ifdef DUP_EPI
        if constexpr (Epi::ID == DUP_EPI) { E(acc, cur, wr, wc, fr, fq); asm volatile("" ::: "memory"); }
#endif
        if constexpr (!Epi::AFTER_DRAIN) { E(acc, cur, wr, wc, fr, fq); S.done(cur); }
        if (!has_next) break;
#pragma unroll
        for (int a = 0; a < 2; ++a)
#pragma unroll
            for (int b = 0; b < 2; ++b)
#pragma unroll
                for (int m = 0; m < 4; ++m)
#pragma unroll
                    for (int n = 0; n < 2; ++n) acc[a][b][m][n] = (f32x4){0.f, 0.f, 0.f, 0.f};
        cur = nxt; cA = nA; cB = nB; ++ui;
        if constexpr (ALIGN_EPI) { if (wr == 1) PG8_BAR; }
    }
    PG8_WAIT_V(0);
    if constexpr (!ALIGN_EPI) { if (wr == 0) PG8_BAR; }
    PG8_BAR;
    if constexpr (Epi::AFTER_DRAIN) { E.fused(acc, cur, wr, wc, fr, fq, lds, wid, lane); S.done(cur); }
#undef PG8_SA
#undef PG8_SB
#undef PG8_STAGE
#undef PG8_LDA
#undef PG8_LDB
#undef PG8_MMA
#undef PG8_WAIT_V
#undef PG8_WAIT_L
#undef PG8_BAR
#undef PG8_SCHED
}
}
namespace attn_body {
using bf16=__hip_bfloat16;
using bf16x8=__attribute__((ext_vector_type(8)))short;
using s16x4=__attribute__((ext_vector_type(4)))short;
using f32x16=__attribute__((ext_vector_type(16)))float;
using u32x4=__attribute__((ext_vector_type(4)))unsigned;
constexpr int BATCH=4,NHEAD=8,SEQ=4096,D=64,DM=NHEAD*D;
constexpr int NW=8,QBLK=32,QB=QBLK*NW,KVBLK=64,NQB=SEQ/QB;
constexpr int ATTN_PITCH=DM, ATTN_UNIT_ROWS=QB, OPITCH=1024;
__device__ __forceinline__ int crow(int r,int hi){return (r&3)+8*(r>>2)+4*hi;}
#define SBAR() __builtin_amdgcn_sched_barrier(0)
__device__ __forceinline__ void cmask(f32x16&p0,f32x16&p1,int jb,int qrel,int hi){
  const float NEG=-INFINITY; int kb=64*jb+4*hi;
  #pragma unroll
  for(int r=0;r<16;++r){int kv=kb+(r&3)+8*(r>>2); if(kv>qrel)p0[r]=NEG; if(kv+32>qrel)p1[r]=NEG;}
}

constexpr int NSLOT=3, SLOTB=8192;
constexpr int LDS_K=0, LDS_V=NSLOT*SLOTB, LDS_WS=2*NSLOT*SLOTB, LDS_OST=LDS_WS+NW*64*4, LDS_BYTES=LDS_OST+NW*4096;
constexpr int LDS_TB=86016, LDS_F2=102400, LDS_BYTES_X=118784;
constexpr float C2=0.125f*1.4426950408889634f;
__device__ __forceinline__ void glds16(const void*gsrc,unsigned lds_dst){unsigned keep;
  asm volatile("s_mov_b32 %0, m0\n\ts_mov_b32 m0, %2\n\ts_nop 0\n\tglobal_load_lds_dwordx4 %1, off\n\ts_mov_b32 m0, %0":"=&s"(keep):"v"(gsrc),"s"(lds_dst):"memory");}
__device__ __forceinline__ float max3f(float a,float b,float c){float r;asm("v_max3_f32 %0, %1, %2, %3":"=v"(r):"v"(a),"v"(b),"v"(c));return r;}
__device__ __forceinline__ float max2f(float a,float b){float r;asm("v_max_f32_e32 %0, %1, %2":"=v"(r):"v"(a),"v"(b));return r;}
__device__ __forceinline__ float fadd_s(float a,float b){float r;asm("v_add_f32_e32 %0, %1, %2":"=v"(r):"v"(a),"v"(b));return r;}
__device__ __forceinline__ float fsub_s(float a,float b){float r;asm("v_sub_f32_e32 %0, %1, %2":"=v"(r):"v"(a),"v"(b));return r;}
typedef float f32x4_t __attribute__((ext_vector_type(4))); typedef float f32x2_t __attribute__((ext_vector_type(2))); typedef __bf16 bf16x2_t __attribute__((ext_vector_type(2)));
__device__ __forceinline__ unsigned cvtpk_s(float lo,float hi){f32x2_t v={lo,hi};bf16x2_t b=__builtin_convertvector(v,bf16x2_t);return __builtin_bit_cast(unsigned,b);}
#define WAIT_BAR(N) asm volatile("s_waitcnt vmcnt(" #N ") lgkmcnt(0)\n\ts_barrier":::"memory")

__device__ __forceinline__ void qkt(f32x16&p0,f32x16&p1,const char*Kslot,const bf16x8*qr,const f32x16&negm,int r32,int hi){
  const char*kb=Kslot+hi*1024+r32*16;
  #pragma unroll
  for(int d0=0;d0<4;++d0){
    const bf16x8 b0=*reinterpret_cast<const bf16x8*>(kb+d0*2048);
    const bf16x8 b1=*reinterpret_cast<const bf16x8*>(kb+d0*2048+512);
    if(d0==0){p0=__builtin_amdgcn_mfma_f32_32x32x16_bf16(b0,qr[0],negm,0,0,0);p1=__builtin_amdgcn_mfma_f32_32x32x16_bf16(b1,qr[0],negm,0,0,0);}
    else{p0=__builtin_amdgcn_mfma_f32_32x32x16_bf16(b0,qr[d0],p0,0,0,0);p1=__builtin_amdgcn_mfma_f32_32x32x16_bf16(b1,qr[d0],p1,0,0,0);}}
}
typedef __attribute__((address_space(3))) const char* lds_cptr;
typedef short v4i16_t __attribute__((ext_vector_type(4)));
__device__ __forceinline__ void kload8(bf16x8*kf,lds_cptr kp){
  kf[0]=*(const __attribute__((address_space(3))) bf16x8*)(kp);      kf[1]=*(const __attribute__((address_space(3))) bf16x8*)(kp+512);
  kf[2]=*(const __attribute__((address_space(3))) bf16x8*)(kp+2048); kf[3]=*(const __attribute__((address_space(3))) bf16x8*)(kp+2560);
  kf[4]=*(const __attribute__((address_space(3))) bf16x8*)(kp+4096); kf[5]=*(const __attribute__((address_space(3))) bf16x8*)(kp+4608);
  kf[6]=*(const __attribute__((address_space(3))) bf16x8*)(kp+6144); kf[7]=*(const __attribute__((address_space(3))) bf16x8*)(kp+6656);
}
__device__ __forceinline__ void kload2(bf16x8*kf,lds_cptr kp,int j){ kf[2*j]=*(const __attribute__((address_space(3))) bf16x8*)(kp+j*2048); kf[2*j+1]=*(const __attribute__((address_space(3))) bf16x8*)(kp+j*2048+512); }
__device__ __forceinline__ s16x4 vtr(lds_cptr p){ return __builtin_bit_cast(s16x4,__builtin_amdgcn_ds_read_tr16_b64_v4i16((__attribute__((address_space(3))) v4i16_t*)p)); }
__device__ __forceinline__ float rowmax(const f32x16&p0,const f32x16&p1){
  float a=max3f(p0[0],p0[1],p1[0]),b=max3f(p0[2],p0[3],p1[1]);a=max3f(a,p1[2],p1[3]);
  #pragma unroll
  for(int r=4;r<16;r+=4){a=max3f(a,p0[r],p0[r+1]);b=max3f(b,p0[r+2],p0[r+3]);a=max3f(a,p1[r],p1[r+1]);b=max3f(b,p1[r+2],p1[r+3]);}
  const float m=max2f(a,b);
  auto rr=__builtin_amdgcn_permlane32_swap(__float_as_uint(m),__float_as_uint(m),false,false);
  return max2f(__uint_as_float(rr[0]),__uint_as_float(rr[1]));
}
__device__ __forceinline__ void pv(f32x16*o,int vb,bf16x8 pa0,bf16x8 pa1,bf16x8 pa2,bf16x8 pa3){
  #pragma unroll
  for(int d0=0;d0<2;++d0){s16x4 lo[4],hi[4];
    #pragma unroll
    for(int ks=0;ks<4;++ks){
      asm volatile("ds_read_b64_tr_b16 %0,%1 offset:%c2":"=&v"(lo[ks]):"v"(vb),"i"(d0*4096+ks*1024):"memory");
      asm volatile("ds_read_b64_tr_b16 %0,%1 offset:%c2":"=&v"(hi[ks]):"v"(vb),"i"(d0*4096+ks*1024+512):"memory");}
    asm volatile("s_waitcnt lgkmcnt(0)":::"memory");SBAR();
    #define PK(k) (bf16x8){lo[k][0],lo[k][1],lo[k][2],lo[k][3],hi[k][0],hi[k][1],hi[k][2],hi[k][3]}
    o[d0]=__builtin_amdgcn_mfma_f32_32x32x16_bf16(pa0,PK(0),o[d0],0,0,0);
    o[d0]=__builtin_amdgcn_mfma_f32_32x32x16_bf16(pa1,PK(1),o[d0],0,0,0);
    o[d0]=__builtin_amdgcn_mfma_f32_32x32x16_bf16(pa2,PK(2),o[d0],0,0,0);
    o[d0]=__builtin_amdgcn_mfma_f32_32x32x16_bf16(pa3,PK(3),o[d0],0,0,0);
    #undef PK
  }
}

#ifndef ATTN_STORE16
#define ATTN_STORE16(p,v) (*(u32x4*)(p)=(v))
#endif
template<int THRL> __device__ __forceinline__ void attn_unit(int b,int h,int qb,int t0,const bf16*Q,const bf16*__restrict__ K,const bf16*__restrict__ V,bf16*O,char*shm){
  int tid_=threadIdx.x; asm volatile("":"+v"(tid_)); const int tid=tid_,lane=tid&63,r32=lane&31,hi=lane>>5; const int wid=__builtin_amdgcn_readfirstlane(tid>>6);
  const long rowbase=(long)b*SEQ; const int q0=qb*QB;
  const bf16*Qw=Q+(rowbase+q0+wid*QBLK)*DM+h*D;
  const bf16*Kh=K+(rowbase+(long)t0*KVBLK)*DM+h*D,*Vh=V+(rowbase+(long)t0*KVBLK)*DM+h*D;
  const unsigned lds0=(unsigned)(uintptr_t)shm;
  float*wsf=(float*)(shm+LDS_WS)+wid*64;
  typedef __attribute__((address_space(3))) float lds_f32; typedef __attribute__((address_space(3))) const f32x4_t lds_cf4;
  const lds_f32*tbp=(const lds_f32*)(shm+LDS_F2)+4*hi+64*t0;
  #define TBADD(C0,C1,t) do{ const lds_cf4*tq_=(const lds_cf4*)(tbp+64*(t)); \
    { const f32x4_t a0_=tq_[0],a1_=tq_[2],a2_=tq_[4],a3_=tq_[6]; _Pragma("unroll") for(int v_=0;v_<4;++v_){C0[v_]+=a0_[v_];C0[4+v_]+=a1_[v_];C0[8+v_]+=a2_[v_];C0[12+v_]+=a3_[v_];} } \
    { const f32x4_t a0_=tq_[8],a1_=tq_[10],a2_=tq_[12],a3_=tq_[14]; _Pragma("unroll") for(int v_=0;v_<4;++v_){C1[v_]+=a0_[v_];C1[4+v_]+=a1_[v_];C1[8+v_]+=a2_[v_];C1[12+v_]+=a3_[v_];} } }while(0)
  const bf16*ksrc=Kh+(long)lane*DM+wid*8;
  const bf16*vsrc=Vh+(long)(16*(wid&3)+(lane>>2))*DM+(wid>>2)*32+(lane&3)*8;
  const unsigned kdst=lds0+LDS_K+wid*1024, vdst=lds0+LDS_V+wid*1024;
  #define DMA_K(t,slot) glds16(ksrc+(long)(t)*KVBLK*DM,(unsigned)__builtin_amdgcn_readfirstlane(kdst+(slot)))
  #define DMA_V(t,slot) glds16(vsrc+(long)(t)*KVBLK*DM,(unsigned)__builtin_amdgcn_readfirstlane(vdst+(slot)))
  const int vb0=(int)(lds0+LDS_V)+((lane>>4)&1)*32+(lane&3)*8+(4*hi+((lane&15)>>2))*64;
  const char*Kbase=shm+LDS_K; bf16x8 kf[8];
  const lds_cptr shm3=(lds_cptr)shm; const lds_cptr kp0=shm3+LDS_K+hi*1024+r32*16; const lds_cptr vp0=shm3+LDS_V+((lane>>4)&1)*32+(lane&3)*8+(4*hi+((lane&15)>>2))*64;
  const int NT=(q0+QB)/KVBLK-t0;
  DMA_K(0,0);DMA_V(0,0);DMA_K(1,SLOTB);
  bf16x8 qr[4];
  #pragma unroll
  for(int d0=0;d0<4;++d0)qr[d0]=*reinterpret_cast<const bf16x8*>(&Qw[(long)r32*DM+d0*16+hi*8]);
  float zero_;asm volatile("v_mov_b32 %0, 0":"=v"(zero_));
  float mhat=zero_,l_reg=zero_;f32x16 o[2],negm;
  _Pragma("unroll") for(int r=0;r<16;++r){o[0][r]=zero_;o[1][r]=zero_;negm[r]=zero_;} asm volatile("":"+v"(negm));
  const int qrel=wid*QBLK+r32;
  #define CMASK(P0,P1,t) do{int jb_=(t)-(NT-4); if(jb_>=0)cmask(P0,P1,jb_,qrel,hi);}while(0)
  bool resc=false;
  #define START(P0,P1) do{ const float rm=rowmax(P0,P1); resc=false; \
    { const float dl=rm; mhat=fadd_s(mhat,dl); \
      _Pragma("unroll") for(int r=0;r<16;++r){P0[r]=fsub_s(P0[r],dl);P1[r]=fsub_s(P1[r],dl);} \
      _Pragma("unroll") for(int r=0;r<16;++r)negm[r]=-mhat; asm volatile("":"+v"(negm)); } \
    _Pragma("unroll") for(int r=0;r<16;++r)P0[r]=__builtin_amdgcn_exp2f(P0[r]); }while(0)
  #define RESC() do{ if(resc){ asm volatile("s_waitcnt lgkmcnt(0)":::"memory"); \
      _Pragma("unroll") for(int d_=0;d_<2;++d_) _Pragma("unroll") for(int r=0;r<16;++r)o[d_][r]*=wsf[crow(r,hi)]; } }while(0)
  f32x16 pA0,pA1,pB0,pB1;
  int sl_prev=0,sl_cur=0,sl_next=SLOTB;
  #define ROT() do{sl_prev=sl_cur;sl_cur=sl_next;sl_next=(sl_next==(NSLOT-1)*SLOTB)?0:sl_next+SLOTB;}while(0)
  DMA_K(2,2*SLOTB);
  WAIT_BAR(3);
  qkt(pA0,pA1,Kbase,qr,negm,r32,hi);asm volatile("s_nop 15\n\ts_nop 7":"+v"(pA0),"+v"(pA1));TBADD(pA0,pA1,0);CMASK(pA0,pA1,0);
  START(pA0,pA1);
  _Pragma("unroll") for(int r=0;r<16;++r)pA1[r]=__builtin_amdgcn_exp2f(pA1[r]);
  WAIT_BAR(0);
  DMA_K(3,0);DMA_V(1,SLOTB);
  ROT();
  kload8(kf,kp0+sl_cur);
  WAIT_BAR(2);
  s16x4 vlo[8],vhi[8]; u32x4 pw0,pw1,pw2,pw3;
  #define PKW(P,B) cvtpk_s(P[B],P[B+1])
  #define PAF(k) __builtin_bit_cast(bf16x8,pw##k)
  #define VFR(i) (bf16x8){vlo[i][0],vlo[i][1],vlo[i][2],vlo[i][3],vhi[i][0],vhi[i][1],vhi[i][2],vhi[i][3]}
  #define PIN(x) asm volatile("":"+v"(x))
  #define MX3(a,b,c) __builtin_fmaxf(__builtin_fmaxf((a),(b)),(c))
  #define GAPA(MF,A0,A1,A2,A3,W0,W1,PW) do{ MF; sacc+=A0; sacc+=A1; sacc+=A2; sacc+=A3; PIN(sacc); W0; W1; PIN(PW); SBAR(); }while(0)
  #define EX(v) __builtin_amdgcn_exp2f(v)
  #define GAPB(MF,X,B) do{ MF; X[B]=EX(X[B]); X[B+1]=EX(X[B+1]); X[B+2]=EX(X[B+2]); X[B+3]=EX(X[B+3]); PIN(X); SBAR(); }while(0)
  #define VRD(i) do{ vlo[i]=vtr(vp_+(((i)>>2)*4096+((i)&3)*1024)); vhi[i]=vtr(vp_+(((i)>>2)*4096+((i)&3)*1024+512)); }while(0)
  #define KRD(G,j) do{ if(G){ kload2(kf,kp0+sl_next,j); SBAR(); } }while(0)
  #define STEP(C0,C1,P0,P1,t,GK,GV,GL) do{ SBAR(); \
    const lds_cptr vp_=vp0+sl_prev; \
    VRD(0); SBAR(); float sacc=(P0[0]+P0[1]); \
    GAPA(C0=__builtin_amdgcn_mfma_f32_32x32x16_bf16(kf[0],qr[0],negm,0,0,0), P0[2],P0[3],P0[4],P0[5],     pw0[0]=PKW(P0,0), pw0[1]=PKW(P0,2), pw0); \
    VRD(4); SBAR(); GAPA(C1=__builtin_amdgcn_mfma_f32_32x32x16_bf16(kf[1],qr[0],negm,0,0,0), P0[6],P0[7],P0[8],P0[9],     pw0[2]=PKW(P0,4), pw0[3]=PKW(P0,6), pw0); \
    VRD(1); SBAR(); GAPA(C0=__builtin_amdgcn_mfma_f32_32x32x16_bf16(kf[2],qr[1],C0,0,0,0),   P0[10],P0[11],P0[12],P0[13], pw1[0]=PKW(P0,8), pw1[1]=PKW(P0,10), pw1); \
    VRD(5); SBAR(); GAPA(C1=__builtin_amdgcn_mfma_f32_32x32x16_bf16(kf[3],qr[1],C1,0,0,0),   P0[14],P0[15],P1[0],P1[1],   pw1[2]=PKW(P0,12),pw1[3]=PKW(P0,14), pw1); \
    VRD(2); SBAR(); GAPA(C0=__builtin_amdgcn_mfma_f32_32x32x16_bf16(kf[4],qr[2],C0,0,0,0),   P1[2],P1[3],P1[4],P1[5],     pw2[0]=PKW(P1,0), pw2[1]=PKW(P1,2), pw2); \
    VRD(6); SBAR(); GAPA(C1=__builtin_amdgcn_mfma_f32_32x32x16_bf16(kf[5],qr[2],C1,0,0,0),   P1[6],P1[7],P1[8],P1[9],     pw2[2]=PKW(P1,4), pw2[3]=PKW(P1,6), pw2); \
    VRD(3); SBAR(); GAPA(C0=__builtin_amdgcn_mfma_f32_32x32x16_bf16(kf[6],qr[3],C0,0,0,0),   P1[10],P1[11],P1[12],P1[13], pw3[0]=PKW(P1,8), pw3[1]=PKW(P1,10), pw3); \
    VRD(7); SBAR(); GAPA(C1=__builtin_amdgcn_mfma_f32_32x32x16_bf16(kf[7],qr[3],C1,0,0,0),   P1[14],P1[15],0.f,0.f,       pw3[2]=PKW(P1,12),pw3[3]=PKW(P1,14), pw3); \
    l_reg+=sacc; \
    if(GK){DMA_K((t)+3,sl_cur);} if(GV){DMA_V((t)+1,sl_next);} \
    TBADD(C0,C1,t); CMASK(C0,C1,t); \
    { float a=MX3(C0[0],C0[1],C1[0]),b=MX3(C0[2],C0[3],C1[1]); a=MX3(a,C1[2],C1[3]); \
      _Pragma("unroll") for(int r=4;r<16;r+=4){a=MX3(a,C0[r],C0[r+1]);b=MX3(b,C0[r+2],C0[r+3]);a=MX3(a,C1[r],C1[r+1]);b=MX3(b,C1[r+2],C1[r+3]);} \
      float rm=__builtin_fmaxf(a,b); { auto rr=__builtin_amdgcn_permlane32_swap(__float_as_uint(rm),__float_as_uint(rm),false,false); rm=__builtin_fmaxf(__uint_as_float(rr[0]),__uint_as_float(rr[1])); } \
      resc=false; \
      if(__builtin_expect(__any(rm>(float)THRL),0)){ const float dl=__builtin_fmaxf(rm,0.f); mhat+=dl; \
        _Pragma("unroll") for(int r=0;r<16;++r){C0[r]-=dl;C1[r]-=dl;} \
        _Pragma("unroll") for(int r=0;r<16;++r)negm[r]=-mhat; asm volatile("":"+v"(negm)); \
        const float f=__builtin_amdgcn_exp2f(-dl); l_reg*=f; if(hi==0)wsf[r32]=f; resc=true; } } \
    SBAR(); \
    GAPB(o[0]=__builtin_amdgcn_mfma_f32_32x32x16_bf16(PAF(0),VFR(0),o[0],0,0,0), C0,0); \
    GAPB(o[1]=__builtin_amdgcn_mfma_f32_32x32x16_bf16(PAF(0),VFR(4),o[1],0,0,0), C0,4); \
    KRD(GL,0); GAPB(o[0]=__builtin_amdgcn_mfma_f32_32x32x16_bf16(PAF(1),VFR(1),o[0],0,0,0), C0,8); \
    KRD(GL,1); GAPB(o[1]=__builtin_amdgcn_mfma_f32_32x32x16_bf16(PAF(1),VFR(5),o[1],0,0,0), C0,12); \
    KRD(GL,2); GAPB(o[0]=__builtin_amdgcn_mfma_f32_32x32x16_bf16(PAF(2),VFR(2),o[0],0,0,0), C1,0); \
    KRD(GL,3); GAPB(o[1]=__builtin_amdgcn_mfma_f32_32x32x16_bf16(PAF(2),VFR(6),o[1],0,0,0), C1,4); \
    GAPB(o[0]=__builtin_amdgcn_mfma_f32_32x32x16_bf16(PAF(3),VFR(3),o[0],0,0,0), C1,8); \
    GAPB(o[1]=__builtin_amdgcn_mfma_f32_32x32x16_bf16(PAF(3),VFR(7),o[1],0,0,0), C1,12); \
    }while(0)
  int t=1;
  #undef CMASK
  #define CMASK(P0,P1,t) do{}while(0)
  for(;t+5<NT;t+=2){
    STEP(pB0,pB1,pA0,pA1,t,true,true,true);     WAIT_BAR(2); RESC(); ROT();
    STEP(pA0,pA1,pB0,pB1,t+1,true,true,true);   WAIT_BAR(2); RESC(); ROT();
  }
  #undef CMASK
  #define CMASK(P0,P1,t) do{int jb_=(t)-(NT-4); if(jb_>=0)cmask(P0,P1,jb_,qrel,hi);}while(0)
  #define ENDW(tt) do{ if((tt)+3<NT){WAIT_BAR(2);} else if((tt)+2<NT){WAIT_BAR(1);} else {WAIT_BAR(0);} }while(0)
  for(;t+1<NT;t+=2){
    STEP(pB0,pB1,pA0,pA1,t,(t+3<NT),(t+1<NT),(t+1<NT));       ENDW(t);   RESC(); ROT();
    STEP(pA0,pA1,pB0,pB1,t+1,(t+4<NT),(t+2<NT),(t+2<NT));     ENDW(t+1); RESC(); ROT();
  }
  STEP(pB0,pB1,pA0,pA1,NT-1,false,false,false); RESC();
  { float sacc=pB0[0]+pB0[1]; _Pragma("unroll") for(int r=2;r<16;++r)sacc+=pB0[r]; _Pragma("unroll") for(int r=0;r<16;++r)sacc+=pB1[r]; l_reg+=sacc;
    pw0=(u32x4){PKW(pB0,0),PKW(pB0,2),PKW(pB0,4),PKW(pB0,6)};pw1=(u32x4){PKW(pB0,8),PKW(pB0,10),PKW(pB0,12),PKW(pB0,14)};pw2=(u32x4){PKW(pB1,0),PKW(pB1,2),PKW(pB1,4),PKW(pB1,6)};pw3=(u32x4){PKW(pB1,8),PKW(pB1,10),PKW(pB1,12),PKW(pB1,14)};
    SBAR(); pv(o,vb0+sl_cur,PAF(0),PAF(1),PAF(2),PAF(3)); }
  #undef PKW
  #undef PAF
  #undef VFR
  #undef PIN
  #undef MX3
  #undef GAPA
  #undef GAPB
  #undef EX
  #undef VRD
  #undef KRD
  #undef STEP
  #undef ENDW
  {auto rr=__builtin_amdgcn_permlane32_swap(__float_as_uint(l_reg),__float_as_uint(l_reg),false,false);l_reg=__uint_as_float(rr[0])+__uint_as_float(rr[1]);}
  if(hi==0)wsf[32+r32]=l_reg;asm volatile("s_waitcnt lgkmcnt(0)":::"memory");
  float rli[16];
  #pragma unroll
  for(int r=0;r<16;++r)rli[r]=__builtin_amdgcn_rcpf(wsf[32+crow(r,hi)]);
  bf16*Ow=O+(rowbase+q0+wid*QBLK)*OPITCH+h*D;
  { bf16*stg=(bf16*)(shm+LDS_OST)+wid*2048;
    #pragma unroll
    for(int r=0;r<16;++r){const int orow=crow(r,hi);
      #pragma unroll
      for(int d0=0;d0<2;++d0)stg[orow*64+d0*32+r32]=__float2bfloat16(o[d0][r]*rli[r]);}
    asm volatile("s_waitcnt lgkmcnt(0)":::"memory");
    int ln2_; asm volatile("v_mbcnt_lo_u32_b32 %0, -1, 0\n\tv_mbcnt_hi_u32_b32 %0, -1, %0":"=v"(ln2_));
    #pragma unroll
    for(int i=0;i<4;++i){const int row=i*8+(ln2_>>3),ch=ln2_&7; const u32x4 v=*(const u32x4*)(stg+row*64+ch*8); ATTN_STORE16(Ow+(long)row*OPITCH+ch*8,v);} }
  asm volatile("s_waitcnt lgkmcnt(0)\n\ts_barrier":::"memory");
  #undef TBADD
  #undef DMA_K
  #undef DMA_V
  #undef CMASK
  #undef START
  #undef RESC
  #undef ROT
}
constexpr int ATTN_LDS_BYTES=LDS_BYTES;
struct AttnTensors { const bf16* Q; const bf16* K; const bf16* V; bf16* O; };
struct AttnUnit { int bh; int qb; };
#undef SBAR
#undef WAIT_BAR
}
constexpr int NWAVES = 8;
constexpr int DM = 1024, MP = 16384, MS = 512, MT = MP + MS;
constexpr int SEQ = 4096, NB = 4, DB = 128, DT = 4;
constexpr int DIN = 5648, NIN = 5632, DFF = 2816, NGU = 5632, PLE = 256;
constexpr int HM_ = 4, DKM = 128, HF = 8, DHF = 64, WM = 512, WF = 512;
constexpr int PAST = 2048, PAGE = 128, NPAGES = 16;
constexpr float EPS = 1e-6f;
constexpr float LOG2E = 1.4426950408889634f;
constexpr float C2Q = 0.125f * LOG2E;
constexpr size_t O_YP = 0, O_YS = (size_t)MP * DM, O_KP = O_YS + (size_t)MS * DM, O_VP = O_KP + (size_t)MP * 512, O_LFP = O_VP + (size_t)MP * 512,
    O_CP = O_LFP + (size_t)MP * 8, O_NP = O_CP + (size_t)NB * HM_ * 128 * 128, O_MPR = O_NP + (size_t)NB * HM_ * 128, O_KS = O_MPR + NB * HM_,
    O_VS = O_KS + (size_t)MS * 512, O_LFS = O_VS + (size_t)MS * 512, O_CS = O_LFS + (size_t)MS * 8, O_NS = O_CS + (size_t)DB * HM_ * 128 * 128,
    O_MS = O_NS + (size_t)DB * HM_ * 128, O_END = O_MS + (size_t)DB * HM_;
static_assert(O_END == 43457040, "d_out size");
constexpr size_t MiB = 1u << 20;
constexpr size_t WS_CTL = 0, CTL_ZERO_BYTES = 1 * MiB;
constexpr size_t WS_WIN = 2 * MiB, WS_WGU = 13 * MiB, WS_WDN = 24 * MiB, WS_WOUT = 30 * MiB, WS_WPG = 32 * MiB, WS_WPA = 34 * MiB, WS_WPB = 35 * MiB, WS_WPP = 36 * MiB;
constexpr size_t WS_GATES = 38 * MiB, WS_SSQ2 = 40 * MiB, WS_SSQ3 = 42 * MiB, WS_MISC = 44 * MiB;
constexpr size_t WS_XN = 64 * MiB, WS_PB = 98 * MiB, WS_MQ = 108 * MiB, WS_MK = 125 * MiB, WS_MV = 142 * MiB, WS_MO = 159 * MiB, WS_FQ = 176 * MiB, WS_FK = 193 * MiB, WS_FV = 210 * MiB,
    WS_HM = 227 * MiB, WS_YF = 244 * MiB, WS_GA = 262 * MiB, WS_GB = 296 * MiB, WS_U = 330 * MiB, WS_X1 = 364 * MiB, WS_A2 = 431 * MiB, WS_HB = 465 * MiB, WS_A3 = 557 * MiB, WS_TP = 591 * MiB,
    WS_LT = 625 * MiB, WS_CT = 658 * MiB, WS_HY = 680 * MiB, WS_END = 714 * MiB;
constexpr size_t MI_CHS = 0;
constexpr size_t MI_MC = 8192;
constexpr size_t MI_NL = 16384;
constexpr size_t MI_NC = MI_NL + 512 * 128 * 4;
constexpr size_t MI_F2 = 12 * MiB;
constexpr size_t MI_DEC = 1 * MiB;
constexpr int CW_TMO = 0, CW_CODE = 1, CW_BAR = 4096;

constexpr int RING_OFF = 0, RING_BYTES = 131072;
constexpr int LDSCTL_OFF = RING_BYTES, MISC_OFF = LDSCTL_OFF + 320;
constexpr int LDS_BYTES = 147456;
#define GAS __attribute__((address_space(1)))
#define LAS __attribute__((address_space(3)))
typedef unsigned short bf16;
typedef unsigned v4u __attribute__((ext_vector_type(4)));
typedef float f32x4 __attribute__((ext_vector_type(4)));
typedef short bf16x8 __attribute__((ext_vector_type(8)));
typedef GAS unsigned gu32;
typedef GAS unsigned long long gu64;
#define RLX_AGENT __ATOMIC_RELAXED, __HIP_MEMORY_SCOPE_AGENT
#define LDS_WAIT() asm volatile("s_waitcnt lgkmcnt(0)" ::: "memory")
#define VM_WAIT() asm volatile("s_waitcnt vmcnt(0)" ::: "memory")
__device__ __forceinline__ unsigned long long rt() { return __builtin_amdgcn_s_memrealtime(); }
__device__ __forceinline__ unsigned f2bf(float f) { unsigned u = __builtin_bit_cast(unsigned, f); return (u + 0x7fffu + ((u >> 16) & 1u)) >> 16; }
__device__ __forceinline__ unsigned pk2(float lo, float hi) { return f2bf(lo) | (f2bf(hi) << 16); }

#define XB_TMO      128
#define XB_XCNT(j)  (256  + 64 * (j))
#define XB_XSUB(j)  (1280 + 64 * (j))
#define XB_XGEN(j)  (2304 + 64 * (j))
#define XB_TOP      3328
#define XB_TOPGEN   3392
#define XCD_BAR_WORDS 3456
#define XB_SPIN_CAP (1u << 18)

__device__ __forceinline__ unsigned xb_ld(unsigned* p)              { return __hip_atomic_load(p, __ATOMIC_RELAXED, __HIP_MEMORY_SCOPE_AGENT); }
__device__ __forceinline__ unsigned xb_add(unsigned* p, unsigned v) { return __hip_atomic_fetch_add(p, v, __ATOMIC_RELAXED, __HIP_MEMORY_SCOPE_AGENT); }
__device__ __forceinline__ unsigned xb_xcc_id() { return (unsigned)__builtin_amdgcn_s_getreg((3 << 11) | 20) & 0xFu; }
#define XB_SPIN(cond, bar) do { unsigned _sp = 0; while (cond) { __builtin_amdgcn_s_sleep(1); \
    if ((++_sp & 255u) == 0u) { if (xb_ld(&(bar)[XB_TMO])) break; if (_sp > XB_SPIN_CAP) { atomicAdd(&(bar)[XB_TMO], 1u); break; } } } } while (0)

struct XcdBarrier {
    unsigned* bar; unsigned x;
    volatile LAS unsigned* st;
};

__device__ __forceinline__ XcdBarrier xcd_barrier_post(unsigned* bar, volatile LAS unsigned* st) {
    XcdBarrier b; b.bar = bar; b.x = xb_xcc_id(); b.st = st;
    if (threadIdx.x == 0) (void)xb_add(&bar[XB_XCNT(b.x)], 1u);
    return b;
}
__device__ __forceinline__ void xcd_barrier_complete(unsigned* bar, unsigned x, unsigned& nloc, unsigned& nx) {
    const unsigned G = gridDim.x * gridDim.y * gridDim.z;
    unsigned sum, cnt, mine, sp = 0u;
    for (;;) {
        sum = 0u; cnt = 0u; mine = 0u;
#pragma unroll
        for (unsigned j = 0; j < 16; ++j) { const unsigned c = xb_ld(&bar[XB_XCNT(j)]); sum += c; cnt += (c > 0u) ? 1u : 0u; mine = (j == x) ? c : mine; }
        if (sum == G) break;
        __builtin_amdgcn_s_sleep(1);
        if ((++sp & 255u) == 0u) { if (xb_ld(&bar[XB_TMO])) break; if (sp > XB_SPIN_CAP) { atomicAdd(&bar[XB_TMO], 1u); break; } }
    }
    nloc = mine > 0u ? mine : 1u; nx = cnt > 0u ? cnt : 1u;
}

__device__ __forceinline__ void xcd_barrier(const XcdBarrier& b) {
    asm volatile("s_waitcnt vmcnt(0)" ::: "memory");
    __syncthreads();
    if (threadIdx.x == 0) {
        unsigned* bar = b.bar;
        __builtin_amdgcn_s_waitcnt(0);
        unsigned nloc = b.st[0], nx = b.st[1];
        if (nloc == 0u) { xcd_barrier_complete(bar, b.x, nloc, nx); b.st[0] = nloc; b.st[1] = nx; }
        const unsigned old = xb_add(&bar[XB_XSUB(b.x)], 1u);
        const unsigned gen = old / nloc;
        if (old + 1u == (gen + 1u) * nloc) {
            __builtin_amdgcn_fence(__ATOMIC_RELEASE, "agent");
            asm volatile("s_waitcnt vmcnt(0)" ::: "memory");
            const unsigned og = xb_add(&bar[XB_TOP], 1u);
            const unsigned tg = og / nx;
            if (og + 1u == (tg + 1u) * nx) xb_add(&bar[XB_TOPGEN], 1u);
            else XB_SPIN(xb_ld(&bar[XB_TOPGEN]) == tg, bar);
            __builtin_amdgcn_fence(__ATOMIC_ACQUIRE, "agent");
            xb_add(&bar[XB_XGEN(b.x)], 1u);
            asm volatile("s_waitcnt vmcnt(0)" ::: "memory");
        } else {
            XB_SPIN(xb_ld(&bar[XB_XGEN(b.x)]) == gen, bar);
            __builtin_amdgcn_fence(__ATOMIC_ACQUIRE, "agent");
            asm volatile("s_waitcnt vmcnt(0)" ::: "memory");
        }
    }
    __syncthreads();
}
struct Frame {
    LAS unsigned char* lds;
    volatile LAS unsigned* MISC;
    gu32* ctl;
    int vcu, G;
    float* out; unsigned char* ws;
};
struct Args { const void* in[28]; float* out; unsigned char* ws; int ph_lo, ph_hi; };
#define IN_F(k) ((const float*)A.in[k])
#define I_XP IN_F(0)
#define I_XS IN_F(1)
#define I_PP IN_F(2)
#define I_PS IN_F(3)
#define I_CK IN_F(4)
#define I_CV IN_F(5)
#define I_CLF IN_F(6)
#define I_SC IN_F(7)
#define I_SN IN_F(8)
#define I_SM IN_F(9)
#define I_PT ((const int*)A.in[10])
#define I_GMIX IN_F(11)
#define I_WIN IN_F(12)
#define I_BMI IN_F(13)
#define I_BMF IN_F(14)
#define I_BFF IN_F(15)
#define I_GMH IN_F(16)
#define I_GQN IN_F(17)
#define I_GKN IN_F(18)
#define I_WPA IN_F(19)
#define I_WPB IN_F(20)
#define I_WOUT IN_F(21)
#define I_GFFN IN_F(22)
#define I_WGU IN_F(23)
#define I_WDN IN_F(24)
#define I_GPLE IN_F(25)
#define I_WPG IN_F(26)
#define I_WPP IN_F(27)
__device__ __forceinline__ float wave_sum(float v) {
#pragma unroll
    for (int o = 1; o < 64; o <<= 1) v += __shfl_xor(v, o);
    return v;
}
__device__ __forceinline__ float dot4f(f32x4 a) { return (a[0] * a[0] + a[1] * a[1]) + (a[2] * a[2] + a[3] * a[3]); }
__device__ __forceinline__ float logsig(float x) { return fminf(x, 0.f) - log1pf(expf(-fabsf(x))); }
__device__ __forceinline__ void p0_transpose_load(float (&wv_)[32], const float* W, int ldw, int src_col0, int k0, int lane) {
#pragma unroll
    for (int i = 0; i < 32; ++i) { const int kk = 2 * i + (lane >> 5); wv_[i] = W[(size_t)(k0 + kk) * ldw + src_col0 + (lane & 31)]; }
}
__device__ __forceinline__ void p0_transpose_finish(const float (&wv_)[32], int K, bf16* WT, int dst_row0, int k0, LAS float* scr, int lane, const float* kscale = nullptr, int dko = 0) {
#pragma unroll
    for (int i = 0; i < 32; ++i) { const int kk = 2 * i + (lane >> 5); float w = wv_[i]; if (kscale) w *= kscale[k0 + kk]; scr[kk * 33 + (lane & 31)] = w; }
    LDS_WAIT(); asm volatile("" ::: "memory");
    const int c = lane & 7;
#pragma unroll
    for (int j = 0; j < 4; ++j) { const int n = (lane >> 3) + 8 * j; const LAS float* s = scr + (8 * c) * 33 + n;
        v4u o; o.x = pk2(s[0 * 33], s[1 * 33]); o.y = pk2(s[2 * 33], s[3 * 33]); o.z = pk2(s[4 * 33], s[5 * 33]); o.w = pk2(s[6 * 33], s[7 * 33]);
        *(GAS v4u*)(WT + (size_t)(dst_row0 + n) * K + dko + k0 + 8 * c) = o; }
    LDS_WAIT(); asm volatile("" ::: "memory");
}
__device__ __forceinline__ void p0_transpose_item(const float* W, int ldw, int K, bf16* WT, int src_col0, int dst_row0, int k0, LAS float* scr, int lane, const float* kscale = nullptr, int dko = 0) {
    float wv_[32];
    p0_transpose_load(wv_, W, ldw, src_col0, k0, lane);
    p0_transpose_finish(wv_, K, WT, dst_row0, k0, scr, lane, kscale, dko);
}
__device__ __forceinline__ int hperm(int f) { return 256 * (f >> 8) + 128 * ((f & 63) >> 5) + 32 * ((f & 255) >> 6) + (f & 31); }
__device__ __forceinline__ void p0_win_item(int r, int& src, int& dst, int& k0) {
    const int blk = r >> 4, kb = r & 15; k0 = 64 * kb;
    if (blk < 64) { src = 32 * blk; dst = 32 * blk; }
    else if (blk < 80) { const int f = 32 * (blk - 64); src = 2056 + f; dst = 2048 + hperm(f); }
    else if (blk < 96) { const int f = 32 * (blk - 80); src = 2568 + f; dst = 2560 + hperm(f); }
    else if (blk < 112) { const int f = 32 * (blk - 96); src = 3080 + f; dst = 3072 + f; }
    else { const int f = 32 * (blk - 112); src = 3600 + f; dst = 3584 + f; }
}
__device__ __forceinline__ const float* xrow_ptr(const Args& A, int r) { return r < MP ? I_XP + (size_t)r * DM : I_XS + (size_t)(r - MP) * DM; }

constexpr int NI_IN = 176 * 16, NI_GU = 176 * 16, NI_DN = 32 * 44, NI_OUT = 32 * 16, NI_PG = 32 * 16, NI_PA = 32 * 8, NI_PB = 32 * 8, NI_PP = 32 * 4;
constexpr int NLATE = NI_GU + NI_DN + NI_OUT + NI_PG + NI_PA + NI_PB + NI_PP;
__device__ __forceinline__ void p0_late_item(const Args& A, unsigned char* ws, int r, LAS float* scr, int lane) {
    bf16* WGU = (bf16*)(ws + WS_WGU); bf16* WDN = (bf16*)(ws + WS_WDN); bf16* WOUT = (bf16*)(ws + WS_WOUT); bf16* WPG = (bf16*)(ws + WS_WPG); bf16* WPA = (bf16*)(ws + WS_WPA); bf16* WPB = (bf16*)(ws + WS_WPB); bf16* WPP = (bf16*)(ws + WS_WPP);
    do {
        if (r < NI_GU) { const int db = r >> 4, kb = r & 15; const int pn = db >> 3, q = db & 7, bj = q >> 2, wc = q & 3;
            p0_transpose_item(I_WGU, NGU, DM, WGU, bj * DFF + 128 * pn + 32 * wc, 32 * db, 64 * kb, scr, lane, I_GFFN); break; } r -= NI_GU;
        if (r < NI_DN) { const int blk = r / 44, kb = r % 44; p0_transpose_item(I_WDN, DM, DFF, WDN, 32 * blk, 32 * blk, 64 * kb, scr, lane); break; } r -= NI_DN;
        if (r < NI_OUT) { p0_transpose_item(I_WOUT, DM, DM, WOUT, 32 * (r >> 4), 32 * (r >> 4), 64 * (r & 15), scr, lane); break; } r -= NI_OUT;
        if (r < NI_PG) { p0_transpose_item(I_WPG, DM, DM, WPG, 32 * (r >> 4), 32 * (r >> 4), 64 * (r & 15), scr, lane, I_GPLE); break; } r -= NI_PG;
        if (r < NI_PA) { p0_transpose_item(I_WPA, DM, DM, WPA, 32 * (r >> 3), 32 * (r >> 3), 64 * (r & 7), scr, lane, nullptr, 0); break; } r -= NI_PA;
        if (r < NI_PB) { p0_transpose_item(I_WPB, DM, DM, WPA, 32 * (r >> 3), 32 * (r >> 3), 64 * (r & 7), scr, lane, nullptr, 512); break; } r -= NI_PB;
        p0_transpose_item(I_WPP, DM, PLE, WPP, 32 * (r >> 2), 32 * (r >> 2), 64 * (r & 3), scr, lane);
    } while (0);
}
template <int NR, bool PRE> __device__ __forceinline__ void p0_rows_trip(Frame& F, const Args& A, const int r0, const int lane, const LAS float* wl, bf16* XN, float* GT, const f32x4 (&xp)[4]) {
    const GAS f32x4* xr[NR];
#pragma unroll
    for (int q = 0; q < NR; ++q) xr[q] = (const GAS f32x4*)xrow_ptr(A, r0 + q) + lane;
    f32x4 xv[NR][4]; float ss[NR];
#pragma unroll
    for (int q = 0; q < NR; ++q) ss[q] = 0.f;
#pragma unroll
    for (int j = 0; j < 4; ++j)
#pragma unroll
        for (int q = 0; q < NR; ++q) { if constexpr (PRE) xv[q][j] = xp[j]; else xv[q][j] = xr[q][64 * j]; ss[q] += dot4f(xv[q][j]); }
    float rr[NR];
#pragma unroll
    for (int q = 0; q < NR; ++q) rr[q] = rsqrtf(wave_sum(ss[q]) * (1.f / DM) + EPS);
    float v[16 * NR];
#pragma unroll
    for (int c = 0; c < 16 * NR; ++c) v[c] = 0.f;
#pragma unroll
    for (int j = 0; j < 4; ++j) { const f32x4 gmj = ((const GAS f32x4*)I_GMIX)[64 * j + lane]; f32x4 vx[NR];
#pragma unroll
        for (int q = 0; q < NR; ++q) { vx[q] = xv[q][j] * rr[q] * gmj;
            ((GAS unsigned long long*)(XN + (size_t)(r0 + q) * DM) + lane)[64 * j] = (unsigned long long)pk2(vx[q].x, vx[q].y) | ((unsigned long long)pk2(vx[q].z, vx[q].w) << 32); }
#pragma unroll
        for (int e = 0; e < 4; ++e) { const LAS f32x4* wp = (const LAS f32x4*)(wl + 4352 * j + 16 * e);
#pragma unroll
            for (int qq = 0; qq < 4; ++qq) { const f32x4 w = wp[qq];
#pragma unroll
                for (int q = 0; q < NR; ++q) { const float xs = vx[q][e];
#pragma unroll
                    for (int t = 0; t < 4; ++t) v[16 * q + 4 * qq + t] += xs * w[t]; } }
            asm volatile("" ::: "memory"); } }
    if constexpr (NR == 4) {
#pragma unroll
        for (int i = 0; i < 32; ++i) { const bool up = (lane & 32) != 0; const float keep = up ? v[32 + i] : v[i], send = up ? v[i] : v[32 + i]; v[i] = keep + __shfl_xor(send, 32); }
#pragma unroll
        for (int i = 0; i < 16; ++i) { const bool up = (lane & 16) != 0; const float keep = up ? v[16 + i] : v[i], send = up ? v[i] : v[16 + i]; v[i] = keep + __shfl_xor(send, 16); }
    } else {
#pragma unroll
        for (int i = 0; i < 16; ++i) { v[i] += __shfl_xor(v[i], 32); v[i] += __shfl_xor(v[i], 16); }
    }
#pragma unroll
    for (int i = 0; i < 8; ++i) { const bool up = (lane & 8) != 0; const float keep = up ? v[8 + i] : v[i], send = up ? v[i] : v[8 + i]; v[i] = keep + __shfl_xor(send, 8); }
#pragma unroll
    for (int i = 0; i < 4; ++i) { const bool up = (lane & 4) != 0; const float keep = up ? v[4 + i] : v[i], send = up ? v[i] : v[4 + i]; v[i] = keep + __shfl_xor(send, 4); }
#pragma unroll
    for (int i = 0; i < 2; ++i) { const bool up = (lane & 2) != 0; const float keep = up ? v[2 + i] : v[i], send = up ? v[i] : v[2 + i]; v[i] = keep + __shfl_xor(send, 2); }
    { const bool up = (lane & 1) != 0; const float keep = up ? v[1] : v[0], send = up ? v[0] : v[1]; v[0] = keep + __shfl_xor(send, 1); }
    if (NR == 4 || lane < 16) { const int row = r0 + (NR == 4 ? (lane >> 4) : 0), c = lane & 15; float z = v[0], val;
        if (c < 4) val = z + I_BMI[c]; else if (c < 8) val = logsig(z + I_BMF[c - 4]); else { val = logsig(z + I_BFF[c - 8]);
            if (row < MP) F.out[O_LFP + (size_t)row * 8 + (c - 8)] = val; else F.out[O_LFS + (size_t)(row - MP) * 8 + (c - 8)] = val; }
        GT[(size_t)row * 16 + c] = val; }
}
__device__ __forceinline__ void p0_prologue(Frame& F, const Args& A, const int parts = 7) {
    int tid_ = threadIdx.x; asm volatile("" : "+v"(tid_)); const int tid = tid_, lane = tid & 63, wave = __builtin_amdgcn_readfirstlane(tid >> 6);
    LAS float* scr = (LAS float*)(F.lds + RING_OFF + wave * 16384);
    const int gw = F.vcu * NWAVES + wave, NGW = F.G * NWAVES;
    bf16* WIN = (bf16*)(F.ws + WS_WIN);
    if (parts & 1) {
        for (int it = gw; it < NI_IN; it += 2 * NGW) {
            const int it2 = it + NGW; const bool two = it2 < NI_IN; int s0, d0, k0, s1, d1, k1; p0_win_item(it, s0, d0, k0); p0_win_item(two ? it2 : it, s1, d1, k1);
            float wa[32], wb[32];
            p0_transpose_load(wa, I_WIN, DIN, s0, k0, lane); if (two) p0_transpose_load(wb, I_WIN, DIN, s1, k1, lane);
            p0_transpose_finish(wa, DM, WIN, d0, k0, scr, lane); if (two) p0_transpose_finish(wb, DM, WIN, d1, k1, scr, lane);
        }
    }
    f32x4 gw0[4], gw1[4];
    if (parts & 4) {
#pragma unroll
      for (int u = 0; u < 4; ++u) { const int i = tid + u * (NWAVES * 64), k = i >> 1, g = i & 1; const GAS f32x4* sp = (const GAS f32x4*)(I_WIN + (size_t)k * DIN + (g ? 3592 : 2048)); gw0[u] = sp[0]; gw1[u] = sp[1]; } }
    if (parts & 2) { bf16* PB = (bf16*)(F.ws + WS_PB); const int gt = F.vcu * (NWAVES * 64) + tid, NGT = F.G * NWAVES * 64;
      constexpr int NPB = MT * PLE / 4;
      for (int i0 = gt; i0 < NPB; i0 += 9 * NGT) { f32x4 v[9];
#pragma unroll
          for (int u = 0; u < 9; ++u) { const int i = i0 + u * NGT; const int e = (i < NPB ? i : gt) * 4; const float* src = e < MP * PLE ? I_PP + e : I_PS + (e - MP * PLE); v[u] = *(const GAS f32x4*)src; }
#pragma unroll
          for (int u = 0; u < 9; ++u) { const int i = i0 + u * NGT; if (i < NPB) *(GAS unsigned long long*)(PB + (size_t)i * 4) = (unsigned long long)pk2(v[u].x, v[u].y) | ((unsigned long long)pk2(v[u].z, v[u].w) << 32); } } }
    if (!(parts & 4)) return;
    __syncthreads();
    LAS float* wg = (LAS float*)(F.lds + RING_OFF);
    {
#pragma unroll
      for (int u = 0; u < 4; ++u) { const int i = tid + u * (NWAVES * 64), k = i >> 1, g = i & 1; LAS f32x4* dp = (LAS f32x4*)(wg + 16 * k + 4 * ((k >> 2) & 15) + 64 * (k >> 6) + 8 * g); dp[0] = gw0[u]; dp[1] = gw1[u]; } }
    __syncthreads();
    {
        bf16* XN = (bf16*)(F.ws + WS_XN); float* GT = (float*)(F.ws + WS_GATES);
        const LAS float* wl = wg + 64 * lane + 64 * (lane >> 4) + 4 * (lane & 15);
        const bool has1 = wave < 2 && 2 * F.vcu + wave < MS; const int r1 = MP + 2 * F.vcu + wave; f32x4 x1[4];
#pragma unroll
        for (int j = 0; j < 4; ++j) x1[j] = ((const GAS f32x4*)xrow_ptr(A, has1 ? r1 : MP) + lane)[64 * j];
        for (int pr = gw; pr < MP / 4; pr += NGW) p0_rows_trip<4, false>(F, A, 4 * pr, lane, wl, XN, GT, x1);
        if (has1) p0_rows_trip<1, true>(F, A, r1, lane, wl, XN, GT, x1);
        if (F.G * 2 < MS) for (int r = F.G * 2 + gw; r < MS; r += NGW) p0_rows_trip<1, false>(F, A, MP + r, lane, wl, XN, GT, x1);
    }
}
#define PHASE_IDS_ int tid_ = threadIdx.x; asm volatile("" : "+v"(tid_)); const int tid = tid_, lane = tid & 63, wave = __builtin_amdgcn_readfirstlane(tid >> 6)
#define OPAQUE_WS_ size_t wsoo_ = 0; asm volatile("" : "+s"(wsoo_)); unsigned char* ws = ws_ + wsoo_
typedef short s16x4v __attribute__((ext_vector_type(4)));
typedef short v4i16_t __attribute__((ext_vector_type(4)));
__device__ __forceinline__ s16x4v tr4(const LAS unsigned char* p) { return __builtin_bit_cast(s16x4v, __builtin_amdgcn_ds_read_tr16_b64_v4i16((LAS v4i16_t*)p)); }
__device__ __forceinline__ bf16x8 join8(s16x4v lo, s16x4v hi) { return (bf16x8){lo[0], lo[1], lo[2], lo[3], hi[0], hi[1], hi[2], hi[3]}; }
#define MFMA16(X, Y, C) __builtin_amdgcn_mfma_f32_16x16x32_bf16(X, Y, C, 0, 0, 0)
__device__ __forceinline__ float bflo(unsigned u) { return __uint_as_float(u << 16); }
__device__ __forceinline__ float bfhi(unsigned u) { return __uint_as_float(u & 0xffff0000u); }
__device__ __forceinline__ float bf2f(bf16 v) { return __uint_as_float(((unsigned)v) << 16); }
__device__ __forceinline__ void st4bf(bf16* p, f32x4 v) { *(GAS unsigned long long*)p = (unsigned long long)pk2(v.x, v.y) | ((unsigned long long)pk2(v.z, v.w) << 32); }
__device__ __forceinline__ f32x4 ld4bf(const bf16* p) { const unsigned long long w = *(const GAS unsigned long long*)p; return (f32x4){bflo((unsigned)w), bfhi((unsigned)w), bflo((unsigned)(w >> 32)), bfhi((unsigned)(w >> 32))}; }
constexpr int TP_ = 272;

__device__ __forceinline__ void chunk_scan(const float* GT  , int h, int tid, int lane, int wave, LAS float* sc, float& bj, float& gj, float& gpre, float& G, float& bend) {
    float lf = 0.f, ig = 0.f;
    if (tid < 128) { lf = GT[(size_t)tid * 16 + 4 + h]; ig = GT[(size_t)tid * 16 + h]; }
    float s = lf;
#pragma unroll
    for (int o = 1; o < 64; o <<= 1) { const float t = __shfl_up(s, o); if (lane >= o) s += t; }
    if (tid < 128 && lane == 63) sc[wave] = s;
    __syncthreads();
    if (wave == 1) s += sc[0];
    bj = s; gj = ig - bj;
    float pm = gj;
#pragma unroll
    for (int o = 1; o < 64; o <<= 1) { const float t = __shfl_up(pm, o); if (lane >= o) pm = fmaxf(pm, t); }
    if (tid < 128 && lane == 63) sc[2 + wave] = pm;
    if (tid == 127) sc[4] = s;
    __syncthreads();
    if (wave == 1) pm = fmaxf(pm, sc[2]);
    gpre = pm; G = fmaxf(sc[2], sc[3]); bend = sc[4];
}
struct KVRegs { v4u k[4], v[4]; };
__device__ __forceinline__ void load_kv(KVRegs& R, const bf16* MKp, const bf16* MVp, int tid) {
#pragma unroll
    for (int i = 0; i < 4; ++i) { const int s = (tid >> 4) + 32 * i, c16 = tid & 15; R.k[i] = *(const GAS v4u*)(MKp + (size_t)s * 512 + 8 * c16); R.v[i] = *(const GAS v4u*)(MVp + (size_t)s * 512 + 8 * c16); }
}
__device__ __forceinline__ void store_kv(const KVRegs& R, LAS unsigned char* KT, LAS unsigned char* VT, const LAS float* wkl, int tid) {
#pragma unroll
    for (int i = 0; i < 4; ++i) { const int s = (tid >> 4) + 32 * i, c16 = tid & 15; const v4u kv = R.k[i]; const float w = wkl[s];
        v4u o; o.x = pk2(bflo(kv.x) * w, bfhi(kv.x) * w); o.y = pk2(bflo(kv.y) * w, bfhi(kv.y) * w); o.z = pk2(bflo(kv.z) * w, bfhi(kv.z) * w); o.w = pk2(bflo(kv.w) * w, bfhi(kv.w) * w);
        *(LAS v4u*)(KT + s * TP_ + c16 * 16) = o; *(LAS v4u*)(VT + s * TP_ + c16 * 16) = R.v[i]; }
}
__device__ __forceinline__ void mlstm_a_unit(unsigned char* ws_, LAS unsigned char* lds, int u) {
    PHASE_IDS_; OPAQUE_WS_;
    const int bh = u >> 5, c = u & 31, b = bh >> 2, h = bh & 3; const int r0 = b * SEQ + c * 128;
    LAS unsigned char* KT = lds; LAS unsigned char* VT = lds + 128 * TP_; LAS float* wkl = (LAS float*)(lds + 2 * 128 * TP_); LAS float* sc = wkl + 128;
    KVRegs R; load_kv(R, (const bf16*)(ws + WS_MK) + (size_t)r0 * 512 + h * 128, (const bf16*)(ws + WS_MV) + (size_t)r0 * 512 + h * 128, tid);
    float bj, gj, gpre, G, bend; chunk_scan((const float*)(ws + WS_GATES) + (size_t)r0 * 16, h, tid, lane, wave, sc, bj, gj, gpre, G, bend);
    if (tid < 128) wkl[tid] = expf(gj - G);
    if (tid == 0) { float* chs = (float*)(ws + WS_MISC + MI_CHS) + u * 2; chs[0] = G; chs[1] = bend; }
    __syncthreads();
    store_kv(R, KT, VT, wkl, tid);
    __syncthreads();
    const int fr = lane & 15, fq = lane >> 4, q4 = (lane & 15) >> 2, p4 = lane & 3;
    f32x4 acc[8], accn = (f32x4){0.f, 0.f, 0.f, 0.f};
#pragma unroll
    for (int i = 0; i < 8; ++i) acc[i] = (f32x4){0.f, 0.f, 0.f, 0.f};
    const short one = fr == 0 ? (short)0x3F80 : (short)0; const bf16x8 ones = (bf16x8){one, one, one, one, one, one, one, one};
#pragma unroll
    for (int ks = 0; ks < 4; ++ks) { const int row = 32 * ks + 8 * fq + q4;
        const bf16x8 Y = join8(tr4(VT + row * TP_ + (16 * wave + 4 * p4) * 2), tr4(VT + (row + 4) * TP_ + (16 * wave + 4 * p4) * 2));
#pragma unroll
        for (int di = 0; di < 8; ++di) { const bf16x8 X = join8(tr4(KT + row * TP_ + (16 * di + 4 * p4) * 2), tr4(KT + (row + 4) * TP_ + (16 * di + 4 * p4) * 2));
            acc[di] = MFMA16(X, Y, acc[di]); if (di == wave) accn = MFMA16(X, ones, accn); } }
    float* LT = (float*)(ws + WS_LT) + (size_t)u * 16384;
#pragma unroll
    for (int di = 0; di < 8; ++di) *(GAS f32x4*)(LT + (16 * wave + fr) * 128 + 16 * di + 4 * fq) = acc[di];
    if (fr == 0) *(GAS f32x4*)((float*)(ws + WS_MISC + MI_NL) + (size_t)u * 128 + 16 * wave + 4 * fq) = accn;
    __syncthreads();
}
__device__ __forceinline__ void mlstm_b(unsigned char* ws, float* out, LAS unsigned char* lds, int vcu, int Gn, int tid) {
    const float* LTb = (const float*)(ws + WS_LT); bf16* CTb = (bf16*)(ws + WS_CT); const float* NL = (const float*)(ws + WS_MISC + MI_NL); float* NC = (float*)(ws + WS_MISC + MI_NC);
    for (int it = vcu; it < 256; it += Gn) { const int bh = it >> 4, part = it & 15;
        LAS float* decl = (LAS float*)lds; LAS float* fl = decl + 32; LAS float* chl = decl + 64; LAS float* mcl = decl + 128;
        if (tid < 64) chl[tid] = ((const float*)(ws + WS_MISC + MI_CHS) + (size_t)bh * 64)[tid];
        __syncthreads();
        if (tid == 0) { float m = 0.f;
            for (int c = 0; c < 32; ++c) { const float Gc = chl[2 * c], be = chl[2 * c + 1], Mx = fmaxf(m, Gc); decl[c] = expf(m - Mx); fl[c] = expf(Gc - Mx); mcl[c] = m; m = be + Mx; }
            mcl[32] = m; }
        __syncthreads();
        if (part == 0 && tid < 33) { ((float*)(ws + WS_MISC + MI_MC) + bh * 33)[tid] = mcl[tid]; if (tid == 32) out[O_MPR + bh] = mcl[32]; }
#pragma unroll
        for (int e2 = 0; e2 < 2; ++e2) { const int idx = part * 1024 + e2 * 512 + tid; float Cs = 0.f; const float* lt = LTb + (size_t)bh * 32 * 16384 + idx; bf16* ct = CTb + (size_t)bh * 32 * 16384 + idx;
            float ltv[32];
#pragma unroll
            for (int c = 0; c < 32; ++c) ltv[c] = __builtin_nontemporal_load(lt + (size_t)c * 16384);
#pragma unroll
            for (int c = 0; c < 32; ++c) { ct[(size_t)c * 16384] = (bf16)f2bf(Cs); Cs = decl[c] * Cs + fl[c] * ltv[c]; }
            const int e = idx >> 7, d = idx & 127; out[O_CP + (size_t)bh * 16384 + d * 128 + e] = Cs; }
        if (part == 0 && tid < 128) { float ns = 0.f; float nlv[32];
#pragma unroll
            for (int c = 0; c < 32; ++c) nlv[c] = NL[(size_t)(bh * 32 + c) * 128 + tid];
#pragma unroll
            for (int c = 0; c < 32; ++c) { NC[(size_t)(bh * 32 + c) * 128 + tid] = ns; ns = decl[c] * ns + fl[c] * nlv[c]; }
            out[O_NP + bh * 128 + tid] = ns; }
        __syncthreads();
    }
}
__device__ __forceinline__ void mlstm_c_unit(const Args& A, unsigned char* ws, LAS unsigned char* lds, int u, int tid, int lane, int wave) {
    const int bh = u >> 5, c = u & 31, b = bh >> 2, h = bh & 3; const int r0 = b * SEQ + c * 128;
    LAS unsigned char* KT = lds; LAS unsigned char* VT = lds + 128 * TP_; LAS unsigned char* CTt = lds + 2 * 128 * TP_;
    LAS float* wkl = (LAS float*)(lds + (2 * 128 + 144) * TP_); LAS float* rjl = wkl + 128; LAS float* wil = rjl + 128; LAS float* eml = wil + 128; LAS float* sc = eml + 128;
    KVRegs R; load_kv(R, (const bf16*)(ws + WS_MK) + (size_t)r0 * 512 + h * 128, (const bf16*)(ws + WS_MV) + (size_t)r0 * 512 + h * 128, tid);
    v4u ctr[4]; { const bf16* CTg = (const bf16*)(ws + WS_CT) + (size_t)u * 16384;
#pragma unroll
      for (int i = 0; i < 4; ++i) ctr[i] = *(const GAS v4u*)(CTg + (size_t)((tid >> 4) + 32 * i) * 128 + 8 * (tid & 15)); }
    const float mc = ((const float*)(ws + WS_MISC + MI_MC))[bh * 33 + c];
    f32x4 nca = (f32x4){0.f, 0.f, 0.f, 0.f}, ncb = nca; { const float* NCg = (const float*)(ws + WS_MISC + MI_NC) + (size_t)u * 128; if (tid < 16) { nca = *(const GAS f32x4*)(NCg + 8 * tid); ncb = *(const GAS f32x4*)(NCg + 8 * tid + 4); } }
    float bj, gj, gpre, G, bend; chunk_scan((const float*)(ws + WS_GATES) + (size_t)r0 * 16, h, tid, lane, wave, sc, bj, gj, gpre, G, bend);
    if (tid < 128) { const float Mj = fmaxf(mc, gpre); wkl[tid] = expf(gj - G); rjl[tid] = expf(G - Mj); wil[tid] = expf(mc - Mj); eml[tid] = expf(-(bj + Mj)); }
    __syncthreads();
    store_kv(R, KT, VT, wkl, tid);
    {
#pragma unroll
      for (int i = 0; i < 4; ++i) { const int e = (tid >> 4) + 32 * i, c16 = tid & 15; *(LAS v4u*)(CTt + e * TP_ + c16 * 16) = ctr[i]; }
      if (tid < 256) { const int rr = tid >> 4, c16 = tid & 15; v4u o = (v4u){0u, 0u, 0u, 0u};
          if (rr == 0) { o.x = pk2(nca.x, nca.y); o.y = pk2(nca.z, nca.w); o.z = pk2(ncb.x, ncb.y); o.w = pk2(ncb.z, ncb.w); }
          *(LAS v4u*)(CTt + (128 + rr) * TP_ + c16 * 16) = o; } }
    const int fr = lane & 15, fq = lane >> 4, q4 = (lane & 15) >> 2, p4 = lane & 3; const int j = 16 * wave + fr;
    bf16x8 qf[4];
    { const bf16* Qg = (const bf16*)(ws + WS_MQ) + (size_t)(r0 + j) * 512 + h * 128 + 8 * fq;
#pragma unroll
      for (int kd = 0; kd < 4; ++kd) qf[kd] = *(const GAS bf16x8*)(Qg + 32 * kd); }
    const float* gmh = I_GMH + h * 128 + 4 * fq; const bf16* MOg = (const bf16*)(ws + WS_MO) + (size_t)(r0 + j) * 512 + h * 128 + 4 * fq;
    f32x4 gmv[8]; unsigned long long mov[8];
#pragma unroll
    for (int eb = 0; eb < 8; ++eb) { gmv[eb] = *(const GAS f32x4*)(gmh + 16 * eb); mov[eb] = *(const GAS unsigned long long*)(MOg + 16 * eb); }
    __syncthreads();
    f32x4 O[9];
#pragma unroll
    for (int eb = 0; eb < 9; ++eb) { O[eb] = (f32x4){0.f, 0.f, 0.f, 0.f};
#pragma unroll
        for (int kd = 0; kd < 4; ++kd) { const bf16x8 X = *(const LAS bf16x8*)(CTt + (16 * eb + fr) * TP_ + (32 * kd + 8 * fq) * 2); O[eb] = MFMA16(X, qf[kd], O[eb]); } }
    { const float wi = wil[j];
#pragma unroll
      for (int eb = 0; eb < 9; ++eb) O[eb] *= wi; }
    f32x4 S[8]; const float rj = rjl[j];
#pragma unroll
    for (int sb = 0; sb < 8; ++sb) { S[sb] = (f32x4){0.f, 0.f, 0.f, 0.f};
        if (sb <= wave) {
#pragma unroll
            for (int kd = 0; kd < 4; ++kd) { const bf16x8 X = *(const LAS bf16x8*)(KT + (16 * sb + fr) * TP_ + (32 * kd + 8 * fq) * 2); S[sb] = MFMA16(X, qf[kd], S[sb]); }
#pragma unroll
            for (int v = 0; v < 4; ++v) S[sb][v] = (16 * sb + 4 * fq + v <= j) ? S[sb][v] * rj : 0.f; } }
    const short one = fr == 0 ? (short)0x3F80 : (short)0; const bf16x8 ones = (bf16x8){one, one, one, one, one, one, one, one};
#pragma unroll
    for (int kp = 0; kp < 4; ++kp) if (2 * kp <= wave) {
        v4u pw; pw.x = pk2(S[2 * kp][0], S[2 * kp][1]); pw.y = pk2(S[2 * kp][2], S[2 * kp][3]); pw.z = pk2(S[2 * kp + 1][0], S[2 * kp + 1][1]); pw.w = pk2(S[2 * kp + 1][2], S[2 * kp + 1][3]);
        const bf16x8 Y = __builtin_bit_cast(bf16x8, pw); const int row = 32 * kp + 4 * fq + q4;
#pragma unroll
        for (int eb = 0; eb < 8; ++eb) { const bf16x8 X = join8(tr4(VT + row * TP_ + (16 * eb + 4 * p4) * 2), tr4(VT + (row + 16) * TP_ + (16 * eb + 4 * p4) * 2)); O[eb] = MFMA16(X, Y, O[eb]); }
        O[8] = MFMA16(ones, Y, O[8]); }
    const float den = __shfl(O[8][0], fr); const float hd = 1.0f / fmaxf(fabsf(den), eml[j]);
    float ssq = 0.f;
#pragma unroll
    for (int eb = 0; eb < 8; ++eb) { O[eb] *= hd; ssq += dot4f(O[eb]); }
    ssq += __shfl_xor(ssq, 16); ssq += __shfl_xor(ssq, 32);
    const float rstd = rsqrtf(ssq * (1.0f / 128.0f) + EPS);
    bf16* HMg = (bf16*)(ws + WS_HY) + (size_t)(r0 + j) * 1024 + h * 128 + 4 * fq;
#pragma unroll
    for (int eb = 0; eb < 8; ++eb) { const f32x4 g = gmv[eb]; const unsigned long long mo = mov[eb]; const unsigned m0 = (unsigned)mo, m1 = (unsigned)(mo >> 32);
        const f32x4 o = O[eb] * rstd * g; *(GAS unsigned long long*)(HMg + 16 * eb) = (unsigned long long)pk2(o.x * bflo(m0), o.y * bfhi(m0)) | ((unsigned long long)pk2(o.z * bflo(m1), o.w * bfhi(m1)) << 32); }
    __syncthreads();
}
__device__ __forceinline__ void mlstm_s_unit(const float* sm_, const float* sn_, const float* sc_, const float* gmh_, unsigned char* ws_, float* out, LAS unsigned char* lds, int u) {
    PHASE_IDS_; OPAQUE_WS_;
    const int b = u >> 2, h = u & 3; const int row0 = MP + b * DT;
    LAS float* ql = (LAS float*)lds; LAS float* kl = ql + 512; LAS float* vl = kl + 512; LAS float* kwl = vl + 512; LAS float* nl = kwl + 512; LAS float* red = nl + 128;
    LAS float* Sl = red + 8192; LAS float* qnl = Sl + 16; LAS float* ws2 = qnl + 4;
    const int e4 = tid & 31, dg = tid >> 5; const float* Cg = sc_ + ((size_t)(b * 4 + h) * 128 + dg * 8) * 128 + 4 * e4; f32x4 cvr[8];
#pragma unroll
    for (int i = 0; i < 8; ++i) cvr[i] = __builtin_nontemporal_load((const GAS f32x4*)(Cg + (size_t)i * 128));
    float lf[4], ig[4], bc[4], mj[4], wint[4], wl[4]; const float* GT = (const float*)(ws + WS_GATES) + (size_t)row0 * 16;
#pragma unroll
    for (int j = 0; j < 4; ++j) { ig[j] = GT[j * 16 + h]; lf[j] = GT[j * 16 + 4 + h]; }
    const float mst = sm_[b * 4 + h];
    bc[0] = lf[0]; bc[1] = bc[0] + lf[1]; bc[2] = bc[1] + lf[2]; bc[3] = bc[2] + lf[3];
#pragma unroll
    for (int j = 0; j < 4; ++j) { float m = bc[j] + mst;
#pragma unroll
        for (int s = 0; s <= j; ++s) m = fmaxf(m, bc[j] - bc[s] + ig[s]);
        mj[j] = m; wint[j] = expf(bc[j] + mst - m); }
    const float aend = bc[3] + mst; float mnew = aend;
#pragma unroll
    for (int s = 0; s < 4; ++s) mnew = fmaxf(mnew, bc[3] - bc[s] + ig[s]);
#pragma unroll
    for (int s = 0; s < 4; ++s) wl[s] = expf(bc[3] - bc[s] + ig[s] - mnew);
    const float decay = expf(aend - mnew);
    for (int idx = tid; idx < 1536; idx += 512) { const int arr = idx >> 9, jj = (idx >> 7) & 3, d = idx & 127;
        const bf16* src = (const bf16*)(ws + (arr == 0 ? WS_MQ : arr == 1 ? WS_MK : WS_MV)); ql[idx] = bf2f(src[(size_t)(row0 + jj) * 512 + h * 128 + d]); }
    if (tid < 128) nl[tid] = sn_[(size_t)(b * 4 + h) * 128 + tid];
    __syncthreads();
    { const int s = tid >> 7; const float w = s == 0 ? wl[0] : s == 1 ? wl[1] : s == 2 ? wl[2] : wl[3]; kwl[tid] = w * kl[tid]; }
    for (int p = wave; p < 20; p += 8) {
        const LAS float* a_ = ql + (p < 16 ? (p >> 2) : (p - 16)) * 128; const LAS float* b_ = p < 16 ? kl + (p & 3) * 128 : nl;
        const float a = wave_sum(a_[lane] * b_[lane] + a_[lane + 64] * b_[lane + 64]);
        if (lane == 0) { if (p < 16) Sl[p] = a; else qnl[p - 16] = a; } }
    __syncthreads();
    { float* Co = out + O_CS + ((size_t)(b * 4 + h) * 128 + dg * 8) * 128 + 4 * e4;
      f32x4 part[4]; f32x4 vv[4];
#pragma unroll
      for (int s = 0; s < 4; ++s) { part[s] = (f32x4){0.f, 0.f, 0.f, 0.f}; vv[s] = *(const LAS f32x4*)(vl + s * 128 + 4 * e4); }
#pragma unroll
      for (int i = 0; i < 8; ++i) { const f32x4 cv = cvr[i]; const int d = dg * 8 + i;
          f32x4 cn = cv * decay;
#pragma unroll
          for (int s = 0; s < 4; ++s) { part[s] += cv * ql[s * 128 + d]; cn += vv[s] * kwl[s * 128 + d]; }
          __builtin_nontemporal_store(cn, (GAS f32x4*)(Co + (size_t)i * 128)); }
#pragma unroll
      for (int s = 0; s < 4; ++s) *(LAS f32x4*)(red + (dg * 4 + s) * 128 + 4 * e4) = part[s]; }
    __syncthreads();
    { const int jj = tid >> 7, e = tid & 127; float qc = 0.f;
#pragma unroll
      for (int dg = 0; dg < 16; ++dg) qc += red[(dg * 4 + jj) * 128 + e];
      const float bcj = jj == 0 ? bc[0] : jj == 1 ? bc[1] : jj == 2 ? bc[2] : bc[3], mjj = jj == 0 ? mj[0] : jj == 1 ? mj[1] : jj == 2 ? mj[2] : mj[3], wi = jj == 0 ? wint[0] : jj == 1 ? wint[1] : jj == 2 ? wint[2] : wint[3];
      float num = wi * qc, den = wi * qnl[jj];
#pragma unroll
      for (int s = 0; s < 4; ++s) if (s <= jj) { const float w = Sl[jj * 4 + s] * expf(bcj - bc[s] + ig[s] - mjj); num += w * vl[s * 128 + e]; den += w; }
      const float hv = num / fmaxf(fabsf(den), expf(-mjj));
      const float sq = wave_sum(hv * hv); if (lane == 0) ws2[wave] = sq;
      __syncthreads();
      const float rstd = rsqrtf((ws2[2 * jj] + ws2[2 * jj + 1]) * (1.0f / 128.0f) + EPS);
      const size_t oi = (size_t)(row0 + jj) * 512 + h * 128 + e;
      ((bf16*)(ws + WS_HY))[(size_t)(row0 + jj) * 1024 + h * 128 + e] = (bf16)f2bf(hv * rstd * gmh_[h * 128 + e] * bf2f(((const bf16*)(ws + WS_MO))[oi])); }
    if (tid < 128) out[O_NS + (size_t)(b * 4 + h) * 128 + tid] = decay * nl[tid] + ((kwl[tid] + kwl[128 + tid]) + (kwl[256 + tid] + kwl[384 + tid]));
    if (tid == 0) out[O_MS + b * 4 + h] = mnew;
    __syncthreads();
}
__device__ __forceinline__ float dpp_sum16(float v) {
    v += __builtin_bit_cast(float, __builtin_amdgcn_update_dpp(0, __builtin_bit_cast(int, v), 0xB1, 0xF, 0xF, true));
    v += __builtin_bit_cast(float, __builtin_amdgcn_update_dpp(0, __builtin_bit_cast(int, v), 0x4E, 0xF, 0xF, true));
    v += __builtin_bit_cast(float, __builtin_amdgcn_update_dpp(0, __builtin_bit_cast(int, v), 0x124, 0xF, 0xF, true));
    v += __builtin_bit_cast(float, __builtin_amdgcn_update_dpp(0, __builtin_bit_cast(int, v), 0x128, 0xF, 0xF, true));
    return v;
}
#ifndef DEC_NPG
#define DEC_NPG 4
#endif
constexpr int DEC_NPG_ = DEC_NPG, DEC_NI = NPAGES / DEC_NPG_, DEC_TOK = PAGE * DEC_NPG_, DEC_TPT = DEC_TOK / 64;
constexpr int DEC_ST = 68;
__device__ __forceinline__ void fox_dec_unit(const int* pt_, const float* clf_, const float* ck_, const float* cv_, unsigned char* ws_, float* out, LAS unsigned char* lds, int u) {
    PHASE_IDS_; OPAQUE_WS_;
    const int b = u / DEC_NI, qtr = u % DEC_NI; const int* pt = pt_ + b * NPAGES;
    LAS float* tbl = (LAS float*)lds;
    LAS float* csum = tbl + DEC_TOK * 8; LAS float* osum = csum + 512;
    LAS int* pgl = (LAS int*)(osum + 512); if (tid < DEC_NPG_) pgl[tid] = pt[qtr * DEC_NPG_ + tid];
    { const int hh = tid & 7, cc = tid >> 3; float lfv[DEC_TPT]; float s = 0.f, so = 0.f;
#pragma unroll
      for (int i = 0; i < DEC_TPT; ++i) { const int tok = DEC_TPT * cc + i; const int pg = pt[qtr * DEC_NPG_ + (tok >> 7)]; lfv[i] = clf_[((size_t)pg * PAGE + (tok & 127)) * 8 + hh]; s += lfv[i]; }
      for (int t8 = DEC_TOK * (qtr + 1); t8 < PAST; t8 += 512) {
        float lv[8];
#pragma unroll
        for (int i = 0; i < 8; ++i) { const int pg2 = pt[(t8 >> 7) + (i >> 1)]; lv[i] = clf_[((size_t)pg2 * PAGE + ((cc + 64 * i) & 127)) * 8 + hh]; }
        so += ((lv[0] + lv[1]) + (lv[2] + lv[3])) + ((lv[4] + lv[5]) + (lv[6] + lv[7])); }
      float sc = s;
      { const float t_ = __shfl_down(sc, 8);  if (lane < 56) sc += t_; }
      { const float t_ = __shfl_down(sc, 16); if (lane < 48) sc += t_; }
      { const float t_ = __shfl_down(sc, 32); if (lane < 32) sc += t_; }
      float off = __shfl_down(sc, 8); if (lane >= 56) off = 0.f;
      so += __shfl_xor(so, 8); so += __shfl_xor(so, 16); so += __shfl_xor(so, 32);
      if (lane < 8) { csum[wave * 8 + hh] = sc; osum[wave * 8 + hh] = so; }
      __syncthreads();
#pragma unroll
      for (int w2 = 0; w2 < 8; ++w2) { const float a_ = csum[w2 * 8 + hh], o_ = osum[w2 * 8 + hh]; off += (w2 > wave ? a_ : 0.f) + o_; }
#pragma unroll
      for (int i = DEC_TPT - 1; i >= 0; --i) { tbl[(DEC_TPT * cc + i) * 8 + hh] = off * LOG2E; off += lfv[i]; } }
    __syncthreads();
    const int h = wave, ts = lane >> 3, part = lane & 7;
    f32x4 q[4][2]; const int rowq = MP + b * DT;
#pragma unroll
    for (int t = 0; t < 4; ++t)
#pragma unroll
        for (int j = 0; j < 2; ++j) q[t][j] = ld4bf((const bf16*)(ws + WS_FQ) + (size_t)(rowq + t) * 512 + h * 64 + 32 * j + 4 * part);
#define DPPF(v_, c_) __builtin_bit_cast(float, __builtin_amdgcn_update_dpp(0, __builtin_bit_cast(int, v_), c_, 0xF, 0xF, true))
#define OCTSUM(v_) do { v_ += DPPF(v_, 0xB1); v_ += DPPF(v_, 0x4E); v_ += DPPF(v_, 0x141); } while (0)
#define DOT8(k0_, k1_, t_) (((k0_.x * q[t_][0].x + k0_.y * q[t_][0].y) + (k0_.z * q[t_][0].z + k0_.w * q[t_][0].w)) + ((k1_.x * q[t_][1].x + k1_.y * q[t_][1].y) + (k1_.z * q[t_][1].z + k1_.w * q[t_][1].w)))
    float snew[4]; f32x4 vn[2];
    { const float* GT = (const float*)(ws + WS_GATES) + (size_t)rowq * 16 + 8 + h; float fn = 0.f; const int tn = ts & 3;
#pragma unroll
      for (int t2 = 0; t2 < 4; ++t2) { const float x = GT[t2 * 16]; if (t2 <= tn) fn += x; }
      f32x4 kn[2];
#pragma unroll
      for (int j = 0; j < 2; ++j) { kn[j] = *(const GAS f32x4*)(out + O_KS + (size_t)(b * DT + tn) * 512 + h * 64 + 32 * j + 4 * part); vn[j] = *(const GAS f32x4*)(out + O_VS + (size_t)(b * DT + tn) * 512 + h * 64 + 32 * j + 4 * part); }
      const float biasn = -fn * LOG2E;
#pragma unroll
      for (int t = 0; t < 4; ++t) { float a_ = DOT8(kn[0], kn[1], t); OCTSUM(a_); snew[t] = (ts < 4 && tn <= t) ? a_ + biasn : -INFINITY; } }
    float R[4], l[4], thr[4]; f32x4 o[4][2];
#pragma unroll
    for (int t = 0; t < 4; ++t) { float mx = snew[t]; mx = fmaxf(mx, __shfl_xor(mx, 8)); mx = fmaxf(mx, __shfl_xor(mx, 16)); mx = fmaxf(mx, __shfl_xor(mx, 32));
        R[t] = mx; thr[t] = mx - 32.0f; l[t] = 0.f; o[t][0] = (f32x4){0.f, 0.f, 0.f, 0.f}; o[t][1] = (f32x4){0.f, 0.f, 0.f, 0.f}; }
    if (qtr == DEC_NI - 1) {
#pragma unroll
        for (int t = 0; t < 4; ++t) { const float p_ = __builtin_amdgcn_exp2f(snew[t] - R[t]); l[t] += p_; o[t][0] += vn[0] * p_; o[t][1] += vn[1] * p_; } }
#define DEC_KADDR(it_) (((size_t)__builtin_amdgcn_readfirstlane(pgl[(it_) >> 3]) * PAGE + ((it_) & 7) * 16 + ts) * 8 + h) * 64 + 4 * part
#define DEC_LOADK(it_, kk_) do { const size_t to_ = DEC_KADDR(it_); \
        _Pragma("unroll") for (int g = 0; g < 2; ++g) _Pragma("unroll") for (int j = 0; j < 2; ++j) kk_[g][j] = __builtin_nontemporal_load((const GAS f32x4*)(ck_ + to_ + (size_t)g * 8 * 512 + 32 * j)); } while (0)
    LAS float* scb = (LAS float*)(lds + 32768) + wave * 2048;
    unsigned long long vmask = 0ull;
    const int t1 = part & 3, g1 = part >> 2; const bool pb2 = (part & 4) != 0, pb1 = (part & 2) != 0, pb0 = (part & 1) != 0;
    float R1 = t1 == 0 ? R[0] : t1 == 1 ? R[1] : t1 == 2 ? R[2] : R[3]; const float thr1 = R1 - 32.0f; float l1 = 0.f;
    typedef float f32x2_ __attribute__((ext_vector_type(2)));
#define LO2(v_) ((f32x2_){(v_).x, (v_).y})
#define HI2(v_) ((f32x2_){(v_).z, (v_).w})
#define DEC_STEP(it_, kk_) do { const int ii_ = (it_); \
        const float bias_ = tbl[(((ii_ >> 3) * 128 + (ii_ & 7) * 16 + ts) * 8 + h) + 64 * g1]; float pv_[8]; \
        _Pragma("unroll") for (int g = 0; g < 2; ++g) _Pragma("unroll") for (int t = 0; t < 4; ++t) { \
            f32x2_ a_ = LO2(kk_[g][0]) * LO2(q[t][0]); a_ = HI2(kk_[g][0]) * HI2(q[t][0]) + a_; a_ = LO2(kk_[g][1]) * LO2(q[t][1]) + a_; a_ = HI2(kk_[g][1]) * HI2(q[t][1]) + a_; pv_[4 * g + t] = a_.x + a_.y; } \
        float w_[4], u_[2]; \
        _Pragma("unroll") for (int i = 0; i < 4; ++i) { const float keep_ = pb2 ? pv_[4 + i] : pv_[i], send_ = pb2 ? pv_[i] : pv_[4 + i]; w_[i] = keep_ + DPPF(send_, 0x141); }        \
        _Pragma("unroll") for (int i = 0; i < 2; ++i) { const float keep_ = pb1 ? w_[2 + i] : w_[i], send_ = pb1 ? w_[i] : w_[2 + i]; u_[i] = keep_ + DPPF(send_, 0x4E); }              \
        const float keep0_ = pb0 ? u_[1] : u_[0], send0_ = pb0 ? u_[0] : u_[1]; const float s_ = keep0_ + DPPF(send0_, 0xB1) + bias_;                                                     \
        if (__any(s_ > R1 + 64.0f)) { float rold_ = R1; \
            _Pragma("unroll") for (int t = 0; t < 4; ++t) { float mx_ = t1 == t ? s_ : -INFINITY; \
                _Pragma("unroll") for (int o_ = 1; o_ < 64; o_ <<= 1) mx_ = fmaxf(mx_, __shfl_xor(mx_, o_)); \
                const float rn_ = fmaxf(R[t], mx_), cr_ = __builtin_amdgcn_exp2f(R[t] - rn_); l[t] *= cr_; o[t][0] *= cr_; o[t][1] *= cr_; R[t] = rn_; } \
            R1 = t1 == 0 ? R[0] : t1 == 1 ? R[1] : t1 == 2 ? R[2] : R[3]; l1 *= __builtin_amdgcn_exp2f(rold_ - R1); } \
        l1 += __builtin_amdgcn_exp2f(s_ - R1); \
        const unsigned long long nm_ = __ballot(s_ >= thr1); const bool f0_ = (nm_ & 0x0F0F0F0F0F0F0F0Full) != 0ull, f1_ = (nm_ & 0xF0F0F0F0F0F0F0F0ull) != 0ull; \
        if (f0_ || f1_) { if (pb2 ? f1_ : f0_) scb[((2 * ii_ + g1) * 8 + ts) * 4 + t1] = s_; \
            vmask |= ((f0_ ? 1ull : 0ull) | (f1_ ? 2ull : 0ull)) << (2 * ii_); } } while (0)
    { f32x4 kA[2][2], kB[2][2];
      DEC_LOADK(0, kA);
#pragma unroll 1
      for (int it = 0; it < 8 * DEC_NPG_; it += 2) {
          DEC_LOADK(it + 1, kB); __builtin_amdgcn_sched_barrier(0);
          DEC_STEP(it, kA); __builtin_amdgcn_sched_barrier(0);
          if (it + 2 < 8 * DEC_NPG_) DEC_LOADK(it + 2, kA);
          __builtin_amdgcn_sched_barrier(0);
          DEC_STEP(it + 1, kB); __builtin_amdgcn_sched_barrier(0);
      } }
    while (vmask != 0ull) {
        int gg[8]; float wg[8];
#pragma unroll
        for (int u = 0; u < 8; ++u) { const bool has_ = vmask != 0ull; const int g_ = has_ ? (int)__builtin_ctzll(vmask) : gg[0]; if (has_) vmask &= vmask - 1ull; gg[u] = g_; wg[u] = has_ ? 1.0f : 0.0f; }
        f32x4 vv[8][2], sv[8];
#pragma unroll
        for (int u = 0; u < 8; ++u) { const size_t to_ = (((size_t)__builtin_amdgcn_readfirstlane(pgl[gg[u] >> 4]) * PAGE + (gg[u] & 15) * 8 + ts) * 8 + h) * 64 + 4 * part;
            vv[u][0] = __builtin_nontemporal_load((const GAS f32x4*)(cv_ + to_)); vv[u][1] = __builtin_nontemporal_load((const GAS f32x4*)(cv_ + to_ + 32));
            sv[u] = *(const LAS f32x4*)(scb + (gg[u] * 8 + ts) * 4); }
        __builtin_amdgcn_sched_barrier(0);
#pragma unroll
        for (int u = 0; u < 8; ++u) {
            const float p0_ = __builtin_amdgcn_exp2f(sv[u].x - R[0]) * wg[u], p1_ = __builtin_amdgcn_exp2f(sv[u].y - R[1]) * wg[u], p2_ = __builtin_amdgcn_exp2f(sv[u].z - R[2]) * wg[u], p3_ = __builtin_amdgcn_exp2f(sv[u].w - R[3]) * wg[u];
            o[0][0] += vv[u][0] * p0_; o[0][1] += vv[u][1] * p0_; o[1][0] += vv[u][0] * p1_; o[1][1] += vv[u][1] * p1_;
            o[2][0] += vv[u][0] * p2_; o[2][1] += vv[u][1] * p2_; o[3][0] += vv[u][0] * p3_; o[3][1] += vv[u][1] * p3_; }
    }
#undef DEC_STEP
#undef DEC_LOADK
#undef DEC_KADDR
#undef DOT8
#undef OCTSUM
#undef DPPF
#undef LO2
#undef HI2
    { float ls_ = l1 + __shfl_xor(l1, 4);
#pragma unroll
      for (int t = 0; t < 4; ++t) l[t] += __shfl(ls_, (lane & ~7) | t); }
#pragma unroll
    for (int t = 0; t < 4; ++t) {
#pragma unroll
        for (int sh = 8; sh <= 32; sh <<= 1) { const float m2 = __shfl_xor(R[t], sh), l2 = __shfl_xor(l[t], sh);
            const float mn = fmaxf(R[t], m2), c1 = __builtin_amdgcn_exp2f(R[t] - mn), c2 = __builtin_amdgcn_exp2f(m2 - mn); l[t] = l[t] * c1 + l2 * c2; R[t] = mn;
#pragma unroll
            for (int j = 0; j < 2; ++j) { f32x4 o2; o2.x = __shfl_xor(o[t][j].x, sh); o2.y = __shfl_xor(o[t][j].y, sh); o2.z = __shfl_xor(o[t][j].z, sh); o2.w = __shfl_xor(o[t][j].w, sh); o[t][j] = o[t][j] * c1 + o2 * c2; } }
        float* rec = (float*)(ws + WS_MISC + MI_DEC) + ((size_t)((b * DEC_NI + qtr) * 8 + h) * 4 + t) * DEC_ST;
        if (ts == 0) { *(GAS f32x4*)(rec + 4 * part) = o[t][0]; *(GAS f32x4*)(rec + 32 + 4 * part) = o[t][1]; if (part == 0) { rec[64] = R[t]; rec[65] = l[t]; } } }
    __syncthreads();
}
__device__ __forceinline__ void fox_dec_combine(unsigned char* ws, int vcu, int Gn, int tid) {
    const float* P = (const float*)(ws + WS_MISC + MI_DEC); bf16* YF = (bf16*)(ws + WS_HY) + 512;
    for (int i = vcu * 512 + tid; i < MS * 128; i += Gn * 512) { const int row = i >> 7, c4 = i & 127, h = c4 >> 4, d = (c4 & 15) * 4, b = row >> 2, t = row & 3;
        const float* r[DEC_NI]; float mm[DEC_NI], mx = -INFINITY;
#pragma unroll
        for (int qd = 0; qd < DEC_NI; ++qd) { r[qd] = P + ((size_t)((b * DEC_NI + qd) * 8 + h) * 4 + t) * DEC_ST; mm[qd] = r[qd][64]; mx = fmaxf(mx, mm[qd]); }
        f32x4 o = (f32x4){0.f, 0.f, 0.f, 0.f}; float ls = 0.f;
#pragma unroll
        for (int qd = 0; qd < DEC_NI; ++qd) { const float w = exp2f(mm[qd] - mx); ls += r[qd][65] * w; o += *(const GAS f32x4*)(r[qd] + d) * w; }
        o *= 1.0f / ls;
        *(GAS unsigned long long*)(YF + (size_t)(MP + row) * 1024 + h * 64 + d) = (unsigned long long)pk2(o.x, o.y) | ((unsigned long long)pk2(o.z, o.w) << 32); }
}
__device__ __forceinline__ void fox_f2_build(unsigned char* ws, LAS unsigned char* lds, int bh, int tid, int lane, int wave) {
    const int b = bh / HF, h = bh % HF;
    const float* GT = (const float*)(ws + WS_GATES) + ((size_t)b * SEQ) * 16 + 8 + h; float* F2g = (float*)(ws + WS_MISC + MI_F2) + (size_t)bh * SEQ;
    LAS float* wsum = (LAS float*)(lds + attn_body::LDS_WS);
    float v[8]; const int base = tid * 8;
#pragma unroll
    for (int i = 0; i < 8; ++i) v[i] = GT[(size_t)(base + i) * 16];
#pragma unroll
    for (int i = 1; i < 8; ++i) v[i] += v[i - 1];
    float sc = v[7];
#pragma unroll
    for (int o = 1; o < 64; o <<= 1) { const float t = __shfl_up(sc, o); if (lane >= o) sc += t; }
    if (lane == 63) wsum[wave] = sc;
    __syncthreads();
    float off = sc - v[7];
    for (int w = 0; w < wave; ++w) off += wsum[w];
    f32x4 o0, o1; o0.x = -(v[0] + off) * LOG2E; o0.y = -(v[1] + off) * LOG2E; o0.z = -(v[2] + off) * LOG2E; o0.w = -(v[3] + off) * LOG2E; o1.x = -(v[4] + off) * LOG2E; o1.y = -(v[5] + off) * LOG2E; o1.z = -(v[6] + off) * LOG2E; o1.w = -(v[7] + off) * LOG2E;
    *(GAS f32x4*)(F2g + base) = o0; *(GAS f32x4*)(F2g + base + 4) = o1;
    __syncthreads();
}
__device__ __forceinline__ void fox_f2_to_lds(unsigned char* ws, LAS unsigned char* lds, int b, int h, int tid, int lane, int wave) {
    const float* F2g = (const float*)(ws + WS_MISC + MI_F2) + (size_t)(b * HF + h) * SEQ; LAS float* F2l = (LAS float*)(lds + attn_body::LDS_F2);
    *(LAS f32x4*)(F2l + 8 * tid) = *(const GAS f32x4*)(F2g + 8 * tid); *(LAS f32x4*)(F2l + 8 * tid + 4) = *(const GAS f32x4*)(F2g + 8 * tid + 4);
    __syncthreads();
}
#define PHASE_IDS int tid_ = threadIdx.x; asm volatile("" : "+v"(tid_)); const int tid = tid_, lane = tid & 63, wave = __builtin_amdgcn_readfirstlane(tid >> 6)
__device__ __forceinline__ void fox_attn_item(unsigned char* ws_, LAS unsigned char* ldsl, unsigned char* lds, int bh, int qb, float margin) {
    PHASE_IDS_; OPAQUE_WS_;
    const int b = bh / HF, h = bh % HF;
    fox_f2_to_lds(ws, ldsl, b, h, tid, lane, wave);
    const LAS float* TBl = (const LAS float*)(ldsl + attn_body::LDS_F2);
    const int NT = 4 * (qb + 1); int t0 = 0; const float thr = TBl[256 * qb] - margin;
    { const int tc = 2 * (lane + 1);
      const bool ok_ = (NT - tc >= 4) && TBl[64 * (tc <= 62 ? tc : 62) - 1] < thr;
      const unsigned long long mk = __ballot(ok_);
      t0 = 2 * (int)__builtin_ctzll(~mk | (1ull << 63)); }
    t0 = __builtin_amdgcn_readfirstlane(t0);
    attn_body::attn_unit<8>(b, h, qb, t0, (const attn_body::bf16*)(ws + WS_FQ), (const attn_body::bf16*)(ws + WS_FK), (const attn_body::bf16*)(ws + WS_FV), (attn_body::bf16*)(ws + WS_HY) + 512, (char*)lds + RING_OFF);
}
__device__ __forceinline__ void late_weights_item(const Args& A, unsigned char* ws_, LAS unsigned char* lds, int q) {
    PHASE_IDS_; OPAQUE_WS_;
    p0_late_item(A, ws, q * 8 + wave, (LAS float*)(lds + RING_OFF + wave * 16384), lane);
    __syncthreads();
}
constexpr int CW_WQW = 192, CW_WQP = 256;
__device__ __forceinline__ void drain_late_weights(Frame& F, const Args& A) {
    PHASE_IDS_; size_t wso_ = 0; asm volatile("" : "+s"(wso_)); unsigned char* ws = F.ws + wso_;
    volatile LAS unsigned* slot = (volatile LAS unsigned*)(F.lds + LDSCTL_OFF);
    for (;;) {
        if (tid == 0) slot[0] = __hip_atomic_fetch_add(F.ctl + CW_WQW, 1u, __ATOMIC_RELAXED, __HIP_MEMORY_SCOPE_AGENT);
        __syncthreads();
        const int k = __builtin_amdgcn_readfirstlane((int)slot[0]);
        __syncthreads();
        if (k >= NLATE / 8) break;
        late_weights_item(A, ws, F.lds, k);
    }
}
struct OneUnit { int pm, pn;
    __device__ __forceinline__ bool next(int i, pg8::Unit& u) const { if (i) return false; u.pm = pm; u.pn = pn; return true; }
    __device__ __forceinline__ void a_ready(const pg8::Unit&) const {}
    __device__ __forceinline__ void done(const pg8::Unit&) const {} };
__device__ __forceinline__ void drain_ple_proj(Frame& F) {
    PHASE_IDS_; size_t wso_ = 0; asm volatile("" : "+s"(wso_)); unsigned char* ws = F.ws + wso_;
    volatile LAS unsigned* slot = (volatile LAS unsigned*)(F.lds + LDSCTL_OFF);
    for (;;) {
        if (tid == 0) slot[0] = __hip_atomic_fetch_add(F.ctl + CW_WQP, 1u, __ATOMIC_RELAXED, __HIP_MEMORY_SCOPE_AGENT);
        __syncthreads();
        const int k = __builtin_amdgcn_readfirstlane((int)slot[0]);
        __syncthreads();
        if (k >= 264) break;
        pg8::Gemm g{(const bf16*)(ws + WS_PB), (const bf16*)(ws + WS_WPP), MT, DM, PLE}; OneUnit S{k >> 2, k & 3};
        pg8::EpiStore E{(bf16*)(ws + WS_TP)};
        pg8::gemm_phase<pg8::EpiStore, OneUnit, false, true>(F.lds + RING_OFF, g, S, E);
        __syncthreads();
    }
}
constexpr int CW_WQ = 64, CW_WQD = 128;
constexpr int WQC_ITEMS = 512 * 3;
constexpr int WQD_ITEMS = DB * DEC_NI;
#ifndef DEC_FIRST_OF_16
#define DEC_FIRST_OF_16 6
#endif
__device__ __forceinline__ void mix_phase_a(Frame& F, const Args& A, unsigned char* lds) {
    PHASE_IDS; size_t wso_ = 0; asm volatile("" : "+s"(wso_)); unsigned char* ws = F.ws + wso_;
    float mq = 0.f, mk = 0.f; for (int i = 0; i < 64; ++i) { mq = fmaxf(mq, fabsf(I_GQN[i])); mk = fmaxf(mk, fabsf(I_GKN[i])); }
    if (tid == 0) ((volatile LAS float*)(F.lds + LDSCTL_OFF))[4] = 24.0f + 2.0f * (64.0f * mq * mk * C2Q);
    volatile LAS unsigned* slot = (volatile LAS unsigned*)(F.lds + LDSCTL_OFF);
    const bool dec_first = (((int)blockIdx.x >> 3) & 15) < DEC_FIRST_OF_16;
    for (int pass = 0; pass < 2; ++pass) { const bool dq = dec_first != (pass == 1);
        for (;;) {
            if (tid == 0) slot[0] = __hip_atomic_fetch_add(F.ctl + (dq ? CW_WQD : CW_WQ), 1u, __ATOMIC_RELAXED, __HIP_MEMORY_SCOPE_AGENT);
            __syncthreads();
            const int k = __builtin_amdgcn_readfirstlane((int)slot[0]);
            __syncthreads();
            if (k >= (dq ? WQD_ITEMS : WQC_ITEMS)) break;
            if (dq) fox_dec_unit(I_PT, I_CLF, I_CK, I_CV, ws, F.out, F.lds, k);
            else if (k < 512) fox_attn_item(ws, F.lds, lds, k & 31, 15 - (k >> 5), ((volatile LAS float*)(F.lds + LDSCTL_OFF))[4]);
            else if (k < 1024) mlstm_a_unit(ws, F.lds, k - 512);
            else mlstm_s_unit(I_SM, I_SN, I_SC, I_GMH, ws, F.out, F.lds, k - 1024);
        } }
    drain_late_weights(F, A);
}
__device__ __forceinline__ void mix_phase_b(Frame& F, const Args& A) {
    PHASE_IDS; size_t wso_ = 0; asm volatile("" : "+s"(wso_)); unsigned char* ws = F.ws + wso_;
    mlstm_b(ws, F.out, F.lds, F.vcu, F.G, tid);
    fox_dec_combine(ws, F.vcu, F.G, tid);
}
__device__ __forceinline__ void mix_phase_c(Frame& F, const Args& A, unsigned char* lds) {
    PHASE_IDS; size_t wso_ = 0; asm volatile("" : "+s"(wso_)); unsigned char* ws = F.ws + wso_;
    for (int u = F.vcu; u < 512; u += F.G) { mlstm_c_unit(A, ws, F.lds, u, tid, lane, wave);
#ifdef DUP_C
        mlstm_c_unit(A, ws, F.lds, u, tid, lane, wave);
#endif
    }
}
__device__ __forceinline__ f32x4 mini_gemm(const bf16* A_, const bf16* Bt, int K, int tr, int tc, LAS float* red, int tid, int lane, int wave, int lda = 0, int ldb = 0) {
    if (lda == 0) lda = K; if (ldb == 0) ldb = K;
    const int fr = lane & 15, fq = lane >> 4; const int ksl = K >> 3, nstep = ksl >> 5;
    f32x4 acc[2][4];
#pragma unroll
    for (int rb = 0; rb < 2; ++rb)
#pragma unroll
        for (int cb = 0; cb < 4; ++cb) acc[rb][cb] = (f32x4){0.f, 0.f, 0.f, 0.f};
    const bf16* Ap = A_ + (size_t)(32 * tr + fr) * lda + wave * ksl + 8 * fq; const bf16* Bp = Bt + (size_t)(64 * tc + fr) * ldb + wave * ksl + 8 * fq;
#pragma unroll 1
    for (int ks0 = 0; ks0 < nstep; ks0 += 4) {
        bf16x8 a[4][2], b[4][4];
#pragma unroll
        for (int u = 0; u < 4; ++u) if (ks0 + u < nstep) {
#pragma unroll
            for (int rb = 0; rb < 2; ++rb) a[u][rb] = *(const GAS bf16x8*)(Ap + (size_t)rb * 16 * lda + 32 * (ks0 + u));
#pragma unroll
            for (int cb = 0; cb < 4; ++cb) b[u][cb] = *(const GAS bf16x8*)(Bp + (size_t)cb * 16 * ldb + 32 * (ks0 + u)); }
        __builtin_amdgcn_sched_barrier(0);
#pragma unroll
        for (int u = 0; u < 4; ++u) if (ks0 + u < nstep) {
#pragma unroll
            for (int rb = 0; rb < 2; ++rb)
#pragma unroll
                for (int cb = 0; cb < 4; ++cb) acc[rb][cb] = MFMA16(b[u][cb], a[u][rb], acc[rb][cb]); }
    }
#pragma unroll
    for (int rb = 0; rb < 2; ++rb)
#pragma unroll
        for (int cb = 0; cb < 4; ++cb) *(LAS f32x4*)(red + wave * 2048 + (16 * rb + fr) * 64 + 16 * cb + 4 * fq) = acc[rb][cb];
    __syncthreads();
    f32x4 s = (f32x4){0.f, 0.f, 0.f, 0.f};
#pragma unroll
    for (int w = 0; w < 8; ++w) s += *(const LAS f32x4*)(red + w * 2048 + (tid >> 4) * 64 + (tid & 15) * 4);
    __syncthreads();
    return s;
}
__device__ __forceinline__ float sig1(float x) { return __builtin_amdgcn_rcpf(1.f + __builtin_amdgcn_exp2f(-LOG2E * x)); }
__device__ __forceinline__ void smp_merge(Frame& F, unsigned char* ws, int tid, int lane, int wave) {
    LAS float* red = (LAS float*)(F.lds + RING_OFF);
    for (int t = F.vcu; t < 256; t += F.G) { const int tr = 8 * (t >> 7) + ((t & 31) >> 2), tc = 4 * ((t >> 5) & 3) + (t & 3);
        const f32x4 a = mini_gemm((const bf16*)(ws + WS_HY) + (size_t)MP * DM, (const bf16*)(ws + WS_WPA), WM, tr, tc, red, tid, lane, wave, DM, DM);
        const f32x4 b = mini_gemm((const bf16*)(ws + WS_HY) + (size_t)MP * DM + 512, (const bf16*)(ws + WS_WPA) + 512, WF, tr, tc, red, tid, lane, wave, DM, DM);
        const size_t idx = (size_t)(MP + 32 * tr + (tid >> 4)) * DM + 64 * tc + 4 * (tid & 15);
        st4bf((bf16*)(ws + WS_U) + idx, ld4bf((const bf16*)(ws + WS_GA) + idx) * a + ld4bf((const bf16*)(ws + WS_GB) + idx) * b); }
}
template <int BASE_BF16> __device__ __forceinline__ void smp_res(Frame& F, const bf16* A_, const bf16* Bt, int K, const void* base, bf16* An, float* ssq, int tid, int lane, int wave) {
    LAS float* red = (LAS float*)(F.lds + RING_OFF);
    for (int t = F.vcu; t < 256; t += F.G) { const int tr = 8 * (t >> 7) + ((t & 31) >> 2), tc = 4 * ((t >> 5) & 3) + (t & 3);
        const f32x4 acc = mini_gemm(A_, Bt, K, tr, tc, red, tid, lane, wave);
        const int r = 32 * tr + (tid >> 4), c = 64 * tc + 4 * (tid & 15); const size_t idx = (size_t)r * DM + c;
        const f32x4 o = (BASE_BF16 ? ld4bf((const bf16*)base + idx) : *(const GAS f32x4*)((const float*)base + idx)) + acc; st4bf(An + idx, o);
        const float s = dpp_sum16(dot4f(o)); if ((tid & 15) == 0) ssq[(size_t)r * 16 + tc] = s; }
}
__device__ __forceinline__ void smp_ple(Frame& F, unsigned char* ws, float* Y  , int tid, int lane, int wave) {
    LAS float* red = (LAS float*)(F.lds + RING_OFF);
    for (int t = F.vcu; t < 256; t += F.G) { const int tr = 8 * (t >> 7) + ((t & 31) >> 2), tc = 4 * ((t >> 5) & 3) + (t & 3);
        const f32x4 acc = mini_gemm((const bf16*)(ws + WS_A3) + (size_t)MP * DM, (const bf16*)(ws + WS_WPG), DM, tr, tc, red, tid, lane, wave);
        const int r = 32 * tr + (tid >> 4), c = 64 * tc + 4 * (tid & 15); const size_t idx = (size_t)r * DM + c;
        const GAS f32x4* sp = (const GAS f32x4*)((const float*)(ws + WS_SSQ3) + (size_t)(MP + r) * 16); const f32x4 q = (sp[0] + sp[1]) + (sp[2] + sp[3]);
        const float rs = rsqrtf(((q[0] + q[1]) + (q[2] + q[3])) * (1.0f / DM) + EPS);
        const f32x4 tp = ld4bf((const bf16*)(ws + WS_TP) + (size_t)MP * DM + idx);
        f32x4 y = ld4bf((const bf16*)(ws + WS_A3) + (size_t)MP * DM + idx); y[0] += sig1(acc[0] * rs) * tp[0]; y[1] += sig1(acc[1] * rs) * tp[1]; y[2] += sig1(acc[2] * rs) * tp[2]; y[3] += sig1(acc[3] * rs) * tp[3];
        *(GAS f32x4*)(Y + idx) = y; }
}
constexpr int N_PHASES = 10;
__global__ void __launch_bounds__(NWAVES * 64, 2) fwd_kernel(Args args) {
    extern __shared__ __attribute__((aligned(16))) unsigned char lds[];
    Frame F;
    F.lds = (LAS unsigned char*)lds;
    F.MISC = (volatile LAS unsigned*)(F.lds + MISC_OFF);
    F.G = gridDim.x; { const int bx = blockIdx.x; F.vcu = (F.G % 8 == 0) ? (bx % 8) * (F.G / 8) + bx / 8 : bx; }
    unsigned char* ws0 = args.ws; F.ws = ws0; F.out = args.out;
    F.ctl = (gu32*)(ws0 + WS_CTL);
    const Args& A = args;
    for (int u = threadIdx.x; u < (LDS_BYTES - LDSCTL_OFF) / 4; u += NWAVES * 64) ((LAS unsigned*)(F.lds + LDSCTL_OFF))[u] = 0u;
    __syncthreads();
    XcdBarrier bar = xcd_barrier_post((unsigned*)(F.ctl + CW_BAR), F.MISC + 8);
    const int lo = args.ph_lo, hi = args.ph_hi;
#ifdef PROBE_A
    unsigned long long stamp_[16]; int ns_ = 0;
#define STAMP() do { stamp_[ns_++] = __builtin_amdgcn_s_memrealtime(); } while (0)
#else
#define STAMP() do {} while (0)
#endif
    STAMP();
#define IN(k) (lo <= (k) && (k) < hi)
#define SEAM(k) do { if (IN(k) && IN((k) + 1)) xcd_barrier(bar); } while (0)
#define PHASE_WS size_t wso_ = 0; asm volatile("" : "+s"(wso_)); unsigned char* ws = ws0 + wso_

#ifdef PROBE_P0
    if (IN(0)) { p0_prologue(F, A, 1); STAMP(); p0_prologue(F, A, 2); STAMP(); p0_prologue(F, A, 4); STAMP(); }
#else
    if (IN(0)) { p0_prologue(F, A); }
#endif
    SEAM(0); STAMP();
    if (IN(1)) { PHASE_WS;
        pg8::Gemm g{(const bf16*)(ws + WS_XN), (const bf16*)(ws + WS_WIN), MT, NIN, DM}; pg8::StaticOrder S; S.init(MT, NIN, F.G, (int)blockIdx.x);
        pg8::EpiIn E{(bf16*)(ws + WS_MQ), (bf16*)(ws + WS_MK), (bf16*)(ws + WS_MV), (bf16*)(ws + WS_MO), (bf16*)(ws + WS_FQ), (bf16*)(ws + WS_FK), (bf16*)(ws + WS_FV), (bf16*)(ws + WS_GA), (bf16*)(ws + WS_GB),
                     F.out + O_KP, F.out + O_KS, F.out + O_VP, F.out + O_VS, I_GQN, I_GKN, C2Q};
        pg8::gemm_phase<pg8::EpiIn, pg8::StaticOrder, true, true>(F.lds + RING_OFF, g, S, E);
        __syncthreads();
        { const int f2i = (int)blockIdx.x - ((int)F.G - 64); if (f2i >= 0 && f2i < 32) { PHASE_IDS; fox_f2_build(ws, F.lds, f2i, tid, lane, wave); } else if ((int)F.G < 64) { PHASE_IDS; for (int bh = (int)blockIdx.x; bh < 32; bh += (int)F.G) fox_f2_build(ws, F.lds, bh, tid, lane, wave); } }
        drain_late_weights(F, A);
    }
    SEAM(1); STAMP();
    if (IN(2)) { mix_phase_a(F, A, lds); }
    SEAM(2); STAMP();
    if (IN(3)) { mix_phase_b(F, A); }
    SEAM(3); STAMP();
    if (IN(4)) { mix_phase_c(F, A, lds); }
    SEAM(4); STAMP();
    if (IN(5)) { PHASE_WS;
        { pg8::Gemm g{(const bf16*)(ws + WS_HY), (const bf16*)(ws + WS_WPA), MP, DM, DM}; pg8::StaticOrder S; S.init(MP, DM, F.G, (int)blockIdx.x);
          pg8::EpiMerge2 E{(const bf16*)(ws + WS_GA), (const bf16*)(ws + WS_GB), (bf16*)(ws + WS_U)};
          pg8::gemm_phase<pg8::EpiMerge2, pg8::StaticOrder, true, true>(F.lds + RING_OFF, g, S, E); }
        __syncthreads();
        { PHASE_IDS; smp_merge(F, ws, tid, lane, wave); }
    }
    SEAM(5); STAMP();
    if (IN(6)) { PHASE_WS;
        pg8::Gemm g{(const bf16*)(ws + WS_U), (const bf16*)(ws + WS_WOUT), MP, DM, DM}; pg8::StaticOrder S; S.init(MP, DM, F.G, (int)blockIdx.x);
        pg8::EpiRes<0> E{I_XP, (bf16*)(ws + WS_A2), (float*)(ws + WS_SSQ2)};
        pg8::gemm_phase<pg8::EpiRes<0>, pg8::StaticOrder, true, true>(F.lds + RING_OFF, g, S, E);
        __syncthreads();
        { PHASE_IDS; smp_res<0>(F, (const bf16*)(ws + WS_U) + (size_t)MP * DM, (const bf16*)(ws + WS_WOUT), DM, I_XS, (bf16*)(ws + WS_A2) + (size_t)MP * DM, (float*)(ws + WS_SSQ2) + (size_t)MP * 16, tid, lane, wave); }
    }
    SEAM(6); STAMP();
    if (IN(7)) { PHASE_WS;
        pg8::Gemm g{(const bf16*)(ws + WS_A2), (const bf16*)(ws + WS_WGU), MT, NGU, DM}; pg8::StaticOrder S; S.init(MT, NGU, F.G, (int)blockIdx.x);
        pg8::EpiGU E{(const float*)(ws + WS_SSQ2), (bf16*)(ws + WS_HB)};
        pg8::gemm_phase<pg8::EpiGU, pg8::StaticOrder, true, true>(F.lds + RING_OFF, g, S, E);
        __syncthreads();
        drain_ple_proj(F);
    }
    SEAM(7); STAMP();
    if (IN(8)) { PHASE_WS;
        { pg8::Gemm g{(const bf16*)(ws + WS_HB), (const bf16*)(ws + WS_WDN), MP, DM, DFF}; pg8::StaticOrder S; S.init(MP, DM, F.G, (int)blockIdx.x);
          pg8::EpiRes<1> E{(const bf16*)(ws + WS_A2), (bf16*)(ws + WS_A3), (float*)(ws + WS_SSQ3)};
          pg8::gemm_phase<pg8::EpiRes<1>, pg8::StaticOrder, true, true>(F.lds + RING_OFF, g, S, E); }
        __syncthreads();
        drain_ple_proj(F);
        __syncthreads();
        { PHASE_IDS; smp_res<1>(F, (const bf16*)(ws + WS_HB) + (size_t)MP * DFF, (const bf16*)(ws + WS_WDN), DFF, (const bf16*)(ws + WS_A2) + (size_t)MP * DM, (bf16*)(ws + WS_A3) + (size_t)MP * DM, (float*)(ws + WS_SSQ3) + (size_t)MP * 16, tid, lane, wave); }
    }
    SEAM(8); STAMP();
    if (IN(9)) { PHASE_WS;
        pg8::Gemm g{(const bf16*)(ws + WS_A3), (const bf16*)(ws + WS_WPG), MP, DM, DM}; pg8::StaticOrder S; S.init(MP, DM, F.G, (int)blockIdx.x);
        pg8::EpiPle E{(const float*)(ws + WS_SSQ3), (const bf16*)(ws + WS_TP), (const bf16*)(ws + WS_A3), F.out + O_YP};
        pg8::gemm_phase<pg8::EpiPle, pg8::StaticOrder, true, true>(F.lds + RING_OFF, g, S, E);
        __syncthreads();
        { PHASE_IDS; smp_ple(F, ws, F.out + O_YS, tid, lane, wave); }
    }
#ifdef PROBE_A
    xcd_barrier(bar); STAMP();
    if (blockIdx.x == 0) { float ta = (float)(stamp_[PROBE_A + 1] - stamp_[PROBE_A]) * 0.01f, tb = (float)(stamp_[PROBE_B + 1] - stamp_[PROBE_B]) * 0.01f;
        const float sc = 1.0f + sqrtf(ta * 0.001f); for (int i = threadIdx.x; i < DB * HM_; i += NWAVES * 64) F.out[O_MS + i] *= sc;
        if (threadIdx.x == 0) F.out[O_YP] += tb * 0.1f; }
#endif
#undef IN
#undef SEAM
}

extern "C" void kernel_launch(void* const* d_in, const int* in_sizes, int n_in, void* d_out, int out_size, void* d_ws, size_t ws_size, hipStream_t stream) {
    static int grid = 0;
    if (grid == 0) {
        if (n_in != 28 || out_size != (int)O_END || ws_size < WS_END) { fprintf(stderr, "kernel_launch: unexpected shapes: n_in %d out %d ws %zu\n", n_in, out_size, ws_size); grid = -1; return; }
        int dev = 0, cus = 0, per_cu = 0;
        if (hipGetDevice(&dev) != hipSuccess || hipDeviceGetAttribute(&cus, hipDeviceAttributeMultiprocessorCount, dev) != hipSuccess) { grid = -1; return; }
        if (hipFuncSetAttribute((const void*)fwd_kernel, hipFuncAttributeMaxDynamicSharedMemorySize, LDS_BYTES) != hipSuccess) { fprintf(stderr, "kernel_launch: hipFuncSetAttribute failed\n"); grid = -1; return; }
        if (hipOccupancyMaxActiveBlocksPerMultiprocessor(&per_cu, (const void*)fwd_kernel, NWAVES * 64, LDS_BYTES) != hipSuccess || per_cu < 1) { fprintf(stderr, "kernel_launch: occupancy query says %d\n", per_cu); }
        (void)hipGetLastError();
        grid = cus;
    }
    if (grid < 0) return;
    if (hipMemsetAsync((char*)d_ws + WS_CTL, 0, CTL_ZERO_BYTES, stream) != hipSuccess) return;
    Args a{};
    for (int i = 0; i < 28; ++i) a.in[i] = d_in[i];
    a.out = (float*)d_out; a.ws = (unsigned char*)d_ws;
#ifndef MK_SPLIT
    a.ph_lo = 0; a.ph_hi = N_PHASES;
    hipLaunchKernelGGL(fwd_kernel, dim3(grid), dim3(NWAVES * 64), LDS_BYTES, stream, a);
#else
    for (int p = 0; p < N_PHASES; ++p) { a.ph_lo = p; a.ph_hi = p + 1; hipLaunchKernelGGL(fwd_kernel, dim3(grid), dim3(NWAVES * 64), LDS_BYTES, stream, a); }
#endif
}
```
